# Optimizing an MI355X kernel written in HIP

```python
import math
import jax, jax.numpy as jnp
from jax import lax
import numpy as np

D_MODEL = 1024
BATCH = 8
SEQ = 4096
DEPTH = 1

HEAD_DIM = 64
N_ATTN_HEADS = 8
ATTN_WIDTH = N_ATTN_HEADS * HEAD_DIM
N_GLA_HEADS = 4
GLA_DK = 64
GLA_DV = 128
GLA_K_WIDTH = N_GLA_HEADS * GLA_DK
GLA_V_WIDTH = N_GLA_HEADS * GLA_DV
GLA_GATE_RANK = 16
GLA_TAU = 16.0
GLA_CHUNK = 64
MIX_WIDTH = ATTN_WIDTH + GLA_V_WIDTH
MOBA_BLOCK = 256
MOBA_TOPK = 3
MOBA_Q_CHUNK = 32
IN_WIDTHS = (ATTN_WIDTH, ATTN_WIDTH, ATTN_WIDTH, GLA_K_WIDTH, GLA_K_WIDTH,
             GLA_V_WIDTH, GLA_V_WIDTH, GLA_GATE_RANK)
IN_WIDTH = sum(IN_WIDTHS)
IN_SPLITS = tuple(int(s) for s in np.cumsum(IN_WIDTHS)[:-1])
D_FF = 2816
CONV_WIDTH = 3
ALPHA = (2.0 * DEPTH) ** 0.25
BETA = (8.0 * DEPTH) ** -0.25
EPS = 1e-5
NEG = -1e30

kernel_name = "hymba_moba_gla_convglu_deepnorm_adaln"


def layer_norm(x, g=None, b=None):
    xf = x.astype(jnp.float32)
    mu = jnp.mean(xf, -1, keepdims=True)
    var = jnp.mean(jnp.square(xf - mu), -1, keepdims=True)
    y = (xf - mu) * lax.rsqrt(var + EPS)
    if g is not None:
        y = y * g + b
    return y.astype(x.dtype)


def rms_norm(x, g):
    xf = x.astype(jnp.float32)
    y = xf * lax.rsqrt(jnp.mean(xf * xf, -1, keepdims=True) + EPS) * g
    return y.astype(x.dtype)


def moba_attention(q, k, v):
    B_, H, S, Dh = q.shape
    L = MOBA_BLOCK
    Sp = ((S + L - 1) // L) * L
    pad = ((0, 0), (0, 0), (0, Sp - S), (0, 0))
    q, k, v = jnp.pad(q, pad), jnp.pad(k, pad), jnp.pad(v, pad)
    nb = Sp // L
    topk = min(MOBA_TOPK, nb)
    scale = Dh ** -0.5
    kb = k.reshape(B_, H, nb, L, Dh)
    vb = v.reshape(B_, H, nb, L, Dh)
    k_mean = jnp.mean(kb.astype(jnp.float32), axis=3)
    score = jnp.einsum('bhsd,bhnd->bhsn', q.astype(jnp.float32), k_mean)
    q_blk = jnp.arange(Sp) // L
    past = jnp.arange(nb)[None, :] < q_blk[:, None]
    score = jnp.where(past, score, NEG)
    _, sel = lax.top_k(score, topk)
    sel_valid = jnp.arange(topk)[None, :] < q_blk[:, None]

    QC = MOBA_Q_CHUNK
    n_qc = Sp // QC
    qc = q.reshape(B_, H, n_qc, QC, Dh).transpose(2, 0, 1, 3, 4)
    selc = sel.reshape(B_, H, n_qc, QC, topk).transpose(2, 0, 1, 3, 4)
    validc = sel_valid.reshape(n_qc, QC, topk)
    b_idx = jnp.arange(B_)[:, None, None, None]
    h_idx = jnp.arange(H)[None, :, None, None]

    def step(args):
        i, q_i, sel_i, valid_i = args
        own = (i * QC) // L
        k_own = lax.dynamic_index_in_dim(kb, own, axis=2, keepdims=False)
        v_own = lax.dynamic_index_in_dim(vb, own, axis=2, keepdims=False)
        k_sel = kb[b_idx, h_idx, sel_i]
        v_sel = vb[b_idx, h_idx, sel_i]
        lg_sel = jnp.einsum('bhqd,bhqjld->bhqjl', q_i, k_sel,
                            preferred_element_type=jnp.float32) * scale
        lg_sel = jnp.where(valid_i[None, None, :, :, None], lg_sel, NEG)
        lg_own = jnp.einsum('bhqd,bhld->bhql', q_i, k_own,
                            preferred_element_type=jnp.float32) * scale
        pos_q = i * QC + jnp.arange(QC)
        pos_k = own * L + jnp.arange(L)
        lg_own = jnp.where(pos_k[None, :] <= pos_q[:, None], lg_own, NEG)
        logits = jnp.concatenate([lg_sel.reshape(B_, H, QC, topk * L), lg_own], -1)
        p = jax.nn.softmax(logits, axis=-1).astype(v.dtype)
        p_sel = p[..., :topk * L].reshape(B_, H, QC, topk, L)
        p_own = p[..., topk * L:]
        return (jnp.einsum('bhqjl,bhqjld->bhqd', p_sel, v_sel)
                + jnp.einsum('bhql,bhld->bhqd', p_own, v_own))

    out = lax.map(step, (jnp.arange(n_qc), qc, selc, validc))
    out = out.transpose(1, 2, 0, 3, 4).reshape(B_, H, Sp, Dh)
    return out[:, :, :S]


def gla_attention(q, k, v, log_a):
    B_, H, S, Dk = q.shape
    Dv = v.shape[-1]
    C = GLA_CHUNK
    N = S // C
    f32 = jnp.float32
    q = q.astype(f32).reshape(B_, H, N, C, Dk) * (Dk ** -0.5)
    k = k.astype(f32).reshape(B_, H, N, C, Dk)
    v32 = v.astype(f32).reshape(B_, H, N, C, Dv)
    b = jnp.cumsum(log_a.astype(f32).reshape(B_, H, N, C, Dk), axis=3)
    b_last = b[:, :, :, -1]
    q_dec = q * jnp.exp(b)
    k_dec = k * jnp.exp(-b)
    k_to_end = k * jnp.exp(b_last[:, :, :, None] - b)
    causal = jnp.tril(jnp.ones((C, C), dtype=bool))
    attn = jnp.where(causal, jnp.einsum('bhncd,bhnsd->bhncs', q_dec, k_dec), 0.0)
    o_intra = jnp.einsum('bhncs,bhnsv->bhncv', attn, v32)
    kv = jnp.einsum('bhnsd,bhnsv->bhndv', k_to_end, v32)

    def scan_fn(state, inp):
        decay, kv_n = inp
        return state * decay[..., None] + kv_n, state

    s0 = jnp.zeros((B_, H, Dk, Dv), f32)
    _, states = lax.scan(scan_fn, s0, (jnp.exp(b_last).transpose(2, 0, 1, 3),
                                       kv.transpose(2, 0, 1, 3, 4)))
    states = states.transpose(1, 2, 0, 3, 4)
    o_inter = jnp.einsum('bhncd,bhndv->bhncv', q_dec, states)
    return (o_intra + o_inter).reshape(B_, H, S, Dv).astype(v.dtype)


def token_mixer(u, w_in, w_gla_gate, b_gla_gate, attn_norm_g, gla_norm_g, w_o):
    B_, S, _ = u.shape
    proj = u @ w_in
    qa, ka, va, qg, kg, vg, gg, rg = jnp.split(proj, IN_SPLITS, axis=-1)

    def heads(t, n):
        return t.reshape(B_, S, n, -1).transpose(0, 2, 1, 3)

    o_a = moba_attention(heads(qa, N_ATTN_HEADS), heads(ka, N_ATTN_HEADS), heads(va, N_ATTN_HEADS))
    log_a = jax.nn.log_sigmoid((rg @ w_gla_gate + b_gla_gate).astype(jnp.float32)) / GLA_TAU
    o_g = gla_attention(heads(qg, N_GLA_HEADS), heads(kg, N_GLA_HEADS),
                        heads(vg, N_GLA_HEADS), heads(log_a, N_GLA_HEADS))
    o_a = rms_norm(o_a.transpose(0, 2, 1, 3), attn_norm_g).reshape(B_, S, ATTN_WIDTH)
    o_g = rms_norm(o_g.transpose(0, 2, 1, 3), gla_norm_g).reshape(B_, S, GLA_V_WIDTH)
    o_g = o_g * jax.nn.silu(gg)
    return jnp.concatenate([o_a, o_g], axis=-1) @ w_o


def causal_dwconv(h, w, b):
    out = lax.conv_general_dilated(
        h, w[:, None, :].astype(h.dtype), window_strides=(1,),
        padding=[(CONV_WIDTH - 1, 0)], dimension_numbers=('NWC', 'WIO', 'NWC'),
        feature_group_count=h.shape[-1])
    return out + b


def conv_glu(u, w_up, b_up, conv_w, conv_b, w_down):
    h = u @ w_up + b_up
    hv, hg = jnp.split(h, 2, axis=-1)
    a = jax.nn.gelu(causal_dwconv(hg, conv_w, conv_b), approximate=False) * hv
    return a @ w_down


def setup_inputs(seed: int = 0) -> dict:
    key = jax.random.key(seed)
    ks = jax.random.split(key, 20)
    f32 = jnp.float32
    n = lambda k, s: jax.random.normal(k, s, f32)
    return {
        "x": n(ks[0], (BATCH, SEQ, D_MODEL)),
        "c": n(ks[1], (BATCH, D_MODEL)),
        "w_ada": n(ks[2], (DEPTH, D_MODEL, 6 * D_MODEL)) * D_MODEL ** -0.5,
        "b_ada": n(ks[3], (DEPTH, 6 * D_MODEL)) * 0.01,
        "w_in": n(ks[4], (DEPTH, D_MODEL, IN_WIDTH)) * D_MODEL ** -0.5,
        "w_gla_gate": n(ks[5], (DEPTH, GLA_GATE_RANK, GLA_K_WIDTH)) * GLA_GATE_RANK ** -0.5,
        "b_gla_gate": n(ks[6], (DEPTH, GLA_K_WIDTH)) * 0.1,
        "attn_norm_g": 1.0 + 0.02 * n(ks[7], (DEPTH, N_ATTN_HEADS, HEAD_DIM)),
        "gla_norm_g": 1.0 + 0.02 * n(ks[8], (DEPTH, N_GLA_HEADS, GLA_DV)),
        "w_o": n(ks[9], (DEPTH, MIX_WIDTH, D_MODEL)) * MIX_WIDTH ** -0.5 * BETA,
        "ln1_g": 1.0 + 0.02 * n(ks[10], (DEPTH, D_MODEL)),
        "ln1_b": 0.02 * n(ks[11], (DEPTH, D_MODEL)),
        "w_up": n(ks[12], (DEPTH, D_MODEL, 2 * D_FF)) * D_MODEL ** -0.5,
        "b_up": 0.02 * n(ks[13], (DEPTH, 2 * D_FF)),
        "conv_w": n(ks[14], (DEPTH, CONV_WIDTH, D_FF)) * CONV_WIDTH ** -0.5,
        "conv_b": 0.02 * n(ks[15], (DEPTH, D_FF)),
        "w_down": n(ks[16], (DEPTH, D_FF, D_MODEL)) * D_FF ** -0.5 * BETA,
        "ln2_g": 1.0 + 0.02 * n(ks[17], (DEPTH, D_MODEL)),
        "ln2_b": 0.02 * n(ks[18], (DEPTH, D_MODEL)),
    }


def reference(x, c, w_ada, b_ada, w_in, w_gla_gate, b_gla_gate, attn_norm_g, gla_norm_g,
              w_o, ln1_g, ln1_b, w_up, b_up, conv_w, conv_b, w_down, ln2_g, ln2_b):
    c_act = jax.nn.silu(c)
    for l in range(DEPTH):
        mod = (c_act @ w_ada[l] + b_ada[l])[:, None, :]
        sh1, sc1, g1, sh2, sc2, g2 = jnp.split(mod, 6, axis=-1)
        u = layer_norm(x) * (1.0 + sc1) + sh1
        y = token_mixer(u, w_in[l], w_gla_gate[l], b_gla_gate[l], attn_norm_g[l],
                        gla_norm_g[l], w_o[l])
        x = layer_norm(ALPHA * x + g1 * y, ln1_g[l], ln1_b[l])
        u = layer_norm(x) * (1.0 + sc2) + sh2
        y = conv_glu(u, w_up[l], b_up[l], conv_w[l], conv_b[l], w_down[l])
        x = layer_norm(ALPHA * x + g2 * y, ln2_g[l], ln2_b[l])
    return x
```

```cpp
#include <hip/hip_runtime.h>
#include <cstdio>
#include <cstdint>
namespace pg8 {
#define PG8_LAS __attribute__((address_space(3)))
typedef unsigned short bf16_t;
typedef short bf16x8 __attribute__((ext_vector_type(8)));
typedef float f32x4 __attribute__((ext_vector_type(4)));
typedef unsigned u32x4 __attribute__((ext_vector_type(4)));
constexpr int BM = 256, BK = 64, HALF = 128, HTB = HALF * BK * 2  , STAGE_BYTES = 8 * HTB, NXCD = 8, WGM = 8;

__host__ __device__ __forceinline__ int lds_byte(int r, int c) { const int st = (r >> 4) * 2 + (c >> 5), rr = r & 15, cc = c & 31, ob = rr * 64 + cc * 2; return st * 1024 + (ob ^ (((ob >> 9) & 1) << 5)); }
__host__ __device__ __forceinline__ void stage_rc(int b, int& R, int& C) { const int st = b / 1024, sb = b % 1024, swz = sb ^ (((sb >> 9) & 1) << 5); R = (st >> 1) * 16 + swz / 64; C = (st & 1) * 32 + (swz % 64) / 2; }
__host__ __device__ __forceinline__ int perm32(int rho) { const int n = rho >> 4, i = rho & 15; return 8 * (i >> 2) + 4 * n + (i & 3); }

struct Unit { int pm, pn; };
struct Gemm { const bf16_t* A; const bf16_t* Bt; int M, N, K; };

struct StaticOrder {
    int nM, nN, nwg, G, c;
    __host__ __device__ void init(int M, int N, int G_, int c_) { nM = M / BM; nN = N / BM; nwg = nM * nN; G = G_; c = c_; }
    __host__ __device__ bool next(int i, Unit& u) const {
        const long L = (long)i * G + c; if (L >= nwg) return false;
        int wgid = (int)L; { const int q = nwg / NXCD, r = nwg % NXCD, xcd = wgid % NXCD, off = wgid / NXCD; wgid = (xcd < r ? xcd * (q + 1) : r * (q + 1) + (xcd - r) * q) + off; }
        const int nig = WGM * nN, gid = wgid / nig, fm = gid * WGM, gsz = (nM - fm) < WGM ? (nM - fm) : WGM;
        u.pm = fm + ((wgid % nig) % gsz); u.pn = (wgid % nig) / gsz; return true;
    }
    __device__ __forceinline__ void a_ready(const Unit&) const {}
    __device__ __forceinline__ void done(const Unit&) const {}
};

__device__ __forceinline__ unsigned cvt_pk_bf16(float lo, float hi) { unsigned r; asm volatile("v_cvt_pk_bf16_f32 %0, %1, %2" : "=v"(r) : "v"(lo), "v"(hi)); return r; }
typedef float f32x2 __attribute__((ext_vector_type(2)));
__device__ __forceinline__ f32x2 gelu_pk(f32x2 v) {
    const f32x2 av = __builtin_elementwise_abs(v), d = av * 0.2316418882f + 1.0f;
    f32x2 t; t.x = __builtin_amdgcn_rcpf(d.x); t.y = __builtin_amdgcn_rcpf(d.y);
    f32x2 q = t * 0.5307027145f + (-0.7265760135f); q = q * t + 0.7107068705f; q = q * t + (-0.142248368f); q = q * t + 0.127414796f; q = q * t;
    const f32x2 s = (v * v) * (-0.72134752044f);
    f32x2 e; e.x = __builtin_amdgcn_exp2f(s.x); e.y = __builtin_amdgcn_exp2f(s.y);
    const f32x2 m = v * (q * e), r = v - m;
    f32x2 o; o.x = v.x < 0.f ? m.x : r.x; o.y = v.y < 0.f ? m.y : r.y; return o;
}

template <int ACT  > struct EpiBf16 {
    static constexpr bool PERM = true, AFTER_DRAIN = false; static_assert(ACT == 0 || ACT == 1, "EpiBf16: ACT is 0 (none) or 1 (gelu_pk)");
    bf16_t* O; int ldc; const float* bias; int split_cols; size_t split_stride; float scale0;
    __device__ __forceinline__ void operator()(const f32x4 (&acc)[2][2][4][2], const Unit& u, int wr, int wc, int fr, int fq) const {
        const int row0 = u.pm * BM + wr * 64 + fr; int colt = u.pn * BM; bf16_t* base = O;
        float sc = 1.f; if (split_cols) { const int t = colt / split_cols; base += (size_t)t * split_stride; colt -= t * split_cols; if (t == 0) sc = scale0; }
        const int col0 = colt + wc * 32 + 8 * fq, bcol0 = u.pn * BM + wc * 32 + 8 * fq;
        f32x4 bv[2][2];
#pragma unroll
        for (int bj = 0; bj < 2; ++bj)
#pragma unroll
            for (int n = 0; n < 2; ++n) bv[bj][n] = bias ? *(const f32x4*)(bias + bcol0 + bj * HALF + 4 * n) : (f32x4){0.f, 0.f, 0.f, 0.f};
#pragma unroll
        for (int ai = 0; ai < 2; ++ai)
#pragma unroll
            for (int m = 0; m < 4; ++m) { bf16_t* rowp = base + (size_t)(row0 + ai * HALF + m * 16) * ldc + col0;
#pragma unroll
                for (int bj = 0; bj < 2; ++bj) { f32x4 v0 = acc[ai][bj][m][0] + bv[bj][0], v1 = acc[ai][bj][m][1] + bv[bj][1];
                    if (ACT == 1) { f32x2 a = gelu_pk((f32x2){v0[0], v0[1]}), b = gelu_pk((f32x2){v0[2], v0[3]}), c = gelu_pk((f32x2){v1[0], v1[1]}), d = gelu_pk((f32x2){v1[2], v1[3]});
                        v0 = (f32x4){a.x, a.y, b.x, b.y}; v1 = (f32x4){c.x, c.y, d.x, d.y}; }
                    v0 = v0 * sc; v1 = v1 * sc; u32x4 w; w.x = cvt_pk_bf16(v0[0], v0[1]); w.y = cvt_pk_bf16(v0[2], v0[3]); w.z = cvt_pk_bf16(v1[0], v1[1]); w.w = cvt_pk_bf16(v1[2], v1[3]);
                    *(u32x4*)(rowp + bj * HALF) = w; } }
    }
};

template <class Epi, class Sched, bool ALIGN_EPI = false, bool SP2 = false>
__device__ __forceinline__ void gemm_phase(PG8_LAS unsigned char* lds, const Gemm g, const Sched& S, const Epi& E) {
    const int tid = threadIdx.x, wid = __builtin_amdgcn_readfirstlane(tid >> 6), lane = tid & 63, wr = wid >> 2, wc = wid & 3, fr = lane & 15, fq = lane >> 4;
    const int K = g.K, nt = K / BK;
    unsigned voffA[2], voffB[2];
#pragma unroll
    for (int i = 0; i < 2; ++i) { int R, C; stage_rc(tid * 16 + i * 8192, R, C); const int Rb = Epi::PERM ? ((R & ~31) + perm32(R & 31)) : R;
        voffA[i] = (unsigned)(R * K + C) * 2u; voffB[i] = (unsigned)(Rb * K + C) * 2u; }
    const size_t kstep = (size_t)(BK * 2);
    const size_t hstep = (size_t)HALF * K * 2;
    const size_t tstep = 2 * hstep;
    const unsigned ldsw = (unsigned)wid * 1024u;
    const int aoff = lds_byte(wr * 64 + fr, fq * 8), boff = lds_byte(wc * 32 + fr, fq * 8);
#define PG8_SA(b, h) (((b) * 2 + (h)) * HTB)
#define PG8_SB(b, h) ((4 + (b) * 2 + (h)) * HTB)
#define PG8_STAGE(bufoff, gbase, voff) do { _Pragma("unroll") for (int _i = 0; _i < 2; ++_i) \
        __builtin_amdgcn_global_load_lds((const unsigned*)((const char*)(gbase) + (voff)[_i]), (PG8_LAS unsigned*)(lds + (bufoff) + ldsw + _i * 8192), 16, 0, 0); } while (0)
#define PG8_LDA(dst, b, h) do { _Pragma("unroll") for (int m = 0; m < 4; ++m) _Pragma("unroll") for (int k = 0; k < 2; ++k) dst[m][k] = *(const PG8_LAS bf16x8*)(lds + PG8_SA(b, h) + aoff + m * 2048 + k * 1024); } while (0)
#define PG8_LDB(dst, b, h) do { _Pragma("unroll") for (int n = 0; n < 2; ++n) _Pragma("unroll") for (int k = 0; k < 2; ++k) dst[n][k] = *(const PG8_LAS bf16x8*)(lds + PG8_SB(b, h) + boff + n * 2048 + k * 1024); } while (0)
#define PG8_MMA(ai, bj, At, Bt) do { __builtin_amdgcn_s_setprio(1); _Pragma("unroll") for (int m = 0; m < 4; ++m) _Pragma("unroll") for (int n = 0; n < 2; ++n) _Pragma("unroll") for (int k = 0; k < 2; ++k) \
        acc[ai][bj][m][n] = __builtin_amdgcn_mfma_f32_16x16x32_bf16(Bt[n][k], At[m][k], acc[ai][bj][m][n], 0, 0, 0); __builtin_amdgcn_s_setprio(0); } while (0)
#define PG8_WAIT_V(n) asm volatile("s_waitcnt vmcnt(" #n ")" ::: "memory")
#define PG8_WAIT_L(n) asm volatile("s_waitcnt lgkmcnt(" #n ")" ::: "memory")
#define PG8_BAR __builtin_amdgcn_s_barrier()
#define PG8_SCHED __builtin_amdgcn_sched_barrier(0)
    Unit cur, nxt; int ui = 0;
    if (!S.next(0, cur)) return;
    f32x4 acc[2][2][4][2];
#pragma unroll
    for (int a = 0; a < 2; ++a)
#pragma unroll
        for (int b = 0; b < 2; ++b)
#pragma unroll
            for (int m = 0; m < 4; ++m)
#pragma unroll
                for (int n = 0; n < 2; ++n) acc[a][b][m][n] = (f32x4){0.f, 0.f, 0.f, 0.f};
    bf16x8 At[4][2], B0[2][2], B1[2][2];
    const char* cA = (const char*)g.A + (size_t)cur.pm * tstep; const char* cB = (const char*)g.Bt + (size_t)cur.pn * tstep;
    S.a_ready(cur);
    if constexpr (SP2) {
        PG8_STAGE(PG8_SB(0, 0), cB, voffB); PG8_STAGE(PG8_SB(0, 1), cB + hstep, voffB); PG8_STAGE(PG8_SA(0, 0), cA, voffA); PG8_STAGE(PG8_SA(0, 1), cA + hstep, voffA);
        if (wr == 1) PG8_BAR;
        PG8_WAIT_V(2); PG8_BAR;
        PG8_STAGE(PG8_SB(1, 0), cB + kstep, voffB); PG8_STAGE(PG8_SA(1, 0), cA + kstep, voffA); PG8_STAGE(PG8_SB(1, 1), cB + hstep + kstep, voffB);
        PG8_WAIT_V(6); PG8_BAR;
    } else {
        PG8_STAGE(PG8_SB(0, 0), cB, voffB); PG8_STAGE(PG8_SA(0, 0), cA, voffA); PG8_STAGE(PG8_SB(0, 1), cB + hstep, voffB); PG8_STAGE(PG8_SA(0, 1), cA + hstep, voffA);
        if (wr == 1) PG8_BAR;
        PG8_WAIT_V(4); PG8_BAR;
        PG8_STAGE(PG8_SB(1, 0), cB + kstep, voffB); PG8_STAGE(PG8_SA(1, 0), cA + kstep, voffA); PG8_STAGE(PG8_SB(1, 1), cB + hstep + kstep, voffB);
        PG8_WAIT_V(6); PG8_BAR;
    }
    for (;;) {
        const bool has_next = S.next(ui + 1, nxt);
        const char* nA = has_next ? (const char*)g.A + (size_t)nxt.pm * tstep : cA; const char* nB = has_next ? (const char*)g.Bt + (size_t)nxt.pn * tstep : cB;
        for (int t = 0; t < nt; t += 2) {
            const bool last = (t == nt - 2);
            const char* a1 = cA + (size_t)(t + 1) * kstep;
            const char* a2 = last ? nA : cA + (size_t)(t + 2) * kstep; const char* b2 = last ? nB : cB + (size_t)(t + 2) * kstep;
            const char* a3 = a2 + kstep; const char* b3 = b2 + kstep;
            if (last && has_next) S.a_ready(nxt);
            if constexpr (SP2) {
            PG8_LDB(B0, 0, 0); PG8_LDB(B1, 0, 1); PG8_SCHED; PG8_LDA(At, 0, 0); PG8_STAGE(PG8_SA(1, 1), a1 + hstep, voffA);
            PG8_WAIT_V(8); PG8_WAIT_L(0); PG8_BAR; PG8_MMA(0, 0, At, B0); PG8_MMA(0, 1, At, B1); PG8_BAR; PG8_SCHED;
            PG8_LDA(At, 0, 1); PG8_STAGE(PG8_SB(0, 0), b2, voffB); PG8_STAGE(PG8_SB(0, 1), b2 + hstep, voffB); PG8_STAGE(PG8_SA(0, 0), a2, voffA);
            PG8_WAIT_V(8); PG8_WAIT_L(0); PG8_BAR; PG8_MMA(1, 0, At, B0); PG8_MMA(1, 1, At, B1); PG8_BAR; PG8_SCHED;
            PG8_LDB(B0, 1, 0); PG8_LDB(B1, 1, 1); PG8_SCHED; PG8_LDA(At, 1, 0); PG8_STAGE(PG8_SA(0, 1), a2 + hstep, voffA);
            PG8_WAIT_V(8); PG8_WAIT_L(0); PG8_BAR; PG8_MMA(0, 0, At, B0); PG8_MMA(0, 1, At, B1); PG8_BAR; PG8_SCHED;
            PG8_LDA(At, 1, 1); PG8_STAGE(PG8_SB(1, 0), b3, voffB); PG8_STAGE(PG8_SB(1, 1), b3 + hstep, voffB); PG8_STAGE(PG8_SA(1, 0), a3, voffA);
            PG8_WAIT_V(8); PG8_WAIT_L(0); PG8_BAR; PG8_MMA(1, 0, At, B0); PG8_MMA(1, 1, At, B1); PG8_BAR; PG8_SCHED;
            } else {
            PG8_LDB(B0, 0, 0); PG8_SCHED; PG8_LDA(At, 0, 0); PG8_STAGE(PG8_SA(1, 1), a1 + hstep, voffA);
            PG8_WAIT_L(8); PG8_BAR; PG8_WAIT_L(0); PG8_MMA(0, 0, At, B0); PG8_BAR; PG8_SCHED;
            PG8_LDB(B1, 0, 1); PG8_STAGE(PG8_SB(0, 0), b2, voffB);
            PG8_BAR; PG8_WAIT_L(0); PG8_MMA(0, 1, At, B1); PG8_BAR;
            PG8_LDA(At, 0, 1); PG8_STAGE(PG8_SA(0, 0), a2, voffA);
            PG8_BAR; PG8_WAIT_L(0); PG8_MMA(1, 0, At, B0); PG8_BAR; PG8_SCHED;
            PG8_STAGE(PG8_SB(0, 1), b2 + hstep, voffB);
            PG8_WAIT_V(6); PG8_BAR; PG8_MMA(1, 1, At, B1); PG8_BAR;
            PG8_LDB(B0, 1, 0); PG8_SCHED; PG8_LDA(At, 1, 0); PG8_STAGE(PG8_SA(0, 1), a2 + hstep, voffA);
            PG8_WAIT_L(8); PG8_BAR; PG8_WAIT_L(0); PG8_MMA(0, 0, At, B0); PG8_BAR; PG8_SCHED;
            PG8_LDB(B1, 1, 1); PG8_STAGE(PG8_SB(1, 0), b3, voffB);
            PG8_BAR; PG8_WAIT_L(0); PG8_MMA(0, 1, At, B1); PG8_BAR;
            PG8_LDA(At, 1, 1); PG8_STAGE(PG8_SA(1, 0), a3, voffA);
            PG8_BAR; PG8_WAIT_L(0); PG8_MMA(1, 0, At, B0); PG8_BAR; PG8_SCHED;
            PG8_STAGE(PG8_SB(1, 1), b3 + hstep, voffB);
            PG8_WAIT_V(6); PG8_BAR; PG8_MMA(1, 1, At, B1); PG8_BAR;
            }
        }
        if constexpr (ALIGN_EPI) { if (wr == 0) PG8_BAR; }
        if constexpr (!Epi::AFTER_DRAIN) { E(acc, cur, wr, wc, fr, fq); S.done(cur); }
        if (!has_next) break;
#pragma unroll
        for (int a = 0; a < 2; ++a)
#pragma unroll
            for (int b = 0; b < 2; ++b)
#pragma unroll
                for (int m = 0; m < 4; ++m)
#pragma unroll
                    for (int n = 0; n < 2; ++n) acc[a][b][m][n] = (f32x4){0.f, 0.f, 0.f, 0.f};
        cur = nxt; cA = nA; cB = nB; ++ui;
        if constexpr (ALIGN_EPI) { if (wr == 1) PG8_BAR; }
    }
    PG8_WAIT_V(0);
    if constexpr (!ALIGN_EPI) { if (wr == 0) PG8_BAR; }
    PG8_BAR;
    if constexpr (Epi::AFTER_DRAIN) { E.fused(acc, cur, wr, wc, fr, fq, lds, wid, lane); S.done(cur); }
#undef PG8_SA
#undef PG8_SB
#undef PG8_STAGE
#undef PG8_LDA
#undef PG8_LDB
#undef PG8_MMA
#undef PG8_WAIT_V
#undef PG8_WAIT_L
#undef PG8_BAR
#undef PG8_SCHED
}
}

#ifndef PG8_SP2
#define PG8_SP2 true
#endif
#ifndef PG8_ALIGN
#define PG8_ALIGN true
#endif
namespace pg8 {
__device__ __forceinline__ float gelu1(float v) {
    const float av = __builtin_fabsf(v), t = __builtin_amdgcn_rcpf(av * 0.2316418882f + 1.0f);
    float q = t * 0.5307027145f + (-0.7265760135f); q = q * t + 0.7107068705f; q = q * t + (-0.142248368f); q = q * t + 0.127414796f; q = q * t;
    const float e = __builtin_amdgcn_exp2f((v * v) * (-0.72134752044f));
    const float m = v * (q * e), r = v - m; return v < 0.f ? m : r;
}
struct EpiInProj {
    static constexpr bool PERM = true, AFTER_DRAIN = false;
    bf16_t *QA, *KA, *VA, *QG, *KG, *VG, *GG; float* LOGA; const float* bgate; float qscale;
    __device__ __forceinline__ void operator()(f32x4 (&acc)[2][2][4][2], const Unit& u, int wr, int wc, int fr, int fq) const {
        const int pn = u.pn; const int row0 = u.pm * BM + wr * 64 + fr;
        if (pn < 12) {
            bf16_t* base; int ldc, colt; float sc = 1.f;
            if (pn < 2) { base = QA; ldc = 512; colt = pn * 256; sc = qscale; }
            else if (pn < 4) { base = KA; ldc = 512; colt = (pn - 2) * 256; }
            else if (pn < 6) { base = VA; ldc = 512; colt = (pn - 4) * 256; }
            else if (pn == 6) { base = QG; ldc = 256; colt = 0; }
            else if (pn == 7) { base = KG; ldc = 256; colt = 0; }
            else if (pn < 10) { base = VG; ldc = 512; colt = (pn - 8) * 256; }
            else { base = GG; ldc = 512; colt = (pn - 10) * 256; }
            const int col0 = colt + wc * 32 + 8 * fq;
#pragma unroll
            for (int ai = 0; ai < 2; ++ai)
#pragma unroll
                for (int m = 0; m < 4; ++m) { bf16_t* rowp = base + (size_t)(row0 + ai * HALF + m * 16) * ldc + col0;
#pragma unroll
                    for (int bj = 0; bj < 2; ++bj) { const f32x4 v0 = acc[ai][bj][m][0] * sc, v1 = acc[ai][bj][m][1] * sc;
                        u32x4 w; w.x = cvt_pk_bf16(v0[0], v0[1]); w.y = cvt_pk_bf16(v0[2], v0[3]); w.z = cvt_pk_bf16(v1[0], v1[1]); w.w = cvt_pk_bf16(v1[2], v1[3]);
                        *(u32x4*)(rowp + bj * HALF) = w; } }
        } else {
            const int col0 = wc * 32 + 8 * fq;
            f32x4 bv[2][2];
#pragma unroll
            for (int bj = 0; bj < 2; ++bj)
#pragma unroll
                for (int n = 0; n < 2; ++n) bv[bj][n] = *(const f32x4*)(bgate + col0 + bj * HALF + 4 * n);
#pragma unroll
            for (int ai = 0; ai < 2; ++ai)
#pragma unroll
                for (int m = 0; m < 4; ++m) { float* rowp = LOGA + (size_t)(row0 + ai * HALF + m * 16) * 256 + col0;
#pragma unroll
                    for (int bj = 0; bj < 2; ++bj)
#pragma unroll
                        for (int n = 0; n < 2; ++n) { const f32x4 z = acc[ai][bj][m][n] + bv[bj][n]; f32x4 la;
#pragma unroll
                            for (int j = 0; j < 4; ++j) la[j] = (__builtin_fminf(z[j], 0.f) - __logf(1.0f + __expf(-__builtin_fabsf(z[j])))) * 0.0625f;
                            *(f32x4*)(rowp + bj * HALF + 4 * n) = la; } }
        }
    }
};
struct EpiConvGlu {
    static constexpr bool PERM = true, AFTER_DRAIN = false;
    bf16_t* ACT; const float* bup; const float* cw; const float* cb; float* HALO; float* FIXS; float* FIXV; PG8_LAS float* H;
    __device__ __forceinline__ void operator()(f32x4 (&acc)[2][2][4][2], const Unit& u, int wr, int wc, int fr, int fq) const {
        constexpr int FFD = 2816; typedef unsigned u32x2 __attribute__((ext_vector_type(2)));
        const int lane = fr + 16 * fq, chl = wc * 32 + 8 * fq, ch0 = u.pn * 128 + chl;
        {   f32x4 bv[2], bg[2];
#pragma unroll
            for (int n = 0; n < 2; ++n) { bv[n] = *(const f32x4*)(bup + ch0 + 4 * n); bg[n] = *(const f32x4*)(bup + FFD + ch0 + 4 * n); }
#pragma unroll
            for (int ai = 0; ai < 2; ++ai)
#pragma unroll
                for (int m = 0; m < 4; ++m)
#pragma unroll
                    for (int n = 0; n < 2; ++n) { acc[ai][1][m][n] += bg[n]; acc[ai][0][m][n] += bv[n]; } }
        if (fr >= 14) {
#pragma unroll
            for (int ai = 0; ai < 2; ++ai) { const int bnd = 2 * ai + wr + 1;
#pragma unroll
                for (int n = 0; n < 2; ++n) {
                    if (bnd < 4) *(PG8_LAS f32x4*)(H + (bnd * 2 + (fr - 14)) * 128 + chl + 4 * n) = acc[ai][1][3][n];
                    else *(f32x4*)(HALO + ((size_t)u.pm * 2 + (fr - 14)) * FFD + ch0 + 4 * n) = acc[ai][1][3][n]; } }
        }
        asm volatile("s_waitcnt lgkmcnt(0)" ::: "memory"); __builtin_amdgcn_s_barrier(); asm volatile("" ::: "memory");
        const int l1 = (lane & 48) | ((fr + 15) & 15), l2 = (lane & 48) | ((fr + 14) & 15), l14 = (lane & 48) | 14, l15 = (lane & 48) | 15;
#pragma unroll
        for (int n = 0; n < 2; ++n) {
            const f32x4 w0 = *(const f32x4*)(cw + ch0 + 4 * n), w1 = *(const f32x4*)(cw + FFD + ch0 + 4 * n), w2 = *(const f32x4*)(cw + 2 * FFD + ch0 + 4 * n), cbv = *(const f32x4*)(cb + ch0 + 4 * n);
#pragma unroll
            for (int ai = 0; ai < 2; ++ai)
#pragma unroll
                for (int m = 0; m < 4; ++m) {
                    f32x4 p14, p15;
                    if (m == 0) { const int bnd = 2 * ai + wr;
                        if (bnd == 0) { p14 = (f32x4){0.f, 0.f, 0.f, 0.f}; p15 = p14; }
                        else { p14 = *(const PG8_LAS f32x4*)(H + (bnd * 2 + 0) * 128 + chl + 4 * n); p15 = *(const PG8_LAS f32x4*)(H + (bnd * 2 + 1) * 128 + chl + 4 * n); }
                    } else {
#pragma unroll
                        for (int j = 0; j < 4; ++j) { p14[j] = __shfl(acc[ai][1][m - 1][n][j], l14); p15[j] = __shfl(acc[ai][1][m - 1][n][j], l15); }
                    }
                    const size_t row = (size_t)u.pm * BM + ai * HALF + wr * 64 + m * 16 + fr;
                    const f32x4 cur = acc[ai][1][m][n]; f32x4 s1, s2;
#pragma unroll
                    for (int j = 0; j < 4; ++j) { s1[j] = __shfl(cur[j], l1); s2[j] = __shfl(cur[j], l2); }
                    const f32x4 pr1 = (fr == 0) ? p15 : s1, pr2 = (fr == 0) ? p14 : ((fr == 1) ? p15 : s2);
                    const f32x4 cv = w0 * pr2 + w1 * pr1 + w2 * cur + cbv, hv = acc[ai][0][m][n];
                    const f32x2 ga = gelu_pk((f32x2){cv[0], cv[1]}), gb = gelu_pk((f32x2){cv[2], cv[3]});
                    u32x2 w; w.x = cvt_pk_bf16(ga.x * hv[0], ga.y * hv[1]); w.y = cvt_pk_bf16(gb.x * hv[2], gb.y * hv[3]);
                    *(u32x2*)(ACT + row * FFD + ch0 + 4 * n) = w;
                    if (ai == 0 && m == 0) { if (wr == 0 && fr < 2) { *(f32x4*)(FIXS + ((size_t)u.pm * 2 + fr) * FFD + ch0 + 4 * n) = cv; *(f32x4*)(FIXV + ((size_t)u.pm * 2 + fr) * FFD + ch0 + 4 * n) = hv; } }
                }
        }
    }
};
}
#include <hip/hip_bf16.h>
#include <cmath>
namespace attn_body {
using bf16=__hip_bfloat16;
using bf16x8=__attribute__((ext_vector_type(8)))short;
using s16x4=__attribute__((ext_vector_type(4)))short;
using f32x16=__attribute__((ext_vector_type(16)))float;
using u32x4=__attribute__((ext_vector_type(4)))unsigned;
using f32x4_t=__attribute__((ext_vector_type(4)))float;
constexpr int BATCH=8,NHEAD=8,SEQ=4096,D=64,DM=NHEAD*D,ODM=1024;
constexpr int NW=8,QBLK=32,QB=QBLK*NW,KVBLK=64,NQB=SEQ/QB;
constexpr int ATTN_UNIT_ROWS=QB;
__device__ __forceinline__ int crow(int r,int hi){return (r&3)+8*(r>>2)+4*hi;}
#define SBAR() __builtin_amdgcn_sched_barrier(0)
__device__ __forceinline__ void cmask(f32x16&p0,f32x16&p1,int jb,int qrel,int hi){
  const float NEG=-INFINITY; int kb=64*jb+4*hi;
  #pragma unroll
  for(int r=0;r<16;++r){int kv=kb+(r&3)+8*(r>>2); if(kv>qrel)p0[r]=NEG; if(kv+32>qrel)p1[r]=NEG;}
}

constexpr int NSLOT=3, SLOTB=8192;
constexpr int LDS_K=0, LDS_V=NSLOT*SLOTB, LDS_WS=2*NSLOT*SLOTB, LDS_OST=LDS_WS+NW*64*4, LDS_KM=LDS_OST+NW*8192, LDS_BYTES=LDS_KM+16*64*4;
constexpr float C2=0.125f*1.4426950408889634f;
__device__ __forceinline__ void glds16(const void*gsrc,unsigned lds_dst){unsigned keep;
  asm volatile("s_mov_b32 %0, m0\n\ts_mov_b32 m0, %2\n\ts_nop 0\n\tglobal_load_lds_dwordx4 %1, off\n\ts_mov_b32 m0, %0":"=&s"(keep):"v"(gsrc),"s"(lds_dst):"memory");}
__device__ __forceinline__ float max3f(float a,float b,float c){float r;asm("v_max3_f32 %0, %1, %2, %3":"=v"(r):"v"(a),"v"(b),"v"(c));return r;}
__device__ __forceinline__ float max2f(float a,float b){float r;asm("v_max_f32_e32 %0, %1, %2":"=v"(r):"v"(a),"v"(b));return r;}
__device__ __forceinline__ float fadd_s(float a,float b){float r;asm("v_add_f32_e32 %0, %1, %2":"=v"(r):"v"(a),"v"(b));return r;}
__device__ __forceinline__ float fsub_s(float a,float b){float r;asm("v_sub_f32_e32 %0, %1, %2":"=v"(r):"v"(a),"v"(b));return r;}
typedef float f32x2_t __attribute__((ext_vector_type(2))); typedef __bf16 bf16x2_t __attribute__((ext_vector_type(2)));
__device__ __forceinline__ unsigned cvtpk_s(float lo,float hi){f32x2_t v={lo,hi};bf16x2_t b=__builtin_convertvector(v,bf16x2_t);return __builtin_bit_cast(unsigned,b);}
#define WAIT_BAR(N) asm volatile("s_waitcnt vmcnt(" #N ") lgkmcnt(0)\n\ts_barrier":::"memory")

__device__ __forceinline__ void qkt(f32x16&p0,f32x16&p1,const char*Kslot,const bf16x8*qr,const f32x16&negm,int r32,int hi){
  const char*kb=Kslot+hi*1024+r32*16;
  #pragma unroll
  for(int d0=0;d0<4;++d0){
    const bf16x8 b0=*reinterpret_cast<const bf16x8*>(kb+d0*2048);
    const bf16x8 b1=*reinterpret_cast<const bf16x8*>(kb+d0*2048+512);
    if(d0==0){p0=__builtin_amdgcn_mfma_f32_32x32x16_bf16(b0,qr[0],negm,0,0,0);p1=__builtin_amdgcn_mfma_f32_32x32x16_bf16(b1,qr[0],negm,0,0,0);}
    else{p0=__builtin_amdgcn_mfma_f32_32x32x16_bf16(b0,qr[d0],p0,0,0,0);p1=__builtin_amdgcn_mfma_f32_32x32x16_bf16(b1,qr[d0],p1,0,0,0);}}
}
typedef __attribute__((address_space(3))) const char* lds_cptr;
typedef short v4i16_t __attribute__((ext_vector_type(4)));
__device__ __forceinline__ void kload8(bf16x8*kf,lds_cptr kp){
  kf[0]=*(const __attribute__((address_space(3))) bf16x8*)(kp);      kf[1]=*(const __attribute__((address_space(3))) bf16x8*)(kp+512);
  kf[2]=*(const __attribute__((address_space(3))) bf16x8*)(kp+2048); kf[3]=*(const __attribute__((address_space(3))) bf16x8*)(kp+2560);
  kf[4]=*(const __attribute__((address_space(3))) bf16x8*)(kp+4096); kf[5]=*(const __attribute__((address_space(3))) bf16x8*)(kp+4608);
  kf[6]=*(const __attribute__((address_space(3))) bf16x8*)(kp+6144); kf[7]=*(const __attribute__((address_space(3))) bf16x8*)(kp+6656);
}
__device__ __forceinline__ void kload2(bf16x8*kf,lds_cptr kp,int j){ kf[2*j]=*(const __attribute__((address_space(3))) bf16x8*)(kp+j*2048); kf[2*j+1]=*(const __attribute__((address_space(3))) bf16x8*)(kp+j*2048+512); }
__device__ __forceinline__ s16x4 vtr(lds_cptr p){ return __builtin_bit_cast(s16x4,__builtin_amdgcn_ds_read_tr16_b64_v4i16((__attribute__((address_space(3))) v4i16_t*)p)); }
__device__ __forceinline__ float rowmax(const f32x16&p0,const f32x16&p1){
  float a=max3f(p0[0],p0[1],p1[0]),b=max3f(p0[2],p0[3],p1[1]);a=max3f(a,p1[2],p1[3]);
  #pragma unroll
  for(int r=4;r<16;r+=4){a=max3f(a,p0[r],p0[r+1]);b=max3f(b,p0[r+2],p0[r+3]);a=max3f(a,p1[r],p1[r+1]);b=max3f(b,p1[r+2],p1[r+3]);}
  const float m=max2f(a,b);
  auto rr=__builtin_amdgcn_permlane32_swap(__float_as_uint(m),__float_as_uint(m),false,false);
  return max2f(__uint_as_float(rr[0]),__uint_as_float(rr[1]));
}
__device__ __forceinline__ void pv(f32x16*o,int vb,bf16x8 pa0,bf16x8 pa1,bf16x8 pa2,bf16x8 pa3){
  #pragma unroll
  for(int d0=0;d0<2;++d0){s16x4 lo[4],hi[4];
    #pragma unroll
    for(int ks=0;ks<4;++ks){
      asm volatile("ds_read_b64_tr_b16 %0,%1 offset:%c2":"=&v"(lo[ks]):"v"(vb),"i"(d0*4096+ks*1024):"memory");
      asm volatile("ds_read_b64_tr_b16 %0,%1 offset:%c2":"=&v"(hi[ks]):"v"(vb),"i"(d0*4096+ks*1024+512):"memory");}
    asm volatile("s_waitcnt lgkmcnt(0)":::"memory");SBAR();
    #define PK(k) (bf16x8){lo[k][0],lo[k][1],lo[k][2],lo[k][3],hi[k][0],hi[k][1],hi[k][2],hi[k][3]}
    o[d0]=__builtin_amdgcn_mfma_f32_32x32x16_bf16(pa0,PK(0),o[d0],0,0,0);
    o[d0]=__builtin_amdgcn_mfma_f32_32x32x16_bf16(pa1,PK(1),o[d0],0,0,0);
    o[d0]=__builtin_amdgcn_mfma_f32_32x32x16_bf16(pa2,PK(2),o[d0],0,0,0);
    o[d0]=__builtin_amdgcn_mfma_f32_32x32x16_bf16(pa3,PK(3),o[d0],0,0,0);
    #undef PK
  }
}

#ifndef ATTN_STORE16
#define ATTN_STORE16(p,v) (*(u32x4*)(p)=(v))
#endif
template<int THRL> __device__ __forceinline__ void attn_unit(int b,int h,int qb,const bf16*Q,const bf16* K,const bf16* V,bf16*O,const float*KMEAN,const float*GN,char*shm){
  int tid=threadIdx.x; asm volatile("":"+v"(tid));
  const int lane=tid&63,r32=lane&31,hi=lane>>5; const int wid=__builtin_amdgcn_readfirstlane(tid>>6);
  const long rowbase=(long)b*SEQ; const int q0=qb*QB;
  const bf16*Qw=Q+(rowbase+q0+wid*QBLK)*DM+h*D;
  const bf16*Kh=K+rowbase*DM+h*D,*Vh=V+rowbase*DM+h*D;
  const unsigned lds0=(unsigned)(uintptr_t)shm;
  float*kmf=(float*)(shm+LDS_KM);
  float*wsf=(float*)(shm+LDS_WS)+wid*64;
  const bf16*ksrc=Kh+(long)lane*DM+wid*8;
  const bf16*vsrc=Vh+(long)(16*(wid&3)+(lane>>2))*DM+(wid>>2)*32+(lane&3)*8;
  const unsigned kdst=lds0+LDS_K+wid*1024, vdst=lds0+LDS_V+wid*1024;
  #define DMA_K(t,slot) glds16(ksrc+(long)(t)*KVBLK*DM,(unsigned)__builtin_amdgcn_readfirstlane(kdst+(slot)))
  #define DMA_V(t,slot) glds16(vsrc+(long)(t)*KVBLK*DM,(unsigned)__builtin_amdgcn_readfirstlane(vdst+(slot)))
  const int vb0=(int)(lds0+LDS_V)+((lane>>4)&1)*32+(lane&3)*8+(4*hi+((lane&15)>>2))*64;
  const char*Kbase=shm+LDS_K; bf16x8 kf[8];
  const lds_cptr shm3=(lds_cptr)shm; const lds_cptr kp0=shm3+LDS_K+hi*1024+r32*16; const lds_cptr vp0=shm3+LDS_V+((lane>>4)&1)*32+(lane&3)*8+(4*hi+((lane&15)>>2))*64;
  const int NT=(q0+QB)/KVBLK;
  { const float*kmg=KMEAN+(long)(b*NHEAD+h)*16*64; for(int i=tid;i<16*64;i+=NW*64)kmf[i]=kmg[i]; }
  __syncthreads();
  DMA_K(0,0);DMA_V(0,0);DMA_K(1,SLOTB);
  bf16x8 qr[4];
  #pragma unroll
  for(int d0=0;d0<4;++d0)qr[d0]=*reinterpret_cast<const bf16x8*>(&Qw[(long)r32*DM+d0*16+hi*8]);
  unsigned selmask=1u<<qb;
  { float qf[32];
    #pragma unroll
    for(int d0=0;d0<4;++d0){
      #pragma unroll
      for(int j=0;j<8;++j)qf[d0*8+j]=__uint_as_float(((unsigned)(unsigned short)qr[d0][j])<<16);}
    float sc[15];
    #pragma unroll
    for(int n=0;n<15;++n){ float a=-INFINITY;
      if(n<qb){ a=0.f;
        #pragma unroll
        for(int d0=0;d0<4;++d0){ const f32x4_t k0=*(const f32x4_t*)(kmf+n*64+d0*16+hi*8), k1=*(const f32x4_t*)(kmf+n*64+d0*16+hi*8+4);
          a+=qf[d0*8+0]*k0[0]; a+=qf[d0*8+1]*k0[1]; a+=qf[d0*8+2]*k0[2]; a+=qf[d0*8+3]*k0[3];
          a+=qf[d0*8+4]*k1[0]; a+=qf[d0*8+5]*k1[1]; a+=qf[d0*8+6]*k1[2]; a+=qf[d0*8+7]*k1[3]; }
        a+=__shfl_xor(a,32); }
      sc[n]=a; }
    #pragma unroll
    for(int k=0;k<3;++k){ if(k<qb){ float best=-INFINITY; int bi=0;
        #pragma unroll
        for(int n=0;n<15;++n){ const bool ok=(n<qb)&&!((selmask>>n)&1u)&&(sc[n]>best); best=ok?sc[n]:best; bi=ok?n:bi; }
        selmask|=1u<<bi; } } }
  float mhat=0.f,l_reg=0.f;f32x16 o[2];o[0]=f32x16{};o[1]=f32x16{};
  #define CINIT(t,C0,C1) { const float cv_=((selmask>>((t)>>2))&1u)?-mhat:-1e30f; _Pragma("unroll") for(int r=0;r<16;++r){C0[r]=cv_;C1[r]=cv_;} } asm volatile("":"+v"(C0),"+v"(C1));
  selmask|=(unsigned)(wid*QBLK+r32)<<16;
  #define qrel ((int)(selmask>>16))
  #define CMASK(P0,P1,t) do{int jb_=(t)-(NT-4); if(jb_>=0)cmask(P0,P1,jb_,qrel,hi);}while(0)
  bool resc=false;
  #define START(P0,P1) do{ const float rm=rowmax(P0,P1); resc=false; \
    { const float dl=(rm<-1e29f)?0.f:rm; mhat=fadd_s(mhat,dl);     \
      _Pragma("unroll") for(int r=0;r<16;++r){P0[r]=fsub_s(P0[r],dl);P1[r]=fsub_s(P1[r],dl);} } \
    _Pragma("unroll") for(int r=0;r<16;++r)P0[r]=__builtin_amdgcn_exp2f(P0[r]); }while(0)
  #define RESC() do{ if(resc){ asm volatile("s_waitcnt lgkmcnt(0)":::"memory"); \
      _Pragma("unroll") for(int d_=0;d_<2;++d_) _Pragma("unroll") for(int r=0;r<16;++r)o[d_][r]*=wsf[crow(r,hi)]; } }while(0)
  f32x16 pA0,pA1,pB0,pB1;
  int sl_prev=0,sl_cur=0,sl_next=SLOTB;
  #define ROT() do{sl_prev=sl_cur;sl_cur=sl_next;sl_next=(sl_next==(NSLOT-1)*SLOTB)?0:sl_next+SLOTB;}while(0)
  DMA_K(2,2*SLOTB);
  WAIT_BAR(3);
  { f32x16 cA_,cB_; CINIT(0,cA_,cB_); qkt(pA0,pA1,Kbase,qr,cA_,r32,hi); } asm volatile("s_nop 15\n\ts_nop 7":"+v"(pA0),"+v"(pA1));CMASK(pA0,pA1,0);
  START(pA0,pA1);
  _Pragma("unroll") for(int r=0;r<16;++r)pA1[r]=__builtin_amdgcn_exp2f(pA1[r]);
  WAIT_BAR(0);
  DMA_K(3,0);DMA_V(1,SLOTB);
  ROT();
  kload8(kf,kp0+sl_cur);
  WAIT_BAR(2);
  s16x4 vlo[8],vhi[8]; u32x4 pw0,pw1,pw2,pw3;
  #define PKW(P,B) cvtpk_s(P[B],P[B+1])
  #define PAF(k) __builtin_bit_cast(bf16x8,pw##k)
  #define VFR(i) (bf16x8){vlo[i][0],vlo[i][1],vlo[i][2],vlo[i][3],vhi[i][0],vhi[i][1],vhi[i][2],vhi[i][3]}
  #define PIN(x) asm volatile("":"+v"(x))
  #define MX3(a,b,c) __builtin_fmaxf(__builtin_fmaxf((a),(b)),(c))
  #define GAPA(MF,A0,A1,A2,A3,W0,W1,PW) do{ MF; sacc+=A0; sacc+=A1; sacc+=A2; sacc+=A3; PIN(sacc); W0; W1; PIN(PW); SBAR(); }while(0)
  #define EX(v) __builtin_amdgcn_exp2f(v)
  #define GAPB(MF,X,B) do{ MF; X[B]=EX(X[B]); X[B+1]=EX(X[B+1]); X[B+2]=EX(X[B+2]); X[B+3]=EX(X[B+3]); PIN(X); SBAR(); }while(0)
  #define VRD(i) do{ vlo[i]=vtr(vp_+(((i)>>2)*4096+((i)&3)*1024)); vhi[i]=vtr(vp_+(((i)>>2)*4096+((i)&3)*1024+512)); }while(0)
  #define KRD(G,j) do{ if(G){ kload2(kf,kp0+sl_next,j); SBAR(); } }while(0)
  #define STEP(C0,C1,P0,P1,t,GK,GV,GL) do{ SBAR(); \
    CINIT(t,C0,C1); SBAR(); \
    const lds_cptr vp_=vp0+sl_prev; \
    VRD(0); SBAR(); float sacc=(P0[0]+P0[1]); \
    GAPA(C0=__builtin_amdgcn_mfma_f32_32x32x16_bf16(kf[0],qr[0],C0,0,0,0), P0[2],P0[3],P0[4],P0[5],     pw0[0]=PKW(P0,0), pw0[1]=PKW(P0,2), pw0); \
    VRD(4); SBAR(); GAPA(C1=__builtin_amdgcn_mfma_f32_32x32x16_bf16(kf[1],qr[0],C1,0,0,0), P0[6],P0[7],P0[8],P0[9],     pw0[2]=PKW(P0,4), pw0[3]=PKW(P0,6), pw0); \
    VRD(1); SBAR(); GAPA(C0=__builtin_amdgcn_mfma_f32_32x32x16_bf16(kf[2],qr[1],C0,0,0,0),   P0[10],P0[11],P0[12],P0[13], pw1[0]=PKW(P0,8), pw1[1]=PKW(P0,10), pw1); \
    VRD(5); SBAR(); GAPA(C1=__builtin_amdgcn_mfma_f32_32x32x16_bf16(kf[3],qr[1],C1,0,0,0),   P0[14],P0[15],P1[0],P1[1],   pw1[2]=PKW(P0,12),pw1[3]=PKW(P0,14), pw1); \
    VRD(2); SBAR(); GAPA(C0=__builtin_amdgcn_mfma_f32_32x32x16_bf16(kf[4],qr[2],C0,0,0,0),   P1[2],P1[3],P1[4],P1[5],     pw2[0]=PKW(P1,0), pw2[1]=PKW(P1,2), pw2); \
    VRD(6); SBAR(); GAPA(C1=__builtin_amdgcn_mfma_f32_32x32x16_bf16(kf[5],qr[2],C1,0,0,0),   P1[6],P1[7],P1[8],P1[9],     pw2[2]=PKW(P1,4), pw2[3]=PKW(P1,6), pw2); \
    VRD(3); SBAR(); GAPA(C0=__builtin_amdgcn_mfma_f32_32x32x16_bf16(kf[6],qr[3],C0,0,0,0),   P1[10],P1[11],P1[12],P1[13], pw3[0]=PKW(P1,8), pw3[1]=PKW(P1,10), pw3); \
    VRD(7); SBAR(); GAPA(C1=__builtin_amdgcn_mfma_f32_32x32x16_bf16(kf[7],qr[3],C1,0,0,0),   P1[14],P1[15],0.f,0.f,       pw3[2]=PKW(P1,12),pw3[3]=PKW(P1,14), pw3); \
    l_reg+=sacc; \
    if(GK){DMA_K((t)+3,sl_cur);} if(GV){DMA_V((t)+1,sl_next);} \
    CMASK(C0,C1,t); \
    { float a=MX3(C0[0],C0[1],C1[0]),b=MX3(C0[2],C0[3],C1[1]); a=MX3(a,C1[2],C1[3]); \
      _Pragma("unroll") for(int r=4;r<16;r+=4){a=MX3(a,C0[r],C0[r+1]);b=MX3(b,C0[r+2],C0[r+3]);a=MX3(a,C1[r],C1[r+1]);b=MX3(b,C1[r+2],C1[r+3]);} \
      float rm=__builtin_fmaxf(a,b); { auto rr=__builtin_amdgcn_permlane32_swap(__float_as_uint(rm),__float_as_uint(rm),false,false); rm=__builtin_fmaxf(__uint_as_float(rr[0]),__uint_as_float(rr[1])); } \
      resc=false; \
      if(__builtin_expect(__any(rm>(float)THRL),0)){ const float dl=__builtin_fmaxf(rm,0.f); mhat+=dl; \
        _Pragma("unroll") for(int r=0;r<16;++r){C0[r]-=dl;C1[r]-=dl;} \
        const float f=__builtin_amdgcn_exp2f(-dl); l_reg*=f; if(hi==0)wsf[r32]=f; resc=true; } } \
    SBAR(); \
    GAPB(o[0]=__builtin_amdgcn_mfma_f32_32x32x16_bf16(PAF(0),VFR(0),o[0],0,0,0), C0,0); \
    GAPB(o[1]=__builtin_amdgcn_mfma_f32_32x32x16_bf16(PAF(0),VFR(4),o[1],0,0,0), C0,4); \
    KRD(GL,0); GAPB(o[0]=__builtin_amdgcn_mfma_f32_32x32x16_bf16(PAF(1),VFR(1),o[0],0,0,0), C0,8); \
    KRD(GL,1); GAPB(o[1]=__builtin_amdgcn_mfma_f32_32x32x16_bf16(PAF(1),VFR(5),o[1],0,0,0), C0,12); \
    KRD(GL,2); GAPB(o[0]=__builtin_amdgcn_mfma_f32_32x32x16_bf16(PAF(2),VFR(2),o[0],0,0,0), C1,0); \
    KRD(GL,3); GAPB(o[1]=__builtin_amdgcn_mfma_f32_32x32x16_bf16(PAF(2),VFR(6),o[1],0,0,0), C1,4); \
    GAPB(o[0]=__builtin_amdgcn_mfma_f32_32x32x16_bf16(PAF(3),VFR(3),o[0],0,0,0), C1,8); \
    GAPB(o[1]=__builtin_amdgcn_mfma_f32_32x32x16_bf16(PAF(3),VFR(7),o[1],0,0,0), C1,12); \
    }while(0)
  int t=1;
  #undef CMASK
  #define CMASK(P0,P1,t) do{}while(0)
  for(;t+5<NT;t+=2){
    STEP(pB0,pB1,pA0,pA1,t,true,true,true);     WAIT_BAR(2); RESC(); ROT();
    STEP(pA0,pA1,pB0,pB1,t+1,true,true,true);   WAIT_BAR(2); RESC(); ROT();
  }
  #undef CMASK
  #define CMASK(P0,P1,t) do{int jb_=(t)-(NT-4); if(jb_>=0)cmask(P0,P1,jb_,qrel,hi);}while(0)
  #define ENDW(tt) do{ if((tt)+3<NT){WAIT_BAR(2);} else if((tt)+2<NT){WAIT_BAR(1);} else {WAIT_BAR(0);} }while(0)
  for(;t+1<NT;t+=2){
    STEP(pB0,pB1,pA0,pA1,t,(t+3<NT),(t+1<NT),(t+1<NT));       ENDW(t);   RESC(); ROT();
    STEP(pA0,pA1,pB0,pB1,t+1,(t+4<NT),(t+2<NT),(t+2<NT));     ENDW(t+1); RESC(); ROT();
  }
  STEP(pB0,pB1,pA0,pA1,NT-1,false,false,false); RESC();
  { float sacc=pB0[0]+pB0[1]; _Pragma("unroll") for(int r=2;r<16;++r)sacc+=pB0[r]; _Pragma("unroll") for(int r=0;r<16;++r)sacc+=pB1[r]; l_reg+=sacc;
    pw0=(u32x4){PKW(pB0,0),PKW(pB0,2),PKW(pB0,4),PKW(pB0,6)};pw1=(u32x4){PKW(pB0,8),PKW(pB0,10),PKW(pB0,12),PKW(pB0,14)};pw2=(u32x4){PKW(pB1,0),PKW(pB1,2),PKW(pB1,4),PKW(pB1,6)};pw3=(u32x4){PKW(pB1,8),PKW(pB1,10),PKW(pB1,12),PKW(pB1,14)};
    SBAR(); pv(o,vb0+sl_cur,PAF(0),PAF(1),PAF(2),PAF(3)); }
  #undef PKW
  #undef PAF
  #undef VFR
  #undef PIN
  #undef MX3
  #undef GAPA
  #undef GAPB
  #undef EX
  #undef VRD
  #undef KRD
  #undef STEP
  #undef ENDW
  {auto rr=__builtin_amdgcn_permlane32_swap(__float_as_uint(l_reg),__float_as_uint(l_reg),false,false);l_reg=__uint_as_float(rr[0])+__uint_as_float(rr[1]);}
  if(hi==0)wsf[32+r32]=l_reg;asm volatile("s_waitcnt lgkmcnt(0)":::"memory");
  float rli[16];
  #pragma unroll
  for(int r=0;r<16;++r)rli[r]=__builtin_amdgcn_rcpf(wsf[32+crow(r,hi)]);
  bf16*Ow=O+(rowbase+q0+wid*QBLK)*ODM+h*D;
  { float*stg=(float*)(shm+LDS_OST)+wid*2048;
    #pragma unroll
    for(int r=0;r<16;++r){const int orow=crow(r,hi);
      #pragma unroll
      for(int d0=0;d0<2;++d0)stg[orow*64+d0*32+r32]=o[d0][r]*rli[r];}
    asm volatile("s_waitcnt lgkmcnt(0)":::"memory");
    const int ch=lane&7; const f32x4_t g0=*(const f32x4_t*)(GN+h*D+ch*8), g1=*(const f32x4_t*)(GN+h*D+ch*8+4);
    #pragma unroll
    for(int i=0;i<4;++i){const int row=i*8+(lane>>3); f32x4_t a=*(const f32x4_t*)(stg+row*64+ch*8), c=*(const f32x4_t*)(stg+row*64+ch*8+4);
      float ss=(a[0]*a[0]+a[1]*a[1])+(a[2]*a[2]+a[3]*a[3])+(c[0]*c[0]+c[1]*c[1])+(c[2]*c[2]+c[3]*c[3]);
      ss+=__shfl_xor(ss,1); ss+=__shfl_xor(ss,2); ss+=__shfl_xor(ss,4);
      const float rs=1.0f/sqrtf(ss*(1.0f/64.0f)+1e-5f); a=a*rs*g0; c=c*rs*g1;
      u32x4 v; v[0]=cvtpk_s(a[0],a[1]); v[1]=cvtpk_s(a[2],a[3]); v[2]=cvtpk_s(c[0],c[1]); v[3]=cvtpk_s(c[2],c[3]);
      ATTN_STORE16(Ow+(long)row*ODM+ch*8,v);} }
  asm volatile("s_waitcnt lgkmcnt(0)\n\ts_barrier":::"memory");
  #undef DMA_K
  #undef DMA_V
  #undef CMASK
  #undef START
  #undef RESC
  #undef ROT
  #undef CINIT
  #undef qrel
}
constexpr int ATTN_LDS_BYTES=LDS_BYTES;
struct AttnTensors { const bf16* Q; const bf16* K; const bf16* V; bf16* O; const float* KMEAN; const float* GN; };
struct AttnUnit { int bh; int qb; };
struct StaticOrder {
  int vcu;
  __device__ __forceinline__ explicit StaticOrder(int grid,int block):vcu((block%8)*(grid/8)+block/8){}
  __device__ __forceinline__ bool next(int i,AttnUnit&u)const{ if(i>=4)return false; const int s=vcu&3; u.bh=vcu>>2; u.qb=(i==0)?s:(i==1)?7-s:(i==2)?8+s:15-s; return true; }
  __device__ __forceinline__ void a_ready(const AttnUnit&)const{}
  __device__ __forceinline__ void done(const AttnUnit&)const{}
};
template<class Sched,int THRL=8> __device__ __forceinline__ void attn_phase(char*lds,const AttnTensors&T,const Sched&S){
  AttnUnit u;
  for(int i=0;S.next(i,u);++i){ S.a_ready(u); attn_unit<THRL>(u.bh/NHEAD,u.bh%NHEAD,u.qb,T.Q,T.K,T.V,T.O,T.KMEAN,T.GN,lds); S.done(u); }
}
#undef SBAR
#undef WAIT_BAR
}
#define GAS __attribute__((address_space(1)))
#define LAS __attribute__((address_space(3)))
typedef unsigned short bf16;
typedef unsigned v4u __attribute__((ext_vector_type(4)));
typedef float f32x4 __attribute__((ext_vector_type(4)));
typedef short bf16x8 __attribute__((ext_vector_type(8)));
typedef GAS unsigned gu32;
typedef GAS unsigned long long gu64;
#define RLX_AGENT __ATOMIC_RELAXED, __HIP_MEMORY_SCOPE_AGENT
#define LDS_WAIT() asm volatile("s_waitcnt lgkmcnt(0)" ::: "memory")
#define VM_WAIT() asm volatile("s_waitcnt vmcnt(0)" ::: "memory")
__device__ __forceinline__ unsigned long long rt() { return __builtin_amdgcn_s_memrealtime(); }
__device__ __forceinline__ unsigned f2bf(float f) { unsigned u = __builtin_bit_cast(unsigned, f); return (u + 0x7fffu + ((u >> 16) & 1u)) >> 16; }
__device__ __forceinline__ unsigned pk2(float lo, float hi) { return f2bf(lo) | (f2bf(hi) << 16); }

#define XB_TMO      128
#define XB_XCNT(j)  (256  + 64 * (j))
#define XB_XSUB(j)  (1280 + 64 * (j))
#define XB_XGEN(j)  (2304 + 64 * (j))
#define XB_TOP      3328
#define XB_TOPGEN   3392
#define XCD_BAR_WORDS 3456
#define XB_SPIN_CAP (1u << 18)

__device__ __forceinline__ unsigned xb_ld(unsigned* p)              { return __hip_atomic_load(p, __ATOMIC_RELAXED, __HIP_MEMORY_SCOPE_AGENT); }
__device__ __forceinline__ unsigned xb_add(unsigned* p, unsigned v) { return __hip_atomic_fetch_add(p, v, __ATOMIC_RELAXED, __HIP_MEMORY_SCOPE_AGENT); }
__device__ __forceinline__ unsigned xb_xcc_id() { return (unsigned)__builtin_amdgcn_s_getreg((3 << 11) | 20) & 0xFu; }
#define XB_SPIN(cond, bar) do { unsigned _sp = 0; while (cond) { __builtin_amdgcn_s_sleep(1); \
    if ((++_sp & 255u) == 0u) { if (xb_ld(&(bar)[XB_TMO])) break; if (_sp > XB_SPIN_CAP) { atomicAdd(&(bar)[XB_TMO], 1u); break; } } } } while (0)

struct XcdBarrier {
    unsigned* bar; unsigned x;
    volatile LAS unsigned* st;
};

__device__ __forceinline__ XcdBarrier xcd_barrier_post(unsigned* bar, volatile LAS unsigned* st) {
    XcdBarrier b; b.bar = bar; b.x = xb_xcc_id(); b.st = st;
    if (threadIdx.x == 0) (void)xb_add(&bar[XB_XCNT(b.x)], 1u);
    return b;
}
__device__ __forceinline__ void xcd_barrier_complete(unsigned* bar, unsigned x, unsigned& nloc, unsigned& nx) {
    const unsigned G = gridDim.x * gridDim.y * gridDim.z;
    unsigned sum, cnt, mine, sp = 0u;
    for (;;) {
        sum = 0u; cnt = 0u; mine = 0u;
#pragma unroll
        for (unsigned j = 0; j < 16; ++j) { const unsigned c = xb_ld(&bar[XB_XCNT(j)]); sum += c; cnt += (c > 0u) ? 1u : 0u; mine = (j == x) ? c : mine; }
        if (sum == G) break;
        __builtin_amdgcn_s_sleep(1);
        if ((++sp & 255u) == 0u) { if (xb_ld(&bar[XB_TMO])) break; if (sp > XB_SPIN_CAP) { atomicAdd(&bar[XB_TMO], 1u); break; } }
    }
    nloc = mine > 0u ? mine : 1u; nx = cnt > 0u ? cnt : 1u;
}

__device__ __forceinline__ void xcd_barrier(const XcdBarrier& b) {
    asm volatile("s_waitcnt vmcnt(0)" ::: "memory");
    __syncthreads();
    if (threadIdx.x == 0) {
        unsigned* bar = b.bar;
        __builtin_amdgcn_s_waitcnt(0);
        unsigned nloc = b.st[0], nx = b.st[1];
        if (nloc == 0u) { xcd_barrier_complete(bar, b.x, nloc, nx); b.st[0] = nloc; b.st[1] = nx; }
        const unsigned old = xb_add(&bar[XB_XSUB(b.x)], 1u);
        const unsigned gen = old / nloc;
        if (old + 1u == (gen + 1u) * nloc) {
            __builtin_amdgcn_fence(__ATOMIC_RELEASE, "agent");
            asm volatile("s_waitcnt vmcnt(0)" ::: "memory");
            const unsigned og = xb_add(&bar[XB_TOP], 1u);
            const unsigned tg = og / nx;
            if (og + 1u == (tg + 1u) * nx) xb_add(&bar[XB_TOPGEN], 1u);
            else XB_SPIN(xb_ld(&bar[XB_TOPGEN]) == tg, bar);
            __builtin_amdgcn_fence(__ATOMIC_ACQUIRE, "agent");
            xb_add(&bar[XB_XGEN(b.x)], 1u);
            asm volatile("s_waitcnt vmcnt(0)" ::: "memory");
        } else {
            XB_SPIN(xb_ld(&bar[XB_XGEN(b.x)]) == gen, bar);
            __builtin_amdgcn_fence(__ATOMIC_ACQUIRE, "agent");
            asm volatile("s_waitcnt vmcnt(0)" ::: "memory");
        }
    }
    __syncthreads();
}

constexpr int NWAVES = 8;
#ifndef MK_N_LAUNCHES
#define MK_N_LAUNCHES 1
#endif
constexpr int N_PHASES = 12;
constexpr int N_LAUNCHES = MK_N_LAUNCHES;
static_assert(N_LAUNCHES == 1 || N_LAUNCHES == N_PHASES, "MK_N_LAUNCHES is 1 or 12");

constexpr int BATCH = 8, SEQ = 4096, D = 1024, M = BATCH * SEQ;
constexpr int AW = 512, GKW = 256, GVW = 512, FF = 2816, INW = 3088;
constexpr int NIN = 3328;
constexpr int NGH = 4, GDK = 64, GDV = 128, GCH = 64, NCH = SEQ / GCH;
constexpr float LN_EPS = 1e-5f, ALPHA = 1.189207115002721f;

constexpr size_t MiB = 1u << 20;
constexpr size_t WS_CTL = 0, CTL_ZERO_BYTES = 1 * MiB;
constexpr size_t WS_MODP = 1 * MiB;
constexpr size_t WS_MOD = 4 * MiB;
constexpr size_t WS_KMEAN = 4 * MiB + 256 * 1024;
constexpr size_t WS_DEC = 4 * MiB + 512 * 1024;
constexpr size_t WS_HALO = 5 * MiB, WS_FIXS = 8 * MiB, WS_FIXV = 11 * MiB;
constexpr size_t WS_WIN = 14 * MiB, WS_WO = 21 * MiB, WS_WUP = 23 * MiB, WS_WDN = 34 * MiB;
constexpr size_t WS_XN = 40 * MiB;
constexpr size_t WS_QA = 104 * MiB, WS_KA = 136 * MiB, WS_VA = 168 * MiB, WS_QG = 200 * MiB, WS_KG = 216 * MiB, WS_VG = 232 * MiB, WS_GG = 264 * MiB, WS_LOGA = 296 * MiB;
constexpr size_t WS_KV = 328 * MiB;
constexpr size_t WS_MIX = 392 * MiB;
constexpr size_t WS_Y1 = 104 * MiB;
constexpr size_t WS_X1 = 328 * MiB;
constexpr size_t WS_ACT = 104 * MiB;
constexpr size_t WS_Y2 = 40 * MiB;
constexpr size_t WS_END = 456 * MiB;
static_assert(WS_X1 + (size_t)M * D * 4 <= WS_END && WS_ACT + (size_t)M * FF * 2 <= WS_X1 && WS_MIX + (size_t)M * D * 2 <= WS_END && WS_LOGA + (size_t)M * 256 * 4 <= WS_KV && WS_WDN + (size_t)D * FF * 2 <= WS_XN, "d_ws map");
constexpr int CW_TMO = 0, CW_CODE = 1;
constexpr int CW_BAR = 4096;

constexpr int RING_OFF = 0, RING_BYTES = 131072;
constexpr int LDSCTL_OFF = RING_BYTES, MISC_OFF = LDSCTL_OFF + 320;
constexpr int HTAB_OFF = 132096;
constexpr int LDS_BYTES = 147456;
static_assert(MISC_OFF + 128 <= HTAB_OFF && HTAB_OFF + 4096 <= LDS_BYTES && attn_body::ATTN_LDS_BYTES <= RING_BYTES, "LDS map");

#define CAS __attribute__((address_space(4)))
struct Args { const float* in[19]; float* out; unsigned char* ws; int ph_lo, ph_hi, li, pad; };
struct Frame {
    LAS unsigned char* lds;
    volatile LAS unsigned* MISC;
    gu32* ctl;
    int tid, lane, wave;
    int vcu, G;
    unsigned char* ws;
    const CAS Args* argp;
};
#define ARG_IN(F, k) ({ const CAS Args* p_ = (F).argp; asm volatile("" : "+s"(p_)); p_->in[k]; })
#define ARG_OUT(F) ({ const CAS Args* p_ = (F).argp; asm volatile("" : "+s"(p_)); p_->out; })
enum { I_X = 0, I_C, I_WADA, I_BADA, I_WIN, I_WGATE, I_BGATE, I_ATTNG, I_GLAG, I_WO, I_LN1G, I_LN1B, I_WUP, I_BUP, I_CONVW, I_CONVB, I_WDOWN, I_LN2G, I_LN2B };
__device__ __forceinline__ float bf2f(unsigned short v) { return __uint_as_float(((unsigned)v) << 16); }
__device__ __forceinline__ float wave_sum(float v) {
#pragma unroll
    for (int o = 1; o < 64; o <<= 1) v += __shfl_xor(v, o);
    return v;
}
__device__ __forceinline__ float silu_f(float v) { return v / (1.0f + __expf(-v)); }

__device__ __forceinline__ void p0_transpose_item(const float* W, int pitch, int k0, int n0, bf16* WT, int Kd, int drow0, LAS float* scr, int lane) {
#pragma unroll 8
    for (int i = 0; i < 32; ++i) { const int kk = 2 * i + (lane >> 5); scr[kk * 33 + (lane & 31)] = W[(size_t)(k0 + kk) * pitch + n0 + (lane & 31)]; }
    LDS_WAIT(); asm volatile("" ::: "memory");
    const int c = lane & 7;
#pragma unroll
    for (int j = 0; j < 4; ++j) { const int n = (lane >> 3) + 8 * j; const LAS float* s = scr + (8 * c) * 33 + n;
        v4u o; o.x = pk2(s[0 * 33], s[1 * 33]); o.y = pk2(s[2 * 33], s[3 * 33]); o.z = pk2(s[4 * 33], s[5 * 33]); o.w = pk2(s[6 * 33], s[7 * 33]);
        *(GAS v4u*)(WT + (size_t)(drow0 + n) * Kd + k0 + 8 * c) = o; }
    LDS_WAIT(); asm volatile("" ::: "memory");
}
__device__ __forceinline__ void p0a_prologue(Frame& F) {
    LAS float* scr = (LAS float*)(F.lds + RING_OFF + F.wave * 16384);
    const int gw = F.vcu * NWAVES + F.wave, NGW = F.G * NWAVES, lane = F.lane;
    bf16* Win_t = (bf16*)(F.ws + WS_WIN); bf16* Wo_t = (bf16*)(F.ws + WS_WO); bf16* Wup_t = (bf16*)(F.ws + WS_WUP); bf16* Wdn_t = (bf16*)(F.ws + WS_WDN);
    float* MODP = (float*)(F.ws + WS_MODP);
    const float* c_in = ARG_IN(F, I_C); const float* w_ada = ARG_IN(F, I_WADA); const float* w_in = ARG_IN(F, I_WIN); const float* w_gate = ARG_IN(F, I_WGATE);
    const float* w_o = ARG_IN(F, I_WO); const float* w_up = ARG_IN(F, I_WUP); const float* w_down = ARG_IN(F, I_WDOWN);
    constexpr int I_MOD = 96 * 16, I_IN = 16 * 96, I_O = 16 * 32, I_UP = 16 * 176, I_DN = 44 * 32, I_CB = 16 * 32;
    constexpr int NITEMS = I_MOD + I_IN + I_O + I_UP + I_DN + I_CB;
    for (int it = gw; it < NITEMS; it += NGW) {
        int r = it;
        if (r < I_MOD) {
            const int cg = r % 96, ks = r / 96;
            float sv[8], acc[8];
#pragma unroll
            for (int b = 0; b < 8; ++b) { sv[b] = silu_f(c_in[b * 1024 + 64 * ks + lane]); acc[b] = 0.f; }
            const float* wp = w_ada + (size_t)(64 * ks) * 6144 + 64 * cg + lane;
#pragma unroll 4
            for (int kk = 0; kk < 64; ++kk) { const float w = wp[(size_t)kk * 6144];
#pragma unroll
                for (int b = 0; b < 8; ++b) acc[b] += __int_as_float(__builtin_amdgcn_readlane(__float_as_int(sv[b]), kk)) * w; }
#pragma unroll
            for (int b = 0; b < 8; ++b) MODP[(size_t)(ks * 8 + b) * 6144 + 64 * cg + lane] = acc[b];
            continue; }
        r -= I_MOD;
        if (r < I_IN) { const int kb = r / 96, nb = r % 96; p0_transpose_item(w_in, INW, 64 * kb, 32 * nb, Win_t, D, 32 * nb, scr, lane); continue; } r -= I_IN;
        if (r < I_O) { const int kb = r / 32, nb = r % 32; p0_transpose_item(w_o, D, 64 * kb, 32 * nb, Wo_t, D, 32 * nb, scr, lane); continue; } r -= I_O;
        if (r < I_UP) { const int kb = r / 176, nb = r % 176; const int cc = 32 * nb; const int dr = (cc < FF) ? (256 * (cc / 128) + (cc % 128)) : (256 * ((cc - FF) / 128) + 128 + ((cc - FF) % 128));
            p0_transpose_item(w_up, 2 * FF, 64 * kb, cc, Wup_t, D, dr, scr, lane); continue; } r -= I_UP;
        if (r < I_DN) { const int kb = r / 32, nb = r % 32; p0_transpose_item(w_down, D, 64 * kb, 32 * nb, Wdn_t, FF, 32 * nb, scr, lane); continue; } r -= I_DN;
        {
            const int kb = r / 32, nb = r % 32, k0 = 64 * kb, n = 8 * nb + (lane >> 3), c = lane & 7;
            float g[16], o[8];
#pragma unroll
            for (int rr = 0; rr < 16; ++rr) g[rr] = w_gate[rr * 256 + n];
#pragma unroll
            for (int i = 0; i < 8; ++i) { const float* wr_ = w_in + (size_t)(k0 + 8 * c + i) * INW + 3072;
                const f32x4 a0 = *(const f32x4*)(wr_), a1 = *(const f32x4*)(wr_ + 4), a2 = *(const f32x4*)(wr_ + 8), a3 = *(const f32x4*)(wr_ + 12);
                float s = 0.f;
#pragma unroll
                for (int q = 0; q < 4; ++q) { s += a0[q] * g[q]; s += a1[q] * g[4 + q]; s += a2[q] * g[8 + q]; s += a3[q] * g[12 + q]; }
                o[i] = s; }
            v4u w; w.x = pk2(o[0], o[1]); w.y = pk2(o[2], o[3]); w.z = pk2(o[4], o[5]); w.w = pk2(o[6], o[7]);
            *(GAS v4u*)(Win_t + (size_t)(3072 + n) * D + k0 + 8 * c) = w;
        }
    }
}
__device__ __forceinline__ void ln16(f32x4 (&v)[4]) {
    float s = 0.f;
#pragma unroll
    for (int j = 0; j < 4; ++j) s += (v[j].x + v[j].y) + (v[j].z + v[j].w);
    const float mean = wave_sum(s) * (1.f / D); float s2 = 0.f;
#pragma unroll
    for (int j = 0; j < 4; ++j) { v[j] = v[j] - mean; s2 += (v[j].x * v[j].x + v[j].y * v[j].y) + (v[j].z * v[j].z + v[j].w * v[j].w); }
    const float rstd = 1.f / sqrtf(wave_sum(s2) * (1.f / D) + LN_EPS);
#pragma unroll
    for (int j = 0; j < 4; ++j) v[j] = v[j] * rstd;
}
__device__ __forceinline__ void p0b_adaln1(Frame& F) {
    const int b = F.vcu >> 5, tid = F.tid, lane = F.lane;
    const float* MODP = (const float*)(F.ws + WS_MODP); float* MOD = (float*)(F.ws + WS_MOD);
    LAS float* sv = (LAS float*)(F.lds + RING_OFF);
    const bool writer = (F.vcu & 31) == 0; const float* b_ada = ARG_IN(F, I_BADA); const float* x = ARG_IN(F, I_X);
    for (int j = tid; j < (writer ? 6144 : 2048); j += NWAVES * 64) { float v = b_ada[j];
#pragma unroll
        for (int ks = 0; ks < 16; ++ks) v += MODP[(size_t)(ks * 8 + b) * 6144 + j];
        if (j < 2048) sv[j] = (j >= 1024) ? 1.0f + v : v;
        if (writer) MOD[b * 6144 + j] = v; }
    __syncthreads();
    f32x4 shf[4], scl[4];
#pragma unroll
    for (int j = 0; j < 4; ++j) { shf[j] = *(const LAS f32x4*)(sv + 4 * lane + 256 * j); scl[j] = *(const LAS f32x4*)(sv + 1024 + 4 * lane + 256 * j); }
    bf16* XN = (bf16*)(F.ws + WS_XN);
    for (int r = 0; r < 16; ++r) { const size_t row = (size_t)F.vcu * 128 + F.wave * 16 + r;
        const GAS f32x4* xr = (const GAS f32x4*)(x + row * D) + lane; f32x4 v[4];
#pragma unroll
        for (int j = 0; j < 4; ++j) v[j] = xr[64 * j];
        ln16(v);
        GAS unsigned long long* o8 = (GAS unsigned long long*)(XN + row * D) + lane;
#pragma unroll
        for (int j = 0; j < 4; ++j) { const f32x4 u = v[j] * scl[j] + shf[j]; o8[64 * j] = (unsigned long long)pk2(u.x, u.y) | ((unsigned long long)pk2(u.z, u.w) << 32); } }
    __syncthreads();
}
__device__ __forceinline__ void load_chunk_loga_v(Frame& F, LAS float* LA, LAS float* VV, size_t T0, int h) {
    const float* LOGA = (const float*)(F.ws + WS_LOGA); const bf16* VG = (const bf16*)(F.ws + WS_VG); const int tid = F.tid;
#pragma unroll
    for (int i = 0; i < 2; ++i) { const int idx = tid * 4 + i * 2048, t = idx >> 6, d = idx & 63; *(LAS f32x4*)(LA + idx) = *(const f32x4*)(LOGA + (T0 + t) * 256 + 64 * h + d); }
#pragma unroll
    for (int i = 0; i < 2; ++i) { const int idx = tid * 8 + i * 4096, t = idx >> 7, v = idx & 127; const bf16x8 q = *(const bf16x8*)(VG + (T0 + t) * GVW + 128 * h + v);
        *(LAS f32x4*)(VV + idx) = (f32x4){bf2f(q[0]), bf2f(q[1]), bf2f(q[2]), bf2f(q[3])}; *(LAS f32x4*)(VV + idx + 4) = (f32x4){bf2f(q[4]), bf2f(q[5]), bf2f(q[6]), bf2f(q[7])}; }
}
__device__ __forceinline__ void p2a_kmean_gla1(Frame& F) {
    const int gw = F.vcu * NWAVES + F.wave, NGW = F.G * NWAVES, lane = F.lane, tid = F.tid;
    const bf16* KA = (const bf16*)(F.ws + WS_KA); float* KMEAN = (float*)(F.ws + WS_KMEAN);
    for (int it = gw; it < BATCH * 16 * 8; it += NGW) {
        const int h = it & 7, blk = (it >> 3) & 15, b = it >> 7, c = lane & 7, rg = lane >> 3;
        const bf16* p = KA + ((size_t)b * SEQ + blk * 256 + rg) * AW + 64 * h + 8 * c; float a[8];
#pragma unroll
        for (int j = 0; j < 8; ++j) a[j] = 0.f;
#pragma unroll 8
        for (int i = 0; i < 32; ++i) { const bf16x8 q = *(const bf16x8*)(p + (size_t)(8 * i) * AW);
#pragma unroll
            for (int j = 0; j < 8; ++j) a[j] += bf2f(q[j]); }
#pragma unroll
        for (int j = 0; j < 8; ++j) { a[j] += __shfl_xor(a[j], 8); a[j] += __shfl_xor(a[j], 16); a[j] += __shfl_xor(a[j], 32); }
        if (lane < 8) { float* o = KMEAN + ((size_t)(b * 8 + h) * 16 + blk) * 64 + 8 * c;
            *(f32x4*)o = (f32x4){a[0], a[1], a[2], a[3]} * (1.f / 256.f); *(f32x4*)(o + 4) = (f32x4){a[4], a[5], a[6], a[7]} * (1.f / 256.f); }
    }
    LAS float* LA = (LAS float*)(F.lds + RING_OFF); LAS float* KE = LA + 4096; LAS float* VV = KE + 4096;
    const bf16* KG = (const bf16*)(F.ws + WS_KG); float* KV = (float*)(F.ws + WS_KV); float* DEC = (float*)(F.ws + WS_DEC);
    for (int it = F.vcu; it < BATCH * NGH * NCH; it += F.G) {
        const int bh = it >> 6, n = it & 63, b = bh >> 2, h = bh & 3; const size_t T0 = (size_t)b * SEQ + 64 * n;
        load_chunk_loga_v(F, LA, VV, T0, h);
        __syncthreads();
        if (tid < 64) { float s = 0.f;
#pragma unroll 8
            for (int t = 0; t < 64; ++t) { s += LA[t * 64 + tid]; LA[t * 64 + tid] = s; } }
        __syncthreads();
        { const int t = tid >> 3, d0 = (tid & 7) * 8; const bf16x8 q = *(const bf16x8*)(KG + (T0 + t) * GKW + 64 * h + d0);
#pragma unroll
            for (int j = 0; j < 8; ++j) KE[t * 64 + d0 + j] = bf2f(q[j]) * __expf(LA[63 * 64 + d0 + j] - LA[t * 64 + d0 + j]); }
        if (tid < 64) DEC[(size_t)(bh * 64 + n) * 64 + tid] = __expf(LA[63 * 64 + tid]);
        __syncthreads();
        { const int d = tid >> 3, vg = tid & 7; f32x4 o[4];
#pragma unroll
            for (int q = 0; q < 4; ++q) o[q] = (f32x4){0.f, 0.f, 0.f, 0.f};
#pragma unroll 4
            for (int t = 0; t < 64; ++t) { const float ke = KE[t * 64 + d];
#pragma unroll
                for (int q = 0; q < 4; ++q) o[q] += *(const LAS f32x4*)(VV + t * 128 + 16 * vg + 4 * q) * ke; }
            float* kvp = KV + ((size_t)(bh * 64 + n) * 64 + d) * 128 + 16 * vg;
#pragma unroll
            for (int q = 0; q < 4; ++q) *(f32x4*)(kvp + 4 * q) = o[q]; }
        __syncthreads();
    }
}
__device__ __forceinline__ void p2b_scan(Frame& F) {
    float* KV = (float*)(F.ws + WS_KV); const float* DEC = (const float*)(F.ws + WS_DEC);
    const int nthr = F.G * NWAVES * 64;
    for (int e = F.vcu * NWAVES * 64 + F.tid; e < BATCH * NGH * GDK * GDV; e += nthr) {
        const int bh = e >> 13, dv = e & 8191, d = dv >> 7; float* p = KV + (size_t)bh * 64 * 8192 + dv; const float* dc = DEC + (size_t)bh * 64 * 64 + d;
        float S = 0.f;
        for (int n0 = 0; n0 < 64; n0 += 8) { float tv[8], dd[8];
#pragma unroll
            for (int i = 0; i < 8; ++i) { tv[i] = p[(size_t)(n0 + i) * 8192]; dd[i] = dc[(n0 + i) * 64]; }
#pragma unroll
            for (int i = 0; i < 8; ++i) { p[(size_t)(n0 + i) * 8192] = S; S = S * dd[i] + tv[i]; } }
    }
}
__device__ __forceinline__ void p3_gla_out(Frame& F) {
    const int tid = F.tid;
    LAS float* AT = (LAS float*)(F.lds + RING_OFF);
    LAS float* QD = AT + 64 * 65;
    LAS float* KDT = QD + 64 * 65;
    LAS float* VV = KDT + 4096;
    LAS float* SS = VV + 8192;
    const bf16* QG = (const bf16*)(F.ws + WS_QG); const bf16* KG = (const bf16*)(F.ws + WS_KG); const bf16* GG = (const bf16*)(F.ws + WS_GG);
    const float* KV = (const float*)(F.ws + WS_KV); bf16* MIX = (bf16*)(F.ws + WS_MIX); const float* gla_g = ARG_IN(F, I_GLAG);
    for (int it = F.vcu; it < BATCH * NGH * NCH; it += F.G) {
        const int bh = it >> 6, n = it & 63, b = bh >> 2, h = bh & 3; const size_t T0 = (size_t)b * SEQ + 64 * n;
        load_chunk_loga_v(F, AT, VV, T0, h);
        { const float* sp = KV + (size_t)(bh * 64 + n) * 8192;
#pragma unroll
            for (int i = 0; i < 4; ++i) { const int idx = tid * 4 + i * 2048; *(LAS f32x4*)(SS + idx) = *(const f32x4*)(sp + idx); } }
        __syncthreads();
        if (tid < 64) { float s = 0.f;
#pragma unroll 8
            for (int t = 0; t < 64; ++t) { s += AT[t * 64 + tid]; AT[t * 64 + tid] = s; } }
        __syncthreads();
        { const int t = tid >> 3, d0 = (tid & 7) * 8; const bf16x8 q = *(const bf16x8*)(QG + (T0 + t) * GKW + 64 * h + d0), k = *(const bf16x8*)(KG + (T0 + t) * GKW + 64 * h + d0);
#pragma unroll
            for (int j = 0; j < 8; ++j) { const float bb = AT[t * 64 + d0 + j]; QD[t * 65 + d0 + j] = bf2f(q[j]) * 0.125f * __expf(bb); KDT[(d0 + j) * 64 + t] = bf2f(k[j]) * __expf(-bb); } }
        __syncthreads();
        { const int tq = tid >> 3, tk0 = (tid & 7) * 8; f32x4 a0 = (f32x4){0.f, 0.f, 0.f, 0.f}, a1 = a0;
#pragma unroll 4
            for (int d = 0; d < 64; ++d) { const float q = QD[tq * 65 + d]; a0 += *(const LAS f32x4*)(KDT + d * 64 + tk0) * q; a1 += *(const LAS f32x4*)(KDT + d * 64 + tk0 + 4) * q; }
#pragma unroll
            for (int j = 0; j < 4; ++j) { AT[tq * 65 + tk0 + j] = (tk0 + j <= tq) ? a0[j] : 0.f; AT[tq * 65 + tk0 + 4 + j] = (tk0 + 4 + j <= tq) ? a1[j] : 0.f; } }
        __syncthreads();
        { const int tq = tid >> 3, vg = tid & 7; f32x4 o[4];
#pragma unroll
            for (int q = 0; q < 4; ++q) o[q] = (f32x4){0.f, 0.f, 0.f, 0.f};
#pragma unroll 4
            for (int tk = 0; tk < 64; ++tk) { const float a = AT[tq * 65 + tk];
#pragma unroll
                for (int q = 0; q < 4; ++q) o[q] += *(const LAS f32x4*)(VV + tk * 128 + 16 * vg + 4 * q) * a; }
#pragma unroll 4
            for (int d = 0; d < 64; ++d) { const float a = QD[tq * 65 + d];
#pragma unroll
                for (int q = 0; q < 4; ++q) o[q] += *(const LAS f32x4*)(SS + d * 128 + 16 * vg + 4 * q) * a; }
            float ss = 0.f;
#pragma unroll
            for (int q = 0; q < 4; ++q) ss += (o[q].x * o[q].x + o[q].y * o[q].y) + (o[q].z * o[q].z + o[q].w * o[q].w);
            ss += __shfl_xor(ss, 1); ss += __shfl_xor(ss, 2); ss += __shfl_xor(ss, 4);
            const float rs = 1.0f / sqrtf(ss * (1.f / 128.f) + LN_EPS);
            const bf16* gp = GG + (T0 + tq) * GVW + 128 * h + 16 * vg; const bf16x8 g0 = *(const bf16x8*)gp, g1 = *(const bf16x8*)(gp + 8);
            const float* nw = gla_g + 128 * h + 16 * vg; float r[16];
#pragma unroll
            for (int q = 0; q < 4; ++q) { const f32x4 w = *(const f32x4*)(nw + 4 * q);
#pragma unroll
                for (int j = 0; j < 4; ++j) { const float gv = bf2f(q < 2 ? g0[4 * q + j] : g1[4 * (q - 2) + j]); r[4 * q + j] = o[q][j] * rs * w[j] * silu_f(gv); } }
            bf16* op = MIX + (T0 + tq) * D + AW + 128 * h + 16 * vg;
            v4u w0, w1; w0.x = pk2(r[0], r[1]); w0.y = pk2(r[2], r[3]); w0.z = pk2(r[4], r[5]); w0.w = pk2(r[6], r[7]); w1.x = pk2(r[8], r[9]); w1.y = pk2(r[10], r[11]); w1.z = pk2(r[12], r[13]); w1.w = pk2(r[14], r[15]);
            *(GAS v4u*)op = w0; *(GAS v4u*)(op + 8) = w1; }
        __syncthreads();
    }
}
__device__ __forceinline__ void p4b_ln1_adaln2(Frame& F) {
    const int b = F.vcu >> 5, lane = F.lane; const float* MOD = (const float*)(F.ws + WS_MOD) + b * 6144;
    f32x4 g1[4], lg[4], lb[4], scl[4], shf[4]; const float* ln1_g = ARG_IN(F, I_LN1G); const float* ln1_b = ARG_IN(F, I_LN1B); const float* x = ARG_IN(F, I_X);
#pragma unroll
    for (int j = 0; j < 4; ++j) { const int c = 4 * lane + 256 * j; g1[j] = *(const f32x4*)(MOD + 2048 + c); lg[j] = *(const f32x4*)(ln1_g + c); lb[j] = *(const f32x4*)(ln1_b + c);
        shf[j] = *(const f32x4*)(MOD + 3072 + c); scl[j] = *(const f32x4*)(MOD + 4096 + c) + 1.0f; }
    const bf16* Y1 = (const bf16*)(F.ws + WS_Y1); float* X1 = (float*)(F.ws + WS_X1); bf16* XN = (bf16*)(F.ws + WS_XN);
    for (int r = 0; r < 16; ++r) { const size_t row = (size_t)F.vcu * 128 + F.wave * 16 + r;
        const GAS f32x4* xr = (const GAS f32x4*)(x + row * D) + lane; const GAS unsigned long long* yr = (const GAS unsigned long long*)(Y1 + row * D) + lane; f32x4 v[4];
#pragma unroll
        for (int j = 0; j < 4; ++j) { const unsigned long long yw = yr[64 * j]; const f32x4 y = (f32x4){bf2f((unsigned short)yw), bf2f((unsigned short)(yw >> 16)), bf2f((unsigned short)(yw >> 32)), bf2f((unsigned short)(yw >> 48))};
            v[j] = xr[64 * j] * ALPHA + g1[j] * y; }
        ln16(v);
        GAS f32x4* x1r = (GAS f32x4*)(X1 + row * D) + lane;
#pragma unroll
        for (int j = 0; j < 4; ++j) { v[j] = v[j] * lg[j] + lb[j]; x1r[64 * j] = v[j]; }
        ln16(v);
        GAS unsigned long long* o8 = (GAS unsigned long long*)(XN + row * D) + lane;
#pragma unroll
        for (int j = 0; j < 4; ++j) { const f32x4 u = v[j] * scl[j] + shf[j]; o8[64 * j] = (unsigned long long)pk2(u.x, u.y) | ((unsigned long long)pk2(u.z, u.w) << 32); } }
}
__device__ __forceinline__ void p5b_fixup(Frame& F) {
    const float* HALO = (const float*)(F.ws + WS_HALO); const float* FIXS = (const float*)(F.ws + WS_FIXS); const float* FIXV = (const float*)(F.ws + WS_FIXV); bf16* ACT = (bf16*)(F.ws + WS_ACT);
    const int nthr = F.G * NWAVES * 64; const float* conv_w = ARG_IN(F, I_CONVW);
    for (int e = F.vcu * NWAVES * 64 + F.tid; e < 128 * 2 * FF; e += nthr) {
        const int ch = e % FF, rr = (e / FF) & 1, pm = e / (2 * FF);
        if ((pm & 15) == 0) continue;
        const float h14 = HALO[((size_t)(pm - 1) * 2 + 0) * FF + ch], h15 = HALO[((size_t)(pm - 1) * 2 + 1) * FF + ch];
        const float w0 = conv_w[ch], w1 = conv_w[FF + ch];
        const float extra = rr == 0 ? (w0 * h14 + w1 * h15) : (w0 * h15);
        const float cv = FIXS[((size_t)pm * 2 + rr) * FF + ch] + extra;
        ACT[((size_t)pm * 256 + rr) * FF + ch] = (bf16)f2bf(pg8::gelu1(cv) * FIXV[((size_t)pm * 2 + rr) * FF + ch]);
    }
}
__device__ __forceinline__ void p6b_ln2(Frame& F) {
    const int b = F.vcu >> 5, lane = F.lane; const float* MOD = (const float*)(F.ws + WS_MOD) + b * 6144;
    f32x4 g2[4], lg[4], lb[4]; const float* ln2_g = ARG_IN(F, I_LN2G); const float* ln2_b = ARG_IN(F, I_LN2B); float* outp = ARG_OUT(F);
#pragma unroll
    for (int j = 0; j < 4; ++j) { const int c = 4 * lane + 256 * j; g2[j] = *(const f32x4*)(MOD + 5120 + c); lg[j] = *(const f32x4*)(ln2_g + c); lb[j] = *(const f32x4*)(ln2_b + c); }
    const bf16* Y2 = (const bf16*)(F.ws + WS_Y2); const float* X1 = (const float*)(F.ws + WS_X1);
    for (int r = 0; r < 16; ++r) { const size_t row = (size_t)F.vcu * 128 + F.wave * 16 + r;
        const GAS f32x4* xr = (const GAS f32x4*)(X1 + row * D) + lane; const GAS unsigned long long* yr = (const GAS unsigned long long*)(Y2 + row * D) + lane; f32x4 v[4];
#pragma unroll
        for (int j = 0; j < 4; ++j) { const unsigned long long yw = yr[64 * j]; const f32x4 y = (f32x4){bf2f((unsigned short)yw), bf2f((unsigned short)(yw >> 16)), bf2f((unsigned short)(yw >> 32)), bf2f((unsigned short)(yw >> 48))};
            v[j] = xr[64 * j] * ALPHA + g2[j] * y; }
        ln16(v);
        GAS f32x4* orow = (GAS f32x4*)(outp + row * D) + lane;
#pragma unroll
        for (int j = 0; j < 4; ++j) orow[64 * j] = v[j] * lg[j] + lb[j]; }
}

__global__ void __launch_bounds__(NWAVES * 64, 2) mk_fwd(Args args) {
    extern __shared__ __attribute__((aligned(16))) unsigned char lds[];
    Frame F;
    F.lds = (LAS unsigned char*)lds;
    F.MISC = (volatile LAS unsigned*)(F.lds + MISC_OFF);
    F.tid = threadIdx.x; F.lane = F.tid & 63; F.wave = __builtin_amdgcn_readfirstlane(F.tid >> 6);
    F.G = gridDim.x; { const int bx = blockIdx.x; F.vcu = (F.G % 8 == 0) ? (bx % 8) * (F.G / 8) + bx / 8 : bx; }
    F.ws = args.ws; F.ctl = (gu32*)(args.ws + WS_CTL); F.argp = (const CAS Args*)__builtin_amdgcn_kernarg_segment_ptr();
    for (int u = F.tid; u < (LDS_BYTES - LDSCTL_OFF) / 4; u += NWAVES * 64) ((LAS unsigned*)(F.lds + LDSCTL_OFF))[u] = 0u;
    __syncthreads();
    XcdBarrier bar; bar.bar = (unsigned*)(F.ctl + CW_BAR); bar.x = 0; bar.st = nullptr;
    if (N_LAUNCHES == 1) bar = xcd_barrier_post((unsigned*)(F.ctl + CW_BAR), F.MISC + 8);
#define GRID_BAR(seam) do { if (N_LAUNCHES != 1) { if (F.tid == 0) __hip_atomic_store(F.ctl + CW_TMO, 0xBADBA0u | (unsigned)(seam), RLX_AGENT); } else { xcd_barrier(bar); } } while (0)
    const int lo = args.ph_lo, hi = args.ph_hi;
#ifndef MK_PHASE_MASK
#define MK_PHASE_MASK 0xfff
#endif
#define IN(k) (((MK_PHASE_MASK >> (k)) & 1) && lo <= (k) && (k) < hi)
#define BOTH(k) (IN(k) && IN((k) + 1))
    bf16* XN = (bf16*)(F.ws + WS_XN);
    if (IN(0)) { p0a_prologue(F); if (BOTH(0)) GRID_BAR(0); }
    if (IN(1)) { p0b_adaln1(F); if (BOTH(1)) GRID_BAR(1); }
    if (IN(2)) {
        pg8::Gemm g{XN, (const bf16*)(F.ws + WS_WIN), M, NIN, D}; pg8::StaticOrder S; S.init(M, NIN, F.G, (int)blockIdx.x);
        pg8::EpiInProj E{(bf16*)(F.ws + WS_QA), (bf16*)(F.ws + WS_KA), (bf16*)(F.ws + WS_VA), (bf16*)(F.ws + WS_QG), (bf16*)(F.ws + WS_KG), (bf16*)(F.ws + WS_VG), (bf16*)(F.ws + WS_GG), (float*)(F.ws + WS_LOGA), ARG_IN(F, I_BGATE), attn_body::C2};
        pg8::gemm_phase<pg8::EpiInProj, pg8::StaticOrder, PG8_ALIGN, PG8_SP2>(F.lds + RING_OFF, g, S, E);
        if (BOTH(2)) GRID_BAR(2);
    }
    if (IN(3)) { p2a_kmean_gla1(F); if (BOTH(3)) GRID_BAR(3); }
    if (IN(4)) {
        p2b_scan(F);
        const attn_body::AttnTensors AT{(const attn_body::bf16*)(F.ws + WS_QA), (const attn_body::bf16*)(F.ws + WS_KA), (const attn_body::bf16*)(F.ws + WS_VA), (attn_body::bf16*)(F.ws + WS_MIX), (const float*)(F.ws + WS_KMEAN), ARG_IN(F, I_ATTNG)};
        const attn_body::StaticOrder S((int)F.G, (int)blockIdx.x);
        attn_body::attn_phase<attn_body::StaticOrder>((char*)lds + RING_OFF, AT, S);
        if (BOTH(4)) GRID_BAR(4);
    }
    if (IN(5)) { p3_gla_out(F); if (BOTH(5)) GRID_BAR(5); }
    if (IN(6)) {
        pg8::Gemm g{(const bf16*)(F.ws + WS_MIX), (const bf16*)(F.ws + WS_WO), M, D, D}; pg8::StaticOrder S; S.init(M, D, F.G, (int)blockIdx.x);
        pg8::EpiBf16<0> E{(bf16*)(F.ws + WS_Y1), D, nullptr, 0, 0, 1.f};
        pg8::gemm_phase<pg8::EpiBf16<0>, pg8::StaticOrder, PG8_ALIGN, PG8_SP2>(F.lds + RING_OFF, g, S, E);
        if (BOTH(6)) GRID_BAR(6);
    }
    if (IN(7)) { p4b_ln1_adaln2(F); if (BOTH(7)) GRID_BAR(7); }
    if (IN(8)) {
        pg8::Gemm g{XN, (const bf16*)(F.ws + WS_WUP), M, 2 * FF, D}; pg8::StaticOrder S; S.init(M, 2 * FF, F.G, (int)blockIdx.x);
        pg8::EpiConvGlu E{(bf16*)(F.ws + WS_ACT), ARG_IN(F, I_BUP), ARG_IN(F, I_CONVW), ARG_IN(F, I_CONVB), (float*)(F.ws + WS_HALO), (float*)(F.ws + WS_FIXS), (float*)(F.ws + WS_FIXV), (LAS float*)(F.lds + HTAB_OFF)};
        pg8::gemm_phase<pg8::EpiConvGlu, pg8::StaticOrder, true, PG8_SP2>(F.lds + RING_OFF, g, S, E);
        if (BOTH(8)) GRID_BAR(8);
    }
    if (IN(9)) { p5b_fixup(F); if (BOTH(9)) GRID_BAR(9); }
    if (IN(10)) {
        pg8::Gemm g{(const bf16*)(F.ws + WS_ACT), (const bf16*)(F.ws + WS_WDN), M, D, FF}; pg8::StaticOrder S; S.init(M, D, F.G, (int)blockIdx.x);
        pg8::EpiBf16<0> E{(bf16*)(F.ws + WS_Y2), D, nullptr, 0, 0, 1.f};
        pg8::gemm_phase<pg8::EpiBf16<0>, pg8::StaticOrder, PG8_ALIGN, PG8_SP2>(F.lds + RING_OFF, g, S, E);
        if (BOTH(10)) GRID_BAR(10);
    }
    if (IN(11)) { p6b_ln2(F); }
#undef IN
#undef BOTH
}

extern "C" void kernel_launch(void* const* d_in, const int* in_sizes, int n_in, void* d_out, int out_size, void* d_ws, size_t ws_size, hipStream_t stream) {
    static int grid = 0;
    if (grid == 0) {
        if (n_in != 19 || in_sizes[0] != M * D || out_size != M * D || ws_size < WS_END) { fprintf(stderr, "kernel_launch: built for 19 inputs, x/out of %d floats, >= %zu bytes of workspace; got n_in %d, in0 %d, out %d, ws %zu; nothing launched\n", M * D, (size_t)WS_END, n_in, n_in > 0 ? in_sizes[0] : -1, out_size, ws_size); grid = -1; return; }
        int dev = 0, cus = 0, per_cu = 0;
        if (hipGetDevice(&dev) != hipSuccess || hipDeviceGetAttribute(&cus, hipDeviceAttributeMultiprocessorCount, dev) != hipSuccess) { fprintf(stderr, "kernel_launch: device query failed\n"); grid = -1; return; }
        if (hipFuncSetAttribute((const void*)mk_fwd, hipFuncAttributeMaxDynamicSharedMemorySize, LDS_BYTES) != hipSuccess) { fprintf(stderr, "kernel_launch: hipFuncSetAttribute failed\n"); grid = -1; return; }
        if (hipOccupancyMaxActiveBlocksPerMultiprocessor(&per_cu, (const void*)mk_fwd, NWAVES * 64, LDS_BYTES) != hipSuccess || per_cu < 1)
            fprintf(stderr, "kernel_launch: note: the occupancy query reports %d workgroups per CU\n", per_cu);
        (void)hipGetLastError();
        grid = cus;
        if (grid != 256) { fprintf(stderr, "kernel_launch: this kernel's row split needs exactly 256 CUs, got %d; nothing launched\n", grid); grid = -1; return; }
    }
    if (grid < 0) return;
    if (hipMemsetAsync((char*)d_ws + WS_CTL, 0, CTL_ZERO_BYTES, stream) != hipSuccess) { fprintf(stderr, "kernel_launch: hipMemsetAsync failed\n"); return; }
    Args a{};
    for (int i = 0; i < 19; ++i) a.in[i] = (const float*)d_in[i];
    a.out = (float*)d_out; a.ws = (unsigned char*)d_ws;
    for (int li = 0; li < N_LAUNCHES; ++li) {
        a.ph_lo = (N_LAUNCHES == 1) ? 0 : li; a.ph_hi = (N_LAUNCHES == 1) ? N_PHASES : li + 1; a.li = li;
        hipLaunchKernelGGL(mk_fwd, dim3(grid), dim3(NWAVES * 64), LDS_BYTES, stream, a);
        const hipError_t le = hipPeekAtLastError();
        if (le != hipSuccess) { fprintf(stderr, "kernel_launch: launch %d failed: %s\n", li, hipGetErrorName(le)); break; }
    }
}
```

```cpp
#include <hip/hip_runtime.h>
#include <cstdio>
#include <cstdint>
namespace pg8 {
#define PG8_LAS __attribute__((address_space(3)))
typedef unsigned short bf16_t;
typedef short bf16x8 __attribute__((ext_vector_type(8)));
typedef float f32x4 __attribute__((ext_vector_type(4)));
typedef unsigned u32x4 __attribute__((ext_vector_type(4)));
constexpr int BM = 256, BK = 64, HALF = 128, HTB = HALF * BK * 2  , STAGE_BYTES = 8 * HTB, NXCD = 8, WGM = 8;

__host__ __device__ __forceinline__ int lds_byte(int r, int c) { const int st = (r >> 4) * 2 + (c >> 5), rr = r & 15, cc = c & 31, ob = rr * 64 + cc * 2; return st * 1024 + (ob ^ (((ob >> 9) & 1) << 5)); }
__host__ __device__ __forceinline__ void stage_rc(int b, int& R, int& C) { const int st = b / 1024, sb = b % 1024, swz = sb ^ (((sb >> 9) & 1) << 5); R = (st >> 1) * 16 + swz / 64; C = (st & 1) * 32 + (swz % 64) / 2; }
__host__ __device__ __forceinline__ int perm32(int rho) { const int n = rho >> 4, i = rho & 15; return 8 * (i >> 2) + 4 * n + (i & 3); }

struct Unit { int pm, pn; };
struct Gemm { const bf16_t* A; const bf16_t* Bt; int M, N, K; };

struct StaticOrder {
    int nM, nN, nwg, G, c;
    __host__ __device__ void init(int M, int N, int G_, int c_) { nM = M / BM; nN = N / BM; nwg = nM * nN; G = G_; c = c_; }
    __host__ __device__ bool next(int i, Unit& u) const {
        const long L = (long)i * G + c; if (L >= nwg) return false;
        int wgid = (int)L; { const int q = nwg / NXCD, r = nwg % NXCD, xcd = wgid % NXCD, off = wgid / NXCD; wgid = (xcd < r ? xcd * (q + 1) : r * (q + 1) + (xcd - r) * q) + off; }
        const int nig = WGM * nN, gid = wgid / nig, fm = gid * WGM, gsz = (nM - fm) < WGM ? (nM - fm) : WGM;
        u.pm = fm + ((wgid % nig) % gsz); u.pn = (wgid % nig) / gsz; return true;
    }
    __device__ __forceinline__ void a_ready(const Unit&) const {}
    __device__ __forceinline__ void done(const Unit&) const {}
};

__device__ __forceinline__ unsigned cvt_pk_bf16(float lo, float hi) { unsigned r; asm volatile("v_cvt_pk_bf16_f32 %0, %1, %2" : "=v"(r) : "v"(lo), "v"(hi)); return r; }
typedef float f32x2 __attribute__((ext_vector_type(2)));
__device__ __forceinline__ f32x2 gelu_pk(f32x2 v) {
    const f32x2 av = __builtin_elementwise_abs(v), d = av * 0.2316418882f + 1.0f;
    f32x2 t; t.x = __builtin_amdgcn_rcpf(d.x); t.y = __builtin_amdgcn_rcpf(d.y);
    f32x2 q = t * 0.5307027145f + (-0.7265760135f); q = q * t + 0.7107068705f; q = q * t + (-0.142248368f); q = q * t + 0.127414796f; q = q * t;
    const f32x2 s = (v * v) * (-0.72134752044f);
    f32x2 e; e.x = __builtin_amdgcn_exp2f(s.x); e.y = __builtin_amdgcn_exp2f(s.y);
    const f32x2 m = v * (q * e), r = v - m;
    f32x2 o; o.x = v.x < 0.f ? m.x : r.x; o.y = v.y < 0.f ? m.y : r.y; return o;
}

template <int ACT  > struct EpiBf16 {
    static constexpr bool PERM = true, AFTER_DRAIN = false; static_assert(ACT == 0 || ACT == 1, "EpiBf16: ACT is 0 (none) or 1 (gelu_pk)");
    bf16_t* O; int ldc; const float* bias; int split_cols; size_t split_stride; float scale0;
    __device__ __forceinline__ void operator()(const f32x4 (&acc)[2][2][4][2], const Unit& u, int wr, int wc, int fr, int fq) const {
        const int row0 = u.pm * BM + wr * 64 + fr; int colt = u.pn * BM; bf16_t* base = O;
        float sc = 1.f; if (split_cols) { const int t = colt / split_cols; base += (size_t)t * split_stride; colt -= t * split_cols; if (t == 0) sc = scale0; }
        const int col0 = colt + wc * 32 + 8 * fq, bcol0 = u.pn * BM + wc * 32 + 8 * fq;
        f32x4 bv[2][2];
#pragma unroll
        for (int bj = 0; bj < 2; ++bj)
#pragma unroll
            for (int n = 0; n < 2; ++n) bv[bj][n] = bias ? *(const f32x4*)(bias + bcol0 + bj * HALF + 4 * n) : (f32x4){0.f, 0.f, 0.f, 0.f};
#pragma unroll
        for (int ai = 0; ai < 2; ++ai)
#pragma unroll
            for (int m = 0; m < 4; ++m) { bf16_t* rowp = base + (size_t)(row0 + ai * HALF + m * 16) * ldc + col0;
#pragma unroll
                for (int bj = 0; bj < 2; ++bj) { f32x4 v0 = acc[ai][bj][m][0] + bv[bj][0], v1 = acc[ai][bj][m][1] + bv[bj][1];
                    if (ACT == 1) { f32x2 a = gelu_pk((f32x2){v0[0], v0[1]}), b = gelu_pk((f32x2){v0[2], v0[3]}), c = gelu_pk((f32x2){v1[0], v1[1]}), d = gelu_pk((f32x2){v1[2], v1[3]});
                        v0 = (f32x4){a.x, a.y, b.x, b.y}; v1 = (f32x4){c.x, c.y, d.x, d.y}; }
                    v0 = v0 * sc; v1 = v1 * sc; u32x4 w; w.x = cvt_pk_bf16(v0[0], v0[1]); w.y = cvt_pk_bf16(v0[2], v0[3]); w.z = cvt_pk_bf16(v1[0], v1[1]); w.w = cvt_pk_bf16(v1[2], v1[3]);
                    *(u32x4*)(rowp + bj * HALF) = w; } }
    }
};

template <class Epi, class Sched, bool ALIGN_EPI = false, bool SP2 = false>
__device__ __forceinline__ void gemm_phase(PG8_LAS unsigned char* lds, const Gemm g, const Sched& S, const Epi& E) {
    const int tid = threadIdx.x, wid = __builtin_amdgcn_readfirstlane(tid >> 6), lane = tid & 63, wr = wid >> 2, wc = wid & 3, fr = lane & 15, fq = lane >> 4;
    const int K = g.K, nt = K / BK;
    unsigned voffA[2], voffB[2];
#pragma unroll
    for (int i = 0; i < 2; ++i) { int R, C; stage_rc(tid * 16 + i * 8192, R, C); const int Rb = Epi::PERM ? ((R & ~31) + perm32(R & 31)) : R;
        voffA[i] = (unsigned)(R * K + C) * 2u; voffB[i] = (unsigned)(Rb * K + C) * 2u; }
    const size_t kstep = (size_t)(BK * 2);
    const size_t hstep = (size_t)HALF * K * 2;
    const size_t tstep = 2 * hstep;
    const unsigned ldsw = (unsigned)wid * 1024u;
    const int aoff = lds_byte(wr * 64 + fr, fq * 8), boff = lds_byte(wc * 32 + fr, fq * 8);
#define PG8_SA(b, h) (((b) * 2 + (h)) * HTB)
#define PG8_SB(b, h) ((4 + (b) * 2 + (h)) * HTB)
#define PG8_STAGE(bufoff, gbase, voff) do { _Pragma("unroll") for (int _i = 0; _i < 2; ++_i) \
        __builtin_amdgcn_global_load_lds((const unsigned*)((const char*)(gbase) + (voff)[_i]), (PG8_LAS unsigned*)(lds + (bufoff) + ldsw + _i * 8192), 16, 0, 0); } while (0)
#define PG8_LDA(dst, b, h) do { _Pragma("unroll") for (int m = 0; m < 4; ++m) _Pragma("unroll") for (int k = 0; k < 2; ++k) dst[m][k] = *(const PG8_LAS bf16x8*)(lds + PG8_SA(b, h) + aoff + m * 2048 + k * 1024); } while (0)
#define PG8_LDB(dst, b, h) do { _Pragma("unroll") for (int n = 0; n < 2; ++n) _Pragma("unroll") for (int k = 0; k < 2; ++k) dst[n][k] = *(const PG8_LAS bf16x8*)(lds + PG8_SB(b, h) + boff + n * 2048 + k * 1024); } while (0)
#define PG8_MMA(ai, bj, At, Bt) do { __builtin_amdgcn_s_setprio(1); _Pragma("unroll") for (int m = 0; m < 4; ++m) _Pragma("unroll") for (int n = 0; n < 2; ++n) _Pragma("unroll") for (int k = 0; k < 2; ++k) \
        acc[ai][bj][m][n] = __builtin_amdgcn_mfma_f32_16x16x32_bf16(Bt[n][k], At[m][k], acc[ai][bj][m][n], 0, 0, 0); __builtin_amdgcn_s_setprio(0); } while (0)
#define PG8_WAIT_V(n) asm volatile("s_waitcnt vmcnt(" #n ")" ::: "memory")
#define PG8_WAIT_L(n) asm volatile("s_waitcnt lgkmcnt(" #n ")" ::: "memory")
#define PG8_BAR __builtin_amdgcn_s_barrier()
#define PG8_SCHED __builtin_amdgcn_sched_barrier(0)
    Unit cur, nxt; int ui = 0;
    if (!S.next(0, cur)) return;
    f32x4 acc[2][2][4][2];
#pragma unroll
    for (int a = 0; a < 2; ++a)
#pragma unroll
        for (int b = 0; b < 2; ++b)
#pragma unroll
            for (int m = 0; m < 4; ++m)
#pragma unroll
                for (int n = 0; n < 2; ++n) acc[a][b][m][n] = (f32x4){0.f, 0.f, 0.f, 0.f};
    bf16x8 At[4][2], B0[2][2], B1[2][2];
    const char* cA = (const char*)g.A + (size_t)cur.pm * tstep; const char* cB = (const char*)g.Bt + (size_t)cur.pn * tstep;
    S.a_ready(cur);
    if constexpr (SP2) {
        PG8_STAGE(PG8_SB(0, 0), cB, voffB); PG8_STAGE(PG8_SB(0, 1), cB + hstep, voffB); PG8_STAGE(PG8_SA(0, 0), cA, voffA); PG8_STAGE(PG8_SA(0, 1), cA + hstep, voffA);
        if (wr == 1) PG8_BAR;
        PG8_WAIT_V(2); PG8_BAR;
        PG8_STAGE(PG8_SB(1, 0), cB + kstep, voffB); PG8_STAGE(PG8_SA(1, 0), cA + kstep, voffA); PG8_STAGE(PG8_SB(1, 1), cB + hstep + kstep, voffB);
        PG8_WAIT_V(6); PG8_BAR;
    } else {
        PG8_STAGE(PG8_SB(0, 0), cB, voffB); PG8_STAGE(PG8_SA(0, 0), cA, voffA); PG8_STAGE(PG8_SB(0, 1), cB + hstep, voffB); PG8_STAGE(PG8_SA(0, 1), cA + hstep, voffA);
        if (wr == 1) PG8_BAR;
        PG8_WAIT_V(4); PG8_BAR;
        PG8_STAGE(PG8_SB(1, 0), cB + kstep, voffB); PG8_STAGE(PG8_SA(1, 0), cA + kstep, voffA); PG8_STAGE(PG8_SB(1, 1), cB + hstep + kstep, voffB);
        PG8_WAIT_V(6); PG8_BAR;
    }
    for (;;) {
        const bool has_next = S.next(ui + 1, nxt);
        const char* nA = has_next ? (const char*)g.A + (size_t)nxt.pm * tstep : cA; const char* nB = has_next ? (const char*)g.Bt + (size_t)nxt.pn * tstep : cB;
        for (int t = 0; t < nt; t += 2) {
            const bool last = (t == nt - 2);
            const char* a1 = cA + (size_t)(t + 1) * kstep;
            const char* a2 = last ? nA : cA + (size_t)(t + 2) * kstep; const char* b2 = last ? nB : cB + (size_t)(t + 2) * kstep;
            const char* a3 = a2 + kstep; const char* b3 = b2 + kstep;
            if (last && has_next) S.a_ready(nxt);
            if constexpr (SP2) {
            PG8_LDB(B0, 0, 0); PG8_LDB(B1, 0, 1); PG8_SCHED; PG8_LDA(At, 0, 0); PG8_STAGE(PG8_SA(1, 1), a1 + hstep, voffA);
            PG8_WAIT_V(8); PG8_WAIT_L(0); PG8_BAR; PG8_MMA(0, 0, At, B0); PG8_MMA(0, 1, At, B1); PG8_BAR; PG8_SCHED;
            PG8_LDA(At, 0, 1); PG8_STAGE(PG8_SB(0, 0), b2, voffB); PG8_STAGE(PG8_SB(0, 1), b2 + hstep, voffB); PG8_STAGE(PG8_SA(0, 0), a2, voffA);
            PG8_WAIT_V(8); PG8_WAIT_L(0); PG8_BAR; PG8_MMA(1, 0, At, B0); PG8_MMA(1, 1, At, B1); PG8_BAR; PG8_SCHED;
            PG8_LDB(B0, 1, 0); PG8_LDB(B1, 1, 1); PG8_SCHED; PG8_LDA(At, 1, 0); PG8_STAGE(PG8_SA(0, 1), a2 + hstep, voffA);
            PG8_WAIT_V(8); PG8_WAIT_L(0); PG8_BAR; PG8_MMA(0, 0, At, B0); PG8_MMA(0, 1, At, B1); PG8_BAR; PG8_SCHED;
            PG8_LDA(At, 1, 1); PG8_STAGE(PG8_SB(1, 0), b3, voffB); PG8_STAGE(PG8_SB(1, 1), b3 + hstep, voffB); PG8_STAGE(PG8_SA(1, 0), a3, voffA);
            PG8_WAIT_V(8); PG8_WAIT_L(0); PG8_BAR; PG8_MMA(1, 0, At, B0); PG8_MMA(1, 1, At, B1); PG8_BAR; PG8_SCHED;
            } else {
            PG8_LDB(B0, 0, 0); PG8_SCHED; PG8_LDA(At, 0, 0); PG8_STAGE(PG8_SA(1, 1), a1 + hstep, voffA);
            PG8_WAIT_L(8); PG8_BAR; PG8_WAIT_L(0); PG8_MMA(0, 0, At, B0); PG8_BAR; PG8_SCHED;
            PG8_LDB(B1, 0, 1); PG8_STAGE(PG8_SB(0, 0), b2, voffB);
            PG8_BAR; PG8_WAIT_L(0); PG8_MMA(0, 1, At, B1); PG8_BAR;
            PG8_LDA(At, 0, 1); PG8_STAGE(PG8_SA(0, 0), a2, voffA);
            PG8_BAR; PG8_WAIT_L(0); PG8_MMA(1, 0, At, B0); PG8_BAR; PG8_SCHED;
            PG8_STAGE(PG8_SB(0, 1), b2 + hstep, voffB);
            PG8_WAIT_V(6); PG8_BAR; PG8_MMA(1, 1, At, B1); PG8_BAR;
            PG8_LDB(B0, 1, 0); PG8_SCHED; PG8_LDA(At, 1, 0); PG8_STAGE(PG8_SA(0, 1), a2 + hstep, voffA);
            PG8_WAIT_L(8); PG8_BAR; PG8_WAIT_L(0); PG8_MMA(0, 0, At, B0); PG8_BAR; PG8_SCHED;
            PG8_LDB(B1, 1, 1); PG8_STAGE(PG8_SB(1, 0), b3, voffB);
            PG8_BAR; PG8_WAIT_L(0); PG8_MMA(0, 1, At, B1); PG8_BAR;
            PG8_LDA(At, 1, 1); PG8_STAGE(PG8_SA(1, 0), a3, voffA);
            PG8_BAR; PG8_WAIT_L(0); PG8_MMA(1, 0, At, B0); PG8_BAR; PG8_SCHED;
            PG8_STAGE(PG8_SB(1, 1), b3 + hstep, voffB);
            PG8_WAIT_V(6); PG8_BAR; PG8_MMA(1, 1, At, B1); PG8_BAR;
            }
        }
        if constexpr (ALIGN_EPI) { if (wr == 0) PG8_BAR; }
        if constexpr (!Epi::AFTER_DRAIN) { E(acc, cur, wr, wc, fr, fq); S.done(cur); }
        if (!has_next) break;
#pragma unroll
        for (int a = 0; a < 2; ++a)
#pragma unroll
            for (int b = 0; b < 2; ++b)
#pragma unroll
                for (int m = 0; m < 4; ++m)
#pragma unroll
                    for (int n = 0; n < 2; ++n) acc[a][b][m][n] = (f32x4){0.f, 0.f, 0.f, 0.f};
        cur = nxt; cA = nA; cB = nB; ++ui;
        if constexpr (ALIGN_EPI) { if (wr == 1) PG8_BAR; }
    }
    PG8_WAIT_V(0);
    if constexpr (!ALIGN_EPI) { if (wr == 0) PG8_BAR; }
    PG8_BAR;
    if constexpr (Epi::AFTER_DRAIN) { E.fused(acc, cur, wr, wc, fr, fq, lds, wid, lane); S.done(cur); }
#undef PG8_SA
#undef PG8_SB
#undef PG8_STAGE
#undef PG8_LDA
#undef PG8_LDB
#undef PG8_MMA
#undef PG8_WAIT_V
#undef PG8_WAIT_L
#undef PG8_BAR
#undef PG8_SCHED
}
}

#ifndef PG8_SP2
#define PG8_SP2 true
#endif
#ifndef PG8_ALIGN
#define PG8_ALIGN true
#endif
namespace pg8 {
__device__ __forceinline__ float gelu1(float v) {
    const float av = __builtin_fabsf(v), t = __builtin_amdgcn_rcpf(av * 0.2316418882f + 1.0f);
    float q = t * 0.5307027145f + (-0.7265760135f); q = q * t + 0.7107068705f; q = q * t + (-0.142248368f); q = q * t + 0.127414796f; q = q * t;
    const float e = __builtin_amdgcn_exp2f((v * v) * (-0.72134752044f));
    const float m = v * (q * e), r = v - m; return v < 0.f ? m : r;
}
struct EpiInProj {
    static constexpr bool PERM = true, AFTER_DRAIN = false;
    bf16_t *QA, *KA, *VA, *QG, *KG, *VG, *GG; float* LOGA; const float* bgate; float qscale;
    __device__ __forceinline__ void operator()(f32x4 (&acc)[2][2][4][2], const Unit& u, int wr, int wc, int fr, int fq) const {
        const int pn = u.pn; const int row0 = u.pm * BM + wr * 64 + fr;
        if (pn < 12) {
            bf16_t* base; int ldc, colt; float sc = 1.f;
            if (pn < 2) { base = QA; ldc = 512; colt = pn * 256; sc = qscale; }
            else if (pn < 4) { base = KA; ldc = 512; colt = (pn - 2) * 256; }
            else if (pn < 6) { base = VA; ldc = 512; colt = (pn - 4) * 256; }
            else if (pn == 6) { base = QG; ldc = 256; colt = 0; }
            else if (pn == 7) { base = KG; ldc = 256; colt = 0; }
            else if (pn < 10) { base = VG; ldc = 512; colt = (pn - 8) * 256; }
            else { base = GG; ldc = 512; colt = (pn - 10) * 256; }
            const int col0 = colt + wc * 32 + 8 * fq;
#pragma unroll
            for (int ai = 0; ai < 2; ++ai)
#pragma unroll
                for (int m = 0; m < 4; ++m) { bf16_t* rowp = base + (size_t)(row0 + ai * HALF + m * 16) * ldc + col0;
#pragma unroll
                    for (int bj = 0; bj < 2; ++bj) { const f32x4 v0 = acc[ai][bj][m][0] * sc, v1 = acc[ai][bj][m][1] * sc;
                        u32x4 w; w.x = cvt_pk_bf16(v0[0], v0[1]); w.y = cvt_pk_bf16(v0[2], v0[3]); w.z = cvt_pk_bf16(v1[0], v1[1]); w.w = cvt_pk_bf16(v1[2], v1[3]);
                        *(u32x4*)(rowp + bj * HALF) = w; } }
        } else {
            const int col0 = wc * 32 + 8 * fq;
            f32x4 bv[2][2];
#pragma unroll
            for (int bj = 0; bj < 2; ++bj)
#pragma unroll
                for (int n = 0; n < 2; ++n) bv[bj][n] = *(const f32x4*)(bgate + col0 + bj * HALF + 4 * n);
#pragma unroll
            for (int ai = 0; ai < 2; ++ai)
#pragma unroll
                for (int m = 0; m < 4; ++m) { float* rowp = LOGA + (size_t)(row0 + ai * HALF + m * 16) * 256 + col0;
#pragma unroll
                    for (int bj = 0; bj < 2; ++bj)
#pragma unroll
                        for (int n = 0; n < 2; ++n) { const f32x4 z = acc[ai][bj][m][n] + bv[bj][n]; f32x4 la;
#pragma unroll
                            for (int j = 0; j < 4; ++j) la[j] = (__builtin_fminf(z[j], 0.f) - __logf(1.0f + __expf(-__builtin_fabsf(z[j])))) * 0.0625f;
                            *(f32x4*)(rowp + bj * HALF + 4 * n) = la; } }
        }
    }
};
struct EpiConvGlu {
    static constexpr bool PERM = true, AFTER_DRAIN = false;
    bf16_t* ACT; const float* bup; const float* cw; const float* cb; float* HALO; float* FIXS; float* FIXV; PG8_LAS float* H;
    __device__ __forceinline__ void operator()(f32x4 (&acc)[2][2][4][2], const Unit& u, int wr, int wc, int fr, int fq) const {
        constexpr int FFD = 2816; typedef unsigned u32x2 __attribute__((ext_vector_type(2)));
        const int lane = fr + 16 * fq, chl = wc * 32 + 8 * fq, ch0 = u.pn * 128 + chl;
        {   f32x4 bv[2], bg[2];
#pragma unroll
            for (int n = 0; n < 2; ++n) { bv[n] = *(const f32x4*)(bup + ch0 + 4 * n); bg[n] = *(const f32x4*)(bup + FFD + ch0 + 4 * n); }
#pragma unroll
            for (int ai = 0; ai < 2; ++ai)
#pragma unroll
                for (int m = 0; m < 4; ++m)
#pragma unroll
                    for (int n = 0; n < 2; ++n) { acc[ai][1][m][n] += bg[n]; acc[ai][0][m][n] += bv[n]; } }
        if (fr >= 14) {
#pragma unroll
            for (int ai = 0; ai < 2; ++ai) { const int bnd = 2 * ai + wr + 1;
#pragma unroll
                for (int n = 0; n < 2; ++n) {
                    if (bnd < 4) *(PG8_LAS f32x4*)(H + (bnd * 2 + (fr - 14)) * 128 + chl + 4 * n) = acc[ai][1][3][n];
                    else *(f32x4*)(HALO + ((size_t)u.pm * 2 + (fr - 14)) * FFD + ch0 + 4 * n) = acc[ai][1][3][n]; } }
        }
        asm volatile("s_waitcnt lgkmcnt(0)" ::: "memory"); __builtin_amdgcn_s_barrier(); asm volatile("" ::: "memory");
        const int l1 = (lane & 48) | ((fr + 15) & 15), l2 = (lane & 48) | ((fr + 14) & 15), l14 = (lane & 48) | 14, l15 = (lane & 48) | 15;
#pragma unroll
        for (int n = 0; n < 2; ++n) {
            const f32x4 w0 = *(const f32x4*)(cw + ch0 + 4 * n), w1 = *(const f32x4*)(cw + FFD + ch0 + 4 * n), w2 = *(const f32x4*)(cw + 2 * FFD + ch0 + 4 * n), cbv = *(const f32x4*)(cb + ch0 + 4 * n);
#pragma unroll
            for (int ai = 0; ai < 2; ++ai)
#pragma unroll
                for (int m = 0; m < 4; ++m) {
                    f32x4 p14, p15;
                    if (m == 0) { const int bnd = 2 * ai + wr;
                        if (bnd == 0) { p14 = (f32x4){0.f, 0.f, 0.f, 0.f}; p15 = p14; }
                        else { p14 = *(const PG8_LAS f32x4*)(H + (bnd * 2 + 0) * 128 + chl + 4 * n); p15 = *(const PG8_LAS f32x4*)(H + (bnd * 2 + 1) * 128 + chl + 4 * n); }
                    } else {
#pragma unroll
                        for (int j = 0; j < 4; ++j) { p14[j] = __shfl(acc[ai][1][m - 1][n][j], l14); p15[j] = __shfl(acc[ai][1][m - 1][n][j], l15); }
                    }
                    const size_t row = (size_t)u.pm * BM + ai * HALF + wr * 64 + m * 16 + fr;
                    const f32x4 cur = acc[ai][1][m][n]; f32x4 s1, s2;
#pragma unroll
                    for (int j = 0; j < 4; ++j) { s1[j] = __shfl(cur[j], l1); s2[j] = __shfl(cur[j], l2); }
                    const f32x4 pr1 = (fr == 0) ? p15 : s1, pr2 = (fr == 0) ? p14 : ((fr == 1) ? p15 : s2);
                    const f32x4 cv = w0 * pr2 + w1 * pr1 + w2 * cur + cbv, hv = acc[ai][0][m][n];
                    const f32x2 ga = gelu_pk((f32x2){cv[0], cv[1]}), gb = gelu_pk((f32x2){cv[2], cv[3]});
                    u32x2 w; w.x = cvt_pk_bf16(ga.x * hv[0], ga.y * hv[1]); w.y = cvt_pk_bf16(gb.x * hv[2], gb.y * hv[3]);
                    *(u32x2*)(ACT + row * FFD + ch0 + 4 * n) = w;
                    if (ai == 0 && m == 0) { if (wr == 0 && fr < 2) { *(f32x4*)(FIXS + ((size_t)u.pm * 2 + fr) * FFD + ch0 + 4 * n) = cv; *(f32x4*)(FIXV + ((size_t)u.pm * 2 + fr) * FFD + ch0 + 4 * n) = hv; } }
                }
        }
    }
};
}
#include <hip/hip_bf16.h>
#include <cmath>
namespace attn_body {
using bf16=__hip_bfloat16;
using bf16x8=__attribute__((ext_vector_type(8)))short;
using s16x4=__attribute__((ext_vector_type(4)))short;
using f32x16=__attribute__((ext_vector_type(16)))float;
using u32x4=__attribute__((ext_vector_type(4)))unsigned;
using f32x4_t=__attribute__((ext_vector_type(4)))float;
constexpr int BATCH=8,NHEAD=8,SEQ=4096,D=64,DM=NHEAD*D,ODM=1024;
constexpr int NW=8,QBLK=32,QB=QBLK*NW,KVBLK=64,NQB=SEQ/QB;
constexpr int ATTN_UNIT_ROWS=QB;
__device__ __forceinline__ int crow(int r,int hi){return (r&3)+8*(r>>2)+4*hi;}
#define SBAR() __builtin_amdgcn_sched_barrier(0)
__device__ __forceinline__ void cmask(f32x16&p0,f32x16&p1,int jb,int qrel,int hi){
  const float NEG=-INFINITY; int kb=64*jb+4*hi;
  #pragma unroll
  for(int r=0;r<16;++r){int kv=kb+(r&3)+8*(r>>2); if(kv>qrel)p0[r]=NEG; if(kv+32>qrel)p1[r]=NEG;}
}

constexpr int NSLOT=3, SLOTB=8192;
constexpr int LDS_K=0, LDS_V=NSLOT*SLOTB, LDS_WS=2*NSLOT*SLOTB, LDS_OST=LDS_WS+NW*64*4, LDS_KM=LDS_OST+NW*8192, LDS_BYTES=LDS_KM+16*64*4;
constexpr float C2=0.125f*1.4426950408889634f;
__device__ __forceinline__ void glds16(const void*gsrc,unsigned lds_dst){unsigned keep;
  asm volatile("s_mov_b32 %0, m0\n\ts_mov_b32 m0, %2\n\ts_nop 0\n\tglobal_load_lds_dwordx4 %1, off\n\ts_mov_b32 m0, %0":"=&s"(keep):"v"(gsrc),"s"(lds_dst):"memory");}
__device__ __forceinline__ float max3f(float a,float b,float c){float r;asm("v_max3_f32 %0, %1, %2, %3":"=v"(r):"v"(a),"v"(b),"v"(c));return r;}
__device__ __forceinline__ float max2f(float a,float b){float r;asm("v_max_f32_e32 %0, %1, %2":"=v"(r):"v"(a),"v"(b));return r;}
__device__ __forceinline__ float fadd_s(float a,float b){float r;asm("v_add_f32_e32 %0, %1, %2":"=v"(r):"v"(a),"v"(b));return r;}
__device__ __forceinline__ float fsub_s(float a,float b){float r;asm("v_sub_f32_e32 %0, %1, %2":"=v"(r):"v"(a),"v"(b));return r;}
typedef float f32x2_t __attribute__((ext_vector_type(2))); typedef __bf16 bf16x2_t __attribute__((ext_vector_type(2)));
__device__ __forceinline__ unsigned cvtpk_s(float lo,float hi){f32x2_t v={lo,hi};bf16x2_t b=__builtin_convertvector(v,bf16x2_t);return __builtin_bit_cast(unsigned,b);}
#define WAIT_BAR(N) asm volatile("s_waitcnt vmcnt(" #N ") lgkmcnt(0)\n\ts_barrier":::"memory")

__device__ __forceinline__ void qkt(f32x16&p0,f32x16&p1,const char*Kslot,const bf16x8*qr,const f32x16&negm,int r32,int hi){
  const char*kb=Kslot+hi*1024+r32*16;
  #pragma unroll
  for(int d0=0;d0<4;++d0){
    const bf16x8 b0=*reinterpret_cast<const bf16x8*>(kb+d0*2048);
    const bf16x8 b1=*reinterpret_cast<const bf16x8*>(kb+d0*2048+512);
    if(d0==0){p0=__builtin_amdgcn_mfma_f32_32x32x16_bf16(b0,qr[0],negm,0,0,0);p1=__builtin_amdgcn_mfma_f32_32x32x16_bf16(b1,qr[0],negm,0,0,0);}
    else{p0=__builtin_amdgcn_mfma_f32_32x32x16_bf16(b0,qr[d0],p0,0,0,0);p1=__builtin_amdgcn_mfma_f32_32x32x16_bf16(b1,qr[d0],p1,0,0,0);}}
}
typedef __attribute__((address_space(3))) const char* lds_cptr;
typedef short v4i16_t __attribute__((ext_vector_type(4)));
__device__ __forceinline__ void kload8(bf16x8*kf,lds_cptr kp){
  kf[0]=*(const __attribute__((address_space(3))) bf16x8*)(kp);      kf[1]=*(const __attribute__((address_space(3))) bf16x8*)(kp+512);
  kf[2]=*(const __attribute__((address_space(3))) bf16x8*)(kp+2048); kf[3]=*(const __attribute__((address_space(3))) bf16x8*)(kp+2560);
  kf[4]=*(const __attribute__((address_space(3))) bf16x8*)(kp+4096); kf[5]=*(const __attribute__((address_space(3))) bf16x8*)(kp+4608);
  kf[6]=*(const __attribute__((address_space(3))) bf16x8*)(kp+6144); kf[7]=*(const __attribute__((address_space(3))) bf16x8*)(kp+6656);
}
__device__ __forceinline__ void kload2(bf16x8*kf,lds_cptr kp,int j){ kf[2*j]=*(const __attribute__((address_space(3))) bf16x8*)(kp+j*2048); kf[2*j+1]=*(const __attribute__((address_space(3))) bf16x8*)(kp+j*2048+512); }
__device__ __forceinline__ s16x4 vtr(lds_cptr p){ return __builtin_bit_cast(s16x4,__builtin_amdgcn_ds_read_tr16_b64_v4i16((__attribute__((address_space(3))) v4i16_t*)p)); }
__device__ __forceinline__ float rowmax(const f32x16&p0,const f32x16&p1){
  float a=max3f(p0[0],p0[1],p1[0]),b=max3f(p0[2],p0[3],p1[1]);a=max3f(a,p1[2],p1[3]);
  #pragma unroll
  for(int r=4;r<16;r+=4){a=max3f(a,p0[r],p0[r+1]);b=max3f(b,p0[r+2],p0[r+3]);a=max3f(a,p1[r],p1[r+1]);b=max3f(b,p1[r+2],p1[r+3]);}
  const float m=max2f(a,b);
  auto rr=__builtin_amdgcn_permlane32_swap(__float_as_uint(m),__float_as_uint(m),false,false);
  return max2f(__uint_as_float(rr[0]),__uint_as_float(rr[1]));
}
__device__ __forceinline__ void pv(f32x16*o,int vb,bf16x8 pa0,bf16x8 pa1,bf16x8 pa2,bf16x8 pa3){
  #pragma unroll
  for(int d0=0;d0<2;++d0){s16x4 lo[4],hi[4];
    #pragma unroll
    for(int ks=0;ks<4;++ks){
      asm volatile("ds_read_b64_tr_b16 %0,%1 offset:%c2":"=&v"(lo[ks]):"v"(vb),"i"(d0*4096+ks*1024):"memory");
      asm volatile("ds_read_b64_tr_b16 %0,%1 offset:%c2":"=&v"(hi[ks]):"v"(vb),"i"(d0*4096+ks*1024+512):"memory");}
    asm volatile("s_waitcnt lgkmcnt(0)":::"memory");SBAR();
    #define PK(k) (bf16x8){lo[k][0],lo[k][1],lo[k][2],lo[k][3],hi[k][0],hi[k][1],hi[k][2],hi[k][3]}
    o[d0]=__builtin_amdgcn_mfma_f32_32x32x16_bf16(pa0,PK(0),o[d0],0,0,0);
    o[d0]=__builtin_amdgcn_mfma_f32_32x32x16_bf16(pa1,PK(1),o[d0],0,0,0);
    o[d0]=__builtin_amdgcn_mfma_f32_32x32x16_bf16(pa2,PK(2),o[d0],0,0,0);
    o[d0]=__builtin_amdgcn_mfma_f32_32x32x16_bf16(pa3,PK(3),o[d0],0,0,0);
    #undef PK
  }
}

#ifndef ATTN_STORE16
#define ATTN_STORE16(p,v) (*(u32x4*)(p)=(v))
#endif
template<int THRL> __device__ __forceinline__ void attn_unit(int b,int h,int qb,const bf16*Q,const bf16* K,const bf16* V,bf16*O,const float*KMEAN,const float*GN,char*shm){
  int tid=threadIdx.x; asm volatile("":"+v"(tid));
  const int lane=tid&63,r32=lane&31,hi=lane>>5; const int wid=__builtin_amdgcn_readfirstlane(tid>>6);
  const long rowbase=(long)b*SEQ; const int q0=qb*QB;
  const bf16*Qw=Q+(rowbase+q0+wid*QBLK)*DM+h*D;
  const bf16*Kh=K+rowbase*DM+h*D,*Vh=V+rowbase*DM+h*D;
  const unsigned lds0=(unsigned)(uintptr_t)shm;
  float*kmf=(float*)(shm+LDS_KM);
  float*wsf=(float*)(shm+LDS_WS)+wid*64;
  const bf16*ksrc=Kh+(long)lane*DM+wid*8;
  const bf16*vsrc=Vh+(long)(16*(wid&3)+(lane>>2))*DM+(wid>>2)*32+(lane&3)*8;
  const unsigned kdst=lds0+LDS_K+wid*1024, vdst=lds0+LDS_V+wid*1024;
  #define DMA_K(t,slot) glds16(ksrc+(long)(t)*KVBLK*DM,(unsigned)__builtin_amdgcn_readfirstlane(kdst+(slot)))
  #define DMA_V(t,slot) glds16(vsrc+(long)(t)*KVBLK*DM,(unsigned)__builtin_amdgcn_readfirstlane(vdst+(slot)))
  const int vb0=(int)(lds0+LDS_V)+((lane>>4)&1)*32+(lane&3)*8+(4*hi+((lane&15)>>2))*64;
  const char*Kbase=shm+LDS_K; bf16x8 kf[8];
  const lds_cptr shm3=(lds_cptr)shm; const lds_cptr kp0=shm3+LDS_K+hi*1024+r32*16; const lds_cptr vp0=shm3+LDS_V+((lane>>4)&1)*32+(lane&3)*8+(4*hi+((lane&15)>>2))*64;
  const int NT=(q0+QB)/KVBLK;
  { const float*kmg=KMEAN+(long)(b*NHEAD+h)*16*64; for(int i=tid;i<16*64;i+=NW*64)kmf[i]=kmg[i]; }
  __syncthreads();
  DMA_K(0,0);DMA_V(0,0);DMA_K(1,SLOTB);
  bf16x8 qr[4];
  #pragma unroll
  for(int d0=0;d0<4;++d0)qr[d0]=*reinterpret_cast<const bf16x8*>(&Qw[(long)r32*DM+d0*16+hi*8]);
  unsigned selmask=1u<<qb;
  { float qf[32];
    #pragma unroll
    for(int d0=0;d0<4;++d0){
      #pragma unroll
      for(int j=0;j<8;++j)qf[d0*8+j]=__uint_as_float(((unsigned)(unsigned short)qr[d0][j])<<16);}
    float sc[15];
    #pragma unroll
    for(int n=0;n<15;++n){ float a=-INFINITY;
      if(n<qb){ a=0.f;
        #pragma unroll
        for(int d0=0;d0<4;++d0){ const f32x4_t k0=*(const f32x4_t*)(kmf+n*64+d0*16+hi*8), k1=*(const f32x4_t*)(kmf+n*64+d0*16+hi*8+4);
          a+=qf[d0*8+0]*k0[0]; a+=qf[d0*8+1]*k0[1]; a+=qf[d0*8+2]*k0[2]; a+=qf[d0*8+3]*k0[3];
          a+=qf[d0*8+4]*k1[0]; a+=qf[d0*8+5]*k1[1]; a+=qf[d0*8+6]*k1[2]; a+=qf[d0*8+7]*k1[3]; }
        a+=__shfl_xor(a,32); }
      sc[n]=a; }
    #pragma unroll
    for(int k=0;k<3;++k){ if(k<qb){ float best=-INFINITY; int bi=0;
        #pragma unroll
        for(int n=0;n<15;++n){ const bool ok=(n<qb)&&!((selmask>>n)&1u)&&(sc[n]>best); best=ok?sc[n]:best; bi=ok?n:bi; }
        selmask|=1u<<bi; } } }
  float mhat=0.f,l_reg=0.f;f32x16 o[2];o[0]=f32x16{};o[1]=f32x16{};
  #define CINIT(t,C0,C1) { const float cv_=((selmask>>((t)>>2))&1u)?-mhat:-1e30f; _Pragma("unroll") for(int r=0;r<16;++r){C0[r]=cv_;C1[r]=cv_;} } asm volatile("":"+v"(C0),"+v"(C1));
  selmask|=(unsigned)(wid*QBLK+r32)<<16;
  #define qrel ((int)(selmask>>16))
  #define CMASK(P0,P1,t) do{int jb_=(t)-(NT-4); if(jb_>=0)cmask(P0,P1,jb_,qrel,hi);}while(0)
  bool resc=false;
  #define START(P0,P1) do{ const float rm=rowmax(P0,P1); resc=false; \
    { const float dl=(rm<-1e29f)?0.f:rm; mhat=fadd_s(mhat,dl);     \
      _Pragma("unroll") for(int r=0;r<16;++r){P0[r]=fsub_s(P0[r],dl);P1[r]=fsub_s(P1[r],dl);} } \
    _Pragma("unroll") for(int r=0;r<16;++r)P0[r]=__builtin_amdgcn_exp2f(P0[r]); }while(0)
  #define RESC() do{ if(resc){ asm volatile("s_waitcnt lgkmcnt(0)":::"memory"); \
      _Pragma("unroll") for(int d_=0;d_<2;++d_) _Pragma("unroll") for(int r=0;r<16;++r)o[d_][r]*=wsf[crow(r,hi)]; } }while(0)
  f32x16 pA0,pA1,pB0,pB1;
  int sl_prev=0,sl_cur=0,sl_next=SLOTB;
  #define ROT() do{sl_prev=sl_cur;sl_cur=sl_next;sl_next=(sl_next==(NSLOT-1)*SLOTB)?0:sl_next+SLOTB;}while(0)
  DMA_K(2,2*SLOTB);
  WAIT_BAR(3);
  { f32x16 cA_,cB_; CINIT(0,cA_,cB_); qkt(pA0,pA1,Kbase,qr,cA_,r32,hi); } asm volatile("s_nop 15\n\ts_nop 7":"+v"(pA0),"+v"(pA1));CMASK(pA0,pA1,0);
  START(pA0,pA1);
  _Pragma("unroll") for(int r=0;r<16;++r)pA1[r]=__builtin_amdgcn_exp2f(pA1[r]);
  WAIT_BAR(0);
  DMA_K(3,0);DMA_V(1,SLOTB);
  ROT();
  kload8(kf,kp0+sl_cur);
  WAIT_BAR(2);
  s16x4 vlo[8],vhi[8]; u32x4 pw0,pw1,pw2,pw3;
  #define PKW(P,B) cvtpk_s(P[B],P[B+1])
  #define PAF(k) __builtin_bit_cast(bf16x8,pw##k)
  #define VFR(i) (bf16x8){vlo[i][0],vlo[i][1],vlo[i][2],vlo[i][3],vhi[i][0],vhi[i][1],vhi[i][2],vhi[i][3]}
  #define PIN(x) asm volatile("":"+v"(x))
  #define MX3(a,b,c) __builtin_fmaxf(__builtin_fmaxf((a),(b)),(c))
  #define GAPA(MF,A0,A1,A2,A3,W0,W1,PW) do{ MF; sacc+=A0; sacc+=A1; sacc+=A2; sacc+=A3; PIN(sacc); W0; W1; PIN(PW); SBAR(); }while(0)
  #define EX(v) __builtin_amdgcn_exp2f(v)
  #define GAPB(MF,X,B) do{ MF; X[B]=EX(X[B]); X[B+1]=EX(X[B+1]); X[B+2]=EX(X[B+2]); X[B+3]=EX(X[B+3]); PIN(X); SBAR(); }while(0)
  #define VRD(i) do{ vlo[i]=vtr(vp_+(((i)>>2)*4096+((i)&3)*1024)); vhi[i]=vtr(vp_+(((i)>>2)*4096+((i)&3)*1024+512)); }while(0)
  #define KRD(G,j) do{ if(G){ kload2(kf,kp0+sl_next,j); SBAR(); } }while(0)
  #define STEP(C0,C1,P0,P1,t,GK,GV,GL) do{ SBAR(); \
    CINIT(t,C0,C1); SBAR(); \
    const lds_cptr vp_=vp0+sl_prev; \
    VRD(0); SBAR(); float sacc=(P0[0]+P0[1]); \
    GAPA(C0=__builtin_amdgcn_mfma_f32_32x32x16_bf16(kf[0],qr[0],C0,0,0,0), P0[2],P0[3],P0[4],P0[5],     pw0[0]=PKW(P0,0), pw0[1]=PKW(P0,2), pw0); \
    VRD(4); SBAR(); GAPA(C1=__builtin_amdgcn_mfma_f32_32x32x16_bf16(kf[1],qr[0],C1,0,0,0), P0[6],P0[7],P0[8],P0[9],     pw0[2]=PKW(P0,4), pw0[3]=PKW(P0,6), pw0); \
    VRD(1); SBAR(); GAPA(C0=__builtin_amdgcn_mfma_f32_32x32x16_bf16(kf[2],qr[1],C0,0,0,0),   P0[10],P0[11],P0[12],P0[13], pw1[0]=PKW(P0,8), pw1[1]=PKW(P0,10), pw1); \
    VRD(5); SBAR(); GAPA(C1=__builtin_amdgcn_mfma_f32_32x32x16_bf16(kf[3],qr[1],C1,0,0,0),   P0[14],P0[15],P1[0],P1[1],   pw1[2]=PKW(P0,12),pw1[3]=PKW(P0,14), pw1); \
    VRD(2); SBAR(); GAPA(C0=__builtin_amdgcn_mfma_f32_32x32x16_bf16(kf[4],qr[2],C0,0,0,0),   P1[2],P1[3],P1[4],P1[5],     pw2[0]=PKW(P1,0), pw2[1]=PKW(P1,2), pw2); \
    VRD(6); SBAR(); GAPA(C1=__builtin_amdgcn_mfma_f32_32x32x16_bf16(kf[5],qr[2],C1,0,0,0),   P1[6],P1[7],P1[8],P1[9],     pw2[2]=PKW(P1,4), pw2[3]=PKW(P1,6), pw2); \
    VRD(3); SBAR(); GAPA(C0=__builtin_amdgcn_mfma_f32_32x32x16_bf16(kf[6],qr[3],C0,0,0,0),   P1[10],P1[11],P1[12],P1[13], pw3[0]=PKW(P1,8), pw3[1]=PKW(P1,10), pw3); \
    VRD(7); SBAR(); GAPA(C1=__builtin_amdgcn_mfma_f32_32x32x16_bf16(kf[7],qr[3],C1,0,0,0),   P1[14],P1[15],0.f,0.f,       pw3[2]=PKW(P1,12),pw3[3]=PKW(P1,14), pw3); \
    l_reg+=sacc; \
    if(GK){DMA_K((t)+3,sl_cur);} if(GV){DMA_V((t)+1,sl_next);} \
    CMASK(C0,C1,t); \
    { float a=MX3(C0[0],C0[1],C1[0]),b=MX3(C0[2],C0[3],C1[1]); a=MX3(a,C1[2],C1[3]); \
      _Pragma("unroll") for(int r=4;r<16;r+=4){a=MX3(a,C0[r],C0[r+1]);b=MX3(b,C0[r+2],C0[r+3]);a=MX3(a,C1[r],C1[r+1]);b=MX3(b,C1[r+2],C1[r+3]);} \
      float rm=__builtin_fmaxf(a,b); { auto rr=__builtin_amdgcn_permlane32_swap(__float_as_uint(rm),__float_as_uint(rm),false,false); rm=__builtin_fmaxf(__uint_as_float(rr[0]),__uint_as_float(rr[1])); } \
      resc=false; \
      if(__builtin_expect(__any(rm>(float)THRL),0)){ const float dl=__builtin_fmaxf(rm,0.f); mhat+=dl; \
        _Pragma("unroll") for(int r=0;r<16;++r){C0[r]-=dl;C1[r]-=dl;} \
        const float f=__builtin_amdgcn_exp2f(-dl); l_reg*=f; if(hi==0)wsf[r32]=f; resc=true; } } \
    SBAR(); \
    GAPB(o[0]=__builtin_amdgcn_mfma_f32_32x32x16_bf16(PAF(0),VFR(0),o[0],0,0,0), C0,0); \
    GAPB(o[1]=__builtin_amdgcn_mfma_f32_32x32x16_bf16(PAF(0),VFR(4),o[1],0,0,0), C0,4); \
    KRD(GL,0); GAPB(o[0]=__builtin_amdgcn_mfma_f32_32x32x16_bf16(PAF(1),VFR(1),o[0],0,0,0), C0,8); \
    KRD(GL,1); GAPB(o[1]=__builtin_amdgcn_mfma_f32_32x32x16_bf16(PAF(1),VFR(5),o[1],0,0,0), C0,12); \
    KRD(GL,2); GAPB(o[0]=__builtin_amdgcn_mfma_f32_32x32x16_bf16(PAF(2),VFR(2),o[0],0,0,0), C1,0); \
    KRD(GL,3); GAPB(o[1]=__builtin_amdgcn_mfma_f32_32x32x16_bf16(PAF(2),VFR(6),o[1],0,0,0), C1,4); \
    GAPB(o[0]=__builtin_amdgcn_mfma_f32_32x32x16_bf16(PAF(3),VFR(3),o[0],0,0,0), C1,8); \
    GAPB(o[1]=__builtin_amdgcn_mfma_f32_32x32x16_bf16(PAF(3),VFR(7),o[1],0,0,0), C1,12); \
    }while(0)
  int t=1;
  #undef CMASK
  #define CMASK(P0,P1,t) do{}while(0)
  for(;t+5<NT;t+=2){
    STEP(pB0,pB1,pA0,pA1,t,true,true,true);     WAIT_BAR(2); RESC(); ROT();
    STEP(pA0,pA1,pB0,pB1,t+1,true,true,true);   WAIT_BAR(2); RESC(); ROT();
  }
  #undef CMASK
  #define CMASK(P0,P1,t) do{int jb_=(t)-(NT-4); if(jb_>=0)cmask(P0,P1,jb_,qrel,hi);}while(0)
  #define ENDW(tt) do{ if((tt)+3<NT){WAIT_BAR(2);} else if((tt)+2<NT){WAIT_BAR(1);} else {WAIT_BAR(0);} }while(0)
  for(;t+1<NT;t+=2){
    STEP(pB0,pB1,pA0,pA1,t,(t+3<NT),(t+1<NT),(t+1<NT));       ENDW(t);   RESC(); ROT();
    STEP(pA0,pA1,pB0,pB1,t+1,(t+4<NT),(t+2<NT),(t+2<NT));     ENDW(t+1); RESC(); ROT();
  }
  STEP(pB0,pB1,pA0,pA1,NT-1,false,false,false); RESC();
  { float sacc=pB0[0]+pB0[1]; _Pragma("unroll") for(int r=2;r<16;++r)sacc+=pB0[r]; _Pragma("unroll") for(int r=0;r<16;++r)sacc+=pB1[r]; l_reg+=sacc;
    pw0=(u32x4){PKW(pB0,0),PKW(pB0,2),PKW(pB0,4),PKW(pB0,6)};pw1=(u32x4){PKW(pB0,8),PKW(pB0,10),PKW(pB0,12),PKW(pB0,14)};pw2=(u32x4){PKW(pB1,0),PKW(pB1,2),PKW(pB1,4),PKW(pB1,6)};pw3=(u32x4){PKW(pB1,8),PKW(pB1,10),PKW(pB1,12),PKW(pB1,14)};
    SBAR(); pv(o,vb0+sl_cur,PAF(0),PAF(1),PAF(2),PAF(3)); }
  #undef PKW
  #undef PAF
  #undef VFR
  #undef PIN
  #undef MX3
  #undef GAPA
  #undef GAPB
  #undef EX
  #undef VRD
  #undef KRD
  #undef STEP
  #undef ENDW
  {auto rr=__builtin_amdgcn_permlane32_swap(__float_as_uint(l_reg),__float_as_uint(l_reg),false,false);l_reg=__uint_as_float(rr[0])+__uint_as_float(rr[1]);}
  if(hi==0)wsf[32+r32]=l_reg;asm volatile("s_waitcnt lgkmcnt(0)":::"memory");
  float rli[16];
  #pragma unroll
  for(int r=0;r<16;++r)rli[r]=__builtin_amdgcn_rcpf(wsf[32+crow(r,hi)]);
  bf16*Ow=O+(rowbase+q0+wid*QBLK)*ODM+h*D;
  { float*stg=(float*)(shm+LDS_OST)+wid*2048;
    #pragma unroll
    for(int r=0;r<16;++r){const int orow=crow(r,hi);
      #pragma unroll
      for(int d0=0;d0<2;++d0)stg[orow*64+d0*32+r32]=o[d0][r]*rli[r];}
    asm volatile("s_waitcnt lgkmcnt(0)":::"memory");
    const int ch=lane&7; const f32x4_t g0=*(const f32x4_t*)(GN+h*D+ch*8), g1=*(const f32x4_t*)(GN+h*D+ch*8+4);
    #pragma unroll
    for(int i=0;i<4;++i){const int row=i*8+(lane>>3); f32x4_t a=*(const f32x4_t*)(stg+row*64+ch*8), c=*(const f32x4_t*)(stg+row*64+ch*8+4);
      float ss=(a[0]*a[0]+a[1]*a[1])+(a[2]*a[2]+a[3]*a[3])+(c[0]*c[0]+c[1]*c[1])+(c[2]*c[2]+c[3]*c[3]);
      ss+=__shfl_xor(ss,1); ss+=__shfl_xor(ss,2); ss+=__shfl_xor(ss,4);
      const float rs=1.0f/sqrtf(ss*(1.0f/64.0f)+1e-5f); a=a*rs*g0; c=c*rs*g1;
      u32x4 v; v[0]=cvtpk_s(a[0],a[1]); v[1]=cvtpk_s(a[2],a[3]); v[2]=cvtpk_s(c[0],c[1]); v[3]=cvtpk_s(c[2],c[3]);
      ATTN_STORE16(Ow+(long)row*ODM+ch*8,v);} }
  asm volatile("s_waitcnt lgkmcnt(0)\n\ts_barrier":::"memory");
  #undef DMA_K
  #undef DMA_V
  #undef CMASK
  #undef START
  #undef RESC
  #undef ROT
  #undef CINIT
  #undef qrel
}
constexpr int ATTN_LDS_BYTES=LDS_BYTES;
struct AttnTensors { const bf16* Q; const bf16* K; const bf16* V; bf16* O; const float* KMEAN; const float* GN; };
struct AttnUnit { int bh; int qb; };
struct StaticOrder {
  int vcu;
  __device__ __forceinline__ explicit StaticOrder(int grid,int block):vcu((block%8)*(grid/8)+block/8){}
  __device__ __forceinline__ bool next(int i,AttnUnit&u)const{ if(i>=4)return false; const int s=vcu&3; u.bh=vcu>>2; u.qb=(i==0)?s:(i==1)?7-s:(i==2)?8+s:15-s; return true; }
  __device__ __forceinline__ void a_ready(const AttnUnit&)const{}
  __device__ __forceinline__ void done(const AttnUnit&)const{}
};
template<class Sched,int THRL=8> __device__ __forceinline__ void attn_phase(char*lds,const AttnTensors&T,const Sched&S){
  AttnUnit u;
  for(int i=0;S.next(i,u);++i){ S.a_ready(u); attn_unit<THRL>(u.bh/NHEAD,u.bh%NHEAD,u.qb,T.Q,T.K,T.V,T.O,T.KMEAN,T.GN,lds); S.done(u); }
}
#undef SBAR
#undef WAIT_BAR
}
namespace gla {
typedef short bf16x8 __attribute__((ext_vector_type(8)));
typedef short s16x4 __attribute__((ext_vector_type(4)));
typedef float f32x16 __attribute__((ext_vector_type(16)));
typedef float f32x4 __attribute__((ext_vector_type(4)));
typedef unsigned u32x4 __attribute__((ext_vector_type(4)));
typedef unsigned u32x2 __attribute__((ext_vector_type(2)));
typedef short v4i16_t __attribute__((ext_vector_type(4)));
typedef __attribute__((address_space(3))) unsigned char* lptr;
#define GL_LAS __attribute__((address_space(3)))
constexpr int AREA = 32768, KD_OFF = 0, QD_OFF = 8192, VV_OFF = 16384;
constexpr int TAIL_OFF = 136192;
constexpr int EL_OFF = TAIL_OFF, SSQ_OFF = TAIL_OFF + 1024, DT_OFF = TAIL_OFF + 3072;
__device__ __forceinline__ int crow(int r, int hi) { return (r & 3) + 8 * (r >> 2) + 4 * hi; }
__device__ __forceinline__ s16x4 vtr(lptr p) { return __builtin_bit_cast(s16x4, __builtin_amdgcn_ds_read_tr16_b64_v4i16((GL_LAS v4i16_t*)p)); }
__device__ __forceinline__ bf16x8 cat(s16x4 a, s16x4 b) { return (bf16x8){a[0], a[1], a[2], a[3], b[0], b[1], b[2], b[3]}; }
__device__ __forceinline__ unsigned cvtpk(float lo, float hi) { typedef float f2 __attribute__((ext_vector_type(2))); typedef __bf16 b2 __attribute__((ext_vector_type(2))); f2 v = {lo, hi}; b2 b = __builtin_convertvector(v, b2); return __builtin_bit_cast(unsigned, b); }
__device__ __forceinline__ bf16x8 pack8(const f32x16& x, int s) { u32x4 w; w[0] = cvtpk(x[8 * s + 0], x[8 * s + 1]); w[1] = cvtpk(x[8 * s + 2], x[8 * s + 3]); w[2] = cvtpk(x[8 * s + 4], x[8 * s + 5]); w[3] = cvtpk(x[8 * s + 6], x[8 * s + 7]); return __builtin_bit_cast(bf16x8, w); }
__device__ __forceinline__ float b2f(unsigned short v) { return __uint_as_float(((unsigned)v) << 16); }
#define GL_MFMA(a, b, c) __builtin_amdgcn_mfma_f32_32x32x16_bf16(a, b, c, 0, 0, 0)

struct Tensors { const float* LOGA; const unsigned short *QG, *KG, *VG, *GG; unsigned short* MIX; float* FG; float* BLAST; const float* gng; };

template <bool FULL> __device__ __forceinline__ void group(lptr lds, const Tensors& T, int bh, int g) {
    int tid = threadIdx.x; asm volatile("" : "+v"(tid));
    const int lane = tid & 63, r32 = lane & 31, hi = lane >> 5, wid = __builtin_amdgcn_readfirstlane(tid >> 6), p = wid >> 1, hf = wid & 1;
    const int b = bh >> 2, h = bh & 3;
    const lptr area = lds + p * AREA;
    GL_LAS float* EL = (GL_LAS float*)(lds + EL_OFF) + p * 64;
    f32x16 S[2][2];
#pragma unroll
    for (int i = 0; i < 2; ++i)
#pragma unroll
        for (int j = 0; j < 2; ++j) S[i][j] = f32x16{};
    if (FULL && p == 0) {
        GL_LAS float* DT = (GL_LAS float*)(lds + DT_OFF) + hf * 64;
        for (int gp = 0; gp < g; ++gp) {
            float s = 0.f;
#pragma unroll
            for (int n = 0; n < 8; ++n) s += T.BLAST[(size_t)(bh * 64 + gp * 8 + n) * 64 + lane];
            DT[lane] = __expf(s);
            asm volatile("s_waitcnt lgkmcnt(0)" ::: "memory");
            const float* fg = T.FG + ((size_t)(bh * 8 + gp) * 2 + hf) * 4096;
#pragma unroll
            for (int db = 0; db < 2; ++db)
#pragma unroll
                for (int vb = 0; vb < 2; ++vb)
#pragma unroll
                    for (int q = 0; q < 4; ++q) { const f32x4 f = *(const f32x4*)(fg + ((2 * db + vb) * 4 + q) * 256 + lane * 4); const f32x4 d = *(const GL_LAS f32x4*)(DT + 32 * db + 8 * q + 4 * hi);
#pragma unroll
                        for (int i = 0; i < 4; ++i) S[db][vb][4 * q + i] = S[db][vb][4 * q + i] * d[i] + f[i]; }
            asm volatile("s_waitcnt lgkmcnt(0)" ::: "memory");
        }
    }
    const int trb = (4 * hi + ((lane & 15) >> 2)) * 128 + (16 * ((lane >> 4) & 1) + 4 * (lane & 3)) * 2;
    const int rowb = r32 * 128 + 16 * hi;
    const int prmb = r32 * 128 + 8 * hi;
    for (int rd = 0; rd < 2; ++rd) {
        const int n = 8 * g + 4 * rd + p; const size_t T0 = (size_t)b * 4096 + 64 * n;
        if (hf == 0 || FULL) {
            const float* la = T.LOGA + T0 * 256 + 64 * h + lane; const unsigned short* kq = (hf == 0 ? T.KG : T.QG) + T0 * 256 + 64 * h + lane;
            const lptr img = area + (hf == 0 ? KD_OFF : QD_OFF) + lane * 2; float run = 0.f;
#pragma unroll 1
            for (int t0 = 0; t0 < 64; t0 += 16) { float lv[16]; unsigned short kv[16];
#pragma unroll
                for (int i = 0; i < 16; ++i) { lv[i] = la[(size_t)(t0 + i) * 256]; kv[i] = kq[(size_t)(t0 + i) * 256]; }
#pragma unroll
                for (int i = 0; i < 16; ++i) { run += lv[i]; const float e = __expf(hf == 0 ? -run : run); const float v = b2f(kv[i]) * e * (hf == 0 ? 1.0f : 0.125f);
                    *(GL_LAS unsigned short*)(img + (t0 + i) * 128) = (unsigned short)(cvtpk(v, v) & 0xffffu); } }
            if (hf == 0) { EL[lane] = __expf(run); if (!FULL) T.BLAST[(size_t)(bh * 64 + n) * 64 + lane] = run; }
        }
        {
            const unsigned short* vp = T.VG + (T0 + (lane >> 3)) * 512 + 128 * h + 64 * hf + 8 * (lane & 7); const lptr vi = area + VV_OFF + hf * 8192 + (lane >> 3) * 128 + (lane & 7) * 16;
#pragma unroll
            for (int i = 0; i < 8; ++i) *(GL_LAS u32x4*)(vi + i * 1024) = *(const u32x4*)(vp + (size_t)i * 8 * 512);
        }
        __syncthreads();
        const lptr vv = area + VV_OFF + hf * 8192 + trb;
        f32x16 o[2][2];
        if (FULL) {
            bf16x8 PA[3][2];
#pragma unroll
            for (int c = 0; c < 3; ++c) { const int kb = c >> 1, qb = (c + 1) >> 1; f32x16 X = f32x16{};
#pragma unroll
                for (int s = 0; s < 4; ++s) { const bf16x8 a = *(const GL_LAS bf16x8*)(area + KD_OFF + kb * 4096 + rowb + s * 32), bq = *(const GL_LAS bf16x8*)(area + QD_OFF + qb * 4096 + rowb + s * 32);
                    X = GL_MFMA(a, bq, X); }
                if (kb == qb) {
#pragma unroll
                    for (int r = 0; r < 16; ++r) X[r] = (crow(r, hi) <= r32) ? X[r] : 0.f; }
                PA[c][0] = pack8(X, 0); PA[c][1] = pack8(X, 1); }
#pragma unroll
            for (int i = 0; i < 2; ++i)
#pragma unroll
                for (int j = 0; j < 2; ++j) o[i][j] = f32x16{};
#pragma unroll
            for (int vb = 0; vb < 2; ++vb)
#pragma unroll
                for (int sg = 0; sg < 4; ++sg) { const bf16x8 vf = cat(vtr(vv + vb * 64 + sg * 2048), vtr(vv + vb * 64 + sg * 2048 + 1024));
                    if (sg < 2) { o[0][vb] = GL_MFMA(PA[0][sg], vf, o[0][vb]); o[1][vb] = GL_MFMA(PA[1][sg], vf, o[1][vb]); }
                    else o[1][vb] = GL_MFMA(PA[2][sg - 2], vf, o[1][vb]); }
        }
#pragma unroll 1
        for (int s = 0; s < 4; ++s) {
            if (p == s) {
                if (FULL) {
#pragma unroll
                    for (int sg = 0; sg < 4; ++sg) { const bf16x8 sf0 = pack8(S[sg >> 1][0], sg & 1), sf1 = pack8(S[sg >> 1][1], sg & 1);
#pragma unroll
                        for (int qb = 0; qb < 2; ++qb) { const lptr qa = area + QD_OFF + qb * 4096 + prmb + sg * 32;
                            const bf16x8 af = cat(*(const GL_LAS s16x4*)(qa), *(const GL_LAS s16x4*)(qa + 16));
                            o[qb][0] = GL_MFMA(af, sf0, o[qb][0]); o[qb][1] = GL_MFMA(af, sf1, o[qb][1]); } }
                }
#pragma unroll
                for (int sg = 0; sg < 4; ++sg) { const bf16x8 v0 = cat(vtr(vv + sg * 2048), vtr(vv + sg * 2048 + 1024)), v1 = cat(vtr(vv + 64 + sg * 2048), vtr(vv + 64 + sg * 2048 + 1024));
#pragma unroll
                    for (int db = 0; db < 2; ++db) { const lptr ka = area + KD_OFF + trb + db * 64 + sg * 2048; const bf16x8 kf = cat(vtr(ka), vtr(ka + 1024));
                        S[db][0] = GL_MFMA(kf, v0, S[db][0]); S[db][1] = GL_MFMA(kf, v1, S[db][1]); } }
#pragma unroll
                for (int db = 0; db < 2; ++db)
#pragma unroll
                    for (int q = 0; q < 4; ++q) { const f32x4 e = *(const GL_LAS f32x4*)(EL + 32 * db + 8 * q + 4 * hi);
#pragma unroll
                        for (int i = 0; i < 4; ++i) { S[db][0][4 * q + i] *= e[i]; S[db][1][4 * q + i] *= e[i]; } }
            }
            __syncthreads();
            const bool last = (rd == 1 && s == 3);
            const lptr hand = lds + ((s == 3) ? 0 : s) * AREA;
            if (p == s && !last) {
#pragma unroll
                for (int bi = 0; bi < 4; ++bi)
#pragma unroll
                    for (int q = 0; q < 4; ++q) { const lptr d = hand + ((bi < 2) ? (hf == 0 ? KD_OFF : QD_OFF) : (VV_OFF + hf * 8192)) + ((bi & 1) * 4 + q) * 1024 + lane * 16;
                        *(GL_LAS f32x4*)d = (f32x4){S[bi >> 1][bi & 1][4 * q], S[bi >> 1][bi & 1][4 * q + 1], S[bi >> 1][bi & 1][4 * q + 2], S[bi >> 1][bi & 1][4 * q + 3]}; }
            }
            if (!FULL && last && p == 3) {
                float* fg = T.FG + ((size_t)(bh * 8 + g) * 2 + hf) * 4096;
#pragma unroll
                for (int bi = 0; bi < 4; ++bi)
#pragma unroll
                    for (int q = 0; q < 4; ++q) *(f32x4*)(fg + (bi * 4 + q) * 256 + lane * 4) = (f32x4){S[bi >> 1][bi & 1][4 * q], S[bi >> 1][bi & 1][4 * q + 1], S[bi >> 1][bi & 1][4 * q + 2], S[bi >> 1][bi & 1][4 * q + 3]};
            }
            const bool epi = FULL && ((s >= 1 && p == s - 1) || (s == 3 && p == 3));
            const lptr stg = area + VV_OFF + hf * 8192; GL_LAS float* SSQ = (GL_LAS float*)(lds + SSQ_OFF) + p * 128;
            if (epi) {
#pragma unroll
                for (int qb = 0; qb < 2; ++qb)
#pragma unroll
                    for (int vb = 0; vb < 2; ++vb)
#pragma unroll
                        for (int r = 0; r < 16; ++r) *(GL_LAS unsigned short*)(stg + (32 * qb + crow(r, hi)) * 128 + (32 * vb + r32) * 2) = (unsigned short)(cvtpk(o[qb][vb][r], o[qb][vb][r]) & 0xffffu);
                asm volatile("s_waitcnt lgkmcnt(0)" ::: "memory");
#pragma unroll
                for (int i = 0; i < 8; ++i) { const int t = i * 8 + (lane >> 3); const bf16x8 w = *(const GL_LAS bf16x8*)(stg + t * 128 + (lane & 7) * 16); float ss = 0.f;
#pragma unroll
                    for (int j = 0; j < 8; ++j) { const float x = b2f((unsigned short)w[j]); ss += x * x; }
                    ss += __shfl_xor(ss, 1); ss += __shfl_xor(ss, 2); ss += __shfl_xor(ss, 4);
                    if ((lane & 7) == 0) SSQ[hf * 64 + t] = ss; }
            }
            __syncthreads();
            if (!last && p == ((s + 1) & 3) && (s < 3 || rd == 0)) {
#pragma unroll
                for (int bi = 0; bi < 4; ++bi)
#pragma unroll
                    for (int q = 0; q < 4; ++q) { const lptr d = hand + ((bi < 2) ? (hf == 0 ? KD_OFF : QD_OFF) : (VV_OFF + hf * 8192)) + ((bi & 1) * 4 + q) * 1024 + lane * 16; const f32x4 x = *(const GL_LAS f32x4*)d;
#pragma unroll
                        for (int i = 0; i < 4; ++i) S[bi >> 1][bi & 1][4 * q + i] = x[i]; }
            }
            if (epi) {
                const size_t Te = (size_t)b * 4096 + 64 * n; float gn[8];
#pragma unroll
                for (int j = 0; j < 8; ++j) gn[j] = T.gng[128 * h + 64 * hf + 8 * (lane & 7) + j];
#pragma unroll
                for (int i = 0; i < 8; ++i) { const int t = i * 8 + (lane >> 3); const float tot = SSQ[t] + SSQ[64 + t]; const float rs = 1.0f / sqrtf(tot * (1.0f / 128.0f) + 1e-5f);
                    const bf16x8 w = *(const GL_LAS bf16x8*)(stg + t * 128 + (lane & 7) * 16); const bf16x8 gg = *(const bf16x8*)(T.GG + (Te + t) * 512 + 128 * h + 64 * hf + 8 * (lane & 7)); float r[8];
#pragma unroll
                    for (int j = 0; j < 8; ++j) { const float gv = b2f((unsigned short)gg[j]); r[j] = b2f((unsigned short)w[j]) * rs * gn[j] * (gv / (1.0f + __expf(-gv))); }
                    u32x4 ov; ov[0] = cvtpk(r[0], r[1]); ov[1] = cvtpk(r[2], r[3]); ov[2] = cvtpk(r[4], r[5]); ov[3] = cvtpk(r[6], r[7]);
                    *(u32x4*)(T.MIX + (Te + t) * 1024 + 512 + 128 * h + 64 * hf + 8 * (lane & 7)) = ov; }
            }
        }
        __syncthreads();
    }
}
#undef GL_MFMA
#undef GL_LAS
}
#define GAS __attribute__((address_space(1)))
#define LAS __attribute__((address_space(3)))
typedef unsigned short bf16;
typedef unsigned v4u __attribute__((ext_vector_type(4)));
typedef float f32x4 __attribute__((ext_vector_type(4)));
typedef short bf16x8 __attribute__((ext_vector_type(8)));
typedef GAS unsigned gu32;
typedef GAS unsigned long long gu64;
#define RLX_AGENT __ATOMIC_RELAXED, __HIP_MEMORY_SCOPE_AGENT
#define LDS_WAIT() asm volatile("s_waitcnt lgkmcnt(0)" ::: "memory")
#define VM_WAIT() asm volatile("s_waitcnt vmcnt(0)" ::: "memory")
__device__ __forceinline__ unsigned long long rt() { return __builtin_amdgcn_s_memrealtime(); }
__device__ __forceinline__ unsigned f2bf(float f) { unsigned u = __builtin_bit_cast(unsigned, f); return (u + 0x7fffu + ((u >> 16) & 1u)) >> 16; }
__device__ __forceinline__ unsigned pk2(float lo, float hi) { return f2bf(lo) | (f2bf(hi) << 16); }

#define XB_TMO      128
#define XB_XCNT(j)  (256  + 64 * (j))
#define XB_XSUB(j)  (1280 + 64 * (j))
#define XB_XGEN(j)  (2304 + 64 * (j))
#define XB_TOP      3328
#define XB_TOPGEN   3392
#define XCD_BAR_WORDS 3456
#define XB_SPIN_CAP (1u << 18)

__device__ __forceinline__ unsigned xb_ld(unsigned* p)              { return __hip_atomic_load(p, __ATOMIC_RELAXED, __HIP_MEMORY_SCOPE_AGENT); }
__device__ __forceinline__ unsigned xb_add(unsigned* p, unsigned v) { return __hip_atomic_fetch_add(p, v, __ATOMIC_RELAXED, __HIP_MEMORY_SCOPE_AGENT); }
__device__ __forceinline__ unsigned xb_xcc_id() { return (unsigned)__builtin_amdgcn_s_getreg((3 << 11) | 20) & 0xFu; }
#define XB_SPIN(cond, bar) do { unsigned _sp = 0; while (cond) { __builtin_amdgcn_s_sleep(1); \
    if ((++_sp & 255u) == 0u) { if (xb_ld(&(bar)[XB_TMO])) break; if (_sp > XB_SPIN_CAP) { atomicAdd(&(bar)[XB_TMO], 1u); break; } } } } while (0)

struct XcdBarrier {
    unsigned* bar; unsigned x;
    volatile LAS unsigned* st;
};

__device__ __forceinline__ XcdBarrier xcd_barrier_post(unsigned* bar, volatile LAS unsigned* st) {
    XcdBarrier b; b.bar = bar; b.x = xb_xcc_id(); b.st = st;
    if (threadIdx.x == 0) (void)xb_add(&bar[XB_XCNT(b.x)], 1u);
    return b;
}
__device__ __forceinline__ void xcd_barrier_complete(unsigned* bar, unsigned x, unsigned& nloc, unsigned& nx) {
    const unsigned G = gridDim.x * gridDim.y * gridDim.z;
    unsigned sum, cnt, mine, sp = 0u;
    for (;;) {
        sum = 0u; cnt = 0u; mine = 0u;
#pragma unroll
        for (unsigned j = 0; j < 16; ++j) { const unsigned c = xb_ld(&bar[XB_XCNT(j)]); sum += c; cnt += (c > 0u) ? 1u : 0u; mine = (j == x) ? c : mine; }
        if (sum == G) break;
        __builtin_amdgcn_s_sleep(1);
        if ((++sp & 255u) == 0u) { if (xb_ld(&bar[XB_TMO])) break; if (sp > XB_SPIN_CAP) { atomicAdd(&bar[XB_TMO], 1u); break; } }
    }
    nloc = mine > 0u ? mine : 1u; nx = cnt > 0u ? cnt : 1u;
}

__device__ __forceinline__ void xcd_barrier(const XcdBarrier& b) {
    asm volatile("s_waitcnt vmcnt(0)" ::: "memory");
    __syncthreads();
    if (threadIdx.x == 0) {
        unsigned* bar = b.bar;
        __builtin_amdgcn_s_waitcnt(0);
        unsigned nloc = b.st[0], nx = b.st[1];
        if (nloc == 0u) { xcd_barrier_complete(bar, b.x, nloc, nx); b.st[0] = nloc; b.st[1] = nx; }
        const unsigned old = xb_add(&bar[XB_XSUB(b.x)], 1u);
        const unsigned gen = old / nloc;
        if (old + 1u == (gen + 1u) * nloc) {
            __builtin_amdgcn_fence(__ATOMIC_RELEASE, "agent");
            asm volatile("s_waitcnt vmcnt(0)" ::: "memory");
            const unsigned og = xb_add(&bar[XB_TOP], 1u);
            const unsigned tg = og / nx;
            if (og + 1u == (tg + 1u) * nx) xb_add(&bar[XB_TOPGEN], 1u);
            else XB_SPIN(xb_ld(&bar[XB_TOPGEN]) == tg, bar);
            __builtin_amdgcn_fence(__ATOMIC_ACQUIRE, "agent");
            xb_add(&bar[XB_XGEN(b.x)], 1u);
            asm volatile("s_waitcnt vmcnt(0)" ::: "memory");
        } else {
            XB_SPIN(xb_ld(&bar[XB_XGEN(b.x)]) == gen, bar);
            __builtin_amdgcn_fence(__ATOMIC_ACQUIRE, "agent");
            asm volatile("s_waitcnt vmcnt(0)" ::: "memory");
        }
    }
    __syncthreads();
}

constexpr int NWAVES = 8;
#ifndef MK_N_LAUNCHES
#define MK_N_LAUNCHES 1
#endif
constexpr int N_PHASES = 11;
constexpr int N_LAUNCHES = MK_N_LAUNCHES;
static_assert(N_LAUNCHES == 1 || N_LAUNCHES == N_PHASES, "MK_N_LAUNCHES is 1 or 11");

constexpr int BATCH = 8, SEQ = 4096, D = 1024, M = BATCH * SEQ;
constexpr int AW = 512, GKW = 256, GVW = 512, FF = 2816, INW = 3088;
constexpr int NIN = 3328;
constexpr int NGH = 4, GDK = 64, GDV = 128, GCH = 64, NCH = SEQ / GCH;
constexpr float LN_EPS = 1e-5f, ALPHA = 1.189207115002721f;

constexpr size_t MiB = 1u << 20;
constexpr size_t WS_CTL = 0, CTL_ZERO_BYTES = 1 * MiB;
constexpr size_t WS_MODP = 1 * MiB;
constexpr size_t WS_MOD = 4 * MiB;
constexpr size_t WS_KMEAN = 4 * MiB + 256 * 1024;
constexpr size_t WS_DEC = 4 * MiB + 512 * 1024;
constexpr size_t WS_HALO = 5 * MiB, WS_FIXS = 8 * MiB, WS_FIXV = 11 * MiB;
constexpr size_t WS_WIN = 14 * MiB, WS_WO = 21 * MiB, WS_WUP = 23 * MiB, WS_WDN = 34 * MiB;
constexpr size_t WS_XN = 40 * MiB;
constexpr size_t WS_QA = 104 * MiB, WS_KA = 136 * MiB, WS_VA = 168 * MiB, WS_QG = 200 * MiB, WS_KG = 216 * MiB, WS_VG = 232 * MiB, WS_GG = 264 * MiB, WS_LOGA = 296 * MiB;
constexpr size_t WS_KV = 328 * MiB;
constexpr size_t WS_MIX = 392 * MiB;
constexpr size_t WS_Y1 = 104 * MiB;
constexpr size_t WS_X1 = 328 * MiB;
constexpr size_t WS_ACT = 104 * MiB;
constexpr size_t WS_Y2 = 40 * MiB;
constexpr size_t WS_END = 456 * MiB;
static_assert(WS_X1 + (size_t)M * D * 4 <= WS_END && WS_ACT + (size_t)M * FF * 2 <= WS_X1 && WS_MIX + (size_t)M * D * 2 <= WS_END && WS_LOGA + (size_t)M * 256 * 4 <= WS_KV && WS_WDN + (size_t)D * FF * 2 <= WS_XN, "d_ws map");
constexpr int CW_TMO = 0, CW_CODE = 1;
constexpr int CW_BAR = 4096;

constexpr int RING_OFF = 0, RING_BYTES = 131072;
constexpr int LDSCTL_OFF = RING_BYTES, MISC_OFF = LDSCTL_OFF + 320;
constexpr int HTAB_OFF = 132096;
constexpr int LDS_BYTES = 147456;
static_assert(MISC_OFF + 128 <= HTAB_OFF && HTAB_OFF + 4096 <= LDS_BYTES && attn_body::ATTN_LDS_BYTES <= RING_BYTES, "LDS map");

#define CAS __attribute__((address_space(4)))
struct Args { const float* in[19]; float* out; unsigned char* ws; int ph_lo, ph_hi, li, pad; };
struct Frame {
    LAS unsigned char* lds;
    volatile LAS unsigned* MISC;
    gu32* ctl;
    int tid, lane, wave;
    int vcu, G;
    unsigned char* ws;
    const CAS Args* argp;
};
#define ARG_IN(F, k) ({ const CAS Args* p_ = (F).argp; asm volatile("" : "+s"(p_)); p_->in[k]; })
#define ARG_OUT(F) ({ const CAS Args* p_ = (F).argp; asm volatile("" : "+s"(p_)); p_->out; })
enum { I_X = 0, I_C, I_WADA, I_BADA, I_WIN, I_WGATE, I_BGATE, I_ATTNG, I_GLAG, I_WO, I_LN1G, I_LN1B, I_WUP, I_BUP, I_CONVW, I_CONVB, I_WDOWN, I_LN2G, I_LN2B };
__device__ __forceinline__ float bf2f(unsigned short v) { return __uint_as_float(((unsigned)v) << 16); }
__device__ __forceinline__ float wave_sum(float v) {
#pragma unroll
    for (int o = 1; o < 64; o <<= 1) v += __shfl_xor(v, o);
    return v;
}
__device__ __forceinline__ float silu_f(float v) { return v / (1.0f + __expf(-v)); }

__device__ __forceinline__ void p0_transpose_item(const float* W, int pitch, int k0, int n0, bf16* WT, int Kd, int drow0, LAS float* scr, int lane) {
#pragma unroll 8
    for (int i = 0; i < 32; ++i) { const int kk = 2 * i + (lane >> 5); scr[kk * 33 + (lane & 31)] = W[(size_t)(k0 + kk) * pitch + n0 + (lane & 31)]; }
    LDS_WAIT(); asm volatile("" ::: "memory");
    const int c = lane & 7;
#pragma unroll
    for (int j = 0; j < 4; ++j) { const int n = (lane >> 3) + 8 * j; const LAS float* s = scr + (8 * c) * 33 + n;
        v4u o; o.x = pk2(s[0 * 33], s[1 * 33]); o.y = pk2(s[2 * 33], s[3 * 33]); o.z = pk2(s[4 * 33], s[5 * 33]); o.w = pk2(s[6 * 33], s[7 * 33]);
        *(GAS v4u*)(WT + (size_t)(drow0 + n) * Kd + k0 + 8 * c) = o; }
    LDS_WAIT(); asm volatile("" ::: "memory");
}
__device__ __forceinline__ void p0a_prologue(Frame& F) {
    LAS float* scr = (LAS float*)(F.lds + RING_OFF + F.wave * 16384);
    const int gw = F.vcu * NWAVES + F.wave, NGW = F.G * NWAVES, lane = F.lane;
    bf16* Win_t = (bf16*)(F.ws + WS_WIN); bf16* Wo_t = (bf16*)(F.ws + WS_WO); bf16* Wup_t = (bf16*)(F.ws + WS_WUP); bf16* Wdn_t = (bf16*)(F.ws + WS_WDN);
    float* MODP = (float*)(F.ws + WS_MODP);
    const float* c_in = ARG_IN(F, I_C); const float* w_ada = ARG_IN(F, I_WADA); const float* w_in = ARG_IN(F, I_WIN); const float* w_gate = ARG_IN(F, I_WGATE);
    const float* w_o = ARG_IN(F, I_WO); const float* w_up = ARG_IN(F, I_WUP); const float* w_down = ARG_IN(F, I_WDOWN);
    constexpr int I_MOD = 96 * 16, I_IN = 16 * 96, I_O = 16 * 32, I_UP = 16 * 176, I_DN = 44 * 32, I_CB = 16 * 32;
    constexpr int NITEMS = I_MOD + I_IN + I_O + I_UP + I_DN + I_CB;
    for (int it = gw; it < NITEMS; it += NGW) {
        int r = it;
        if (r < I_MOD) {
            const int cg = r % 96, ks = r / 96;
            float sv[8], acc[8];
#pragma unroll
            for (int b = 0; b < 8; ++b) { sv[b] = silu_f(c_in[b * 1024 + 64 * ks + lane]); acc[b] = 0.f; }
            const float* wp = w_ada + (size_t)(64 * ks) * 6144 + 64 * cg + lane;
#pragma unroll 4
            for (int kk = 0; kk < 64; ++kk) { const float w = wp[(size_t)kk * 6144];
#pragma unroll
                for (int b = 0; b < 8; ++b) acc[b] += __int_as_float(__builtin_amdgcn_readlane(__float_as_int(sv[b]), kk)) * w; }
#pragma unroll
            for (int b = 0; b < 8; ++b) MODP[(size_t)(ks * 8 + b) * 6144 + 64 * cg + lane] = acc[b];
            continue; }
        r -= I_MOD;
        if (r < I_IN) { const int kb = r / 96, nb = r % 96; p0_transpose_item(w_in, INW, 64 * kb, 32 * nb, Win_t, D, 32 * nb, scr, lane); continue; } r -= I_IN;
        if (r < I_O) { const int kb = r / 32, nb = r % 32; p0_transpose_item(w_o, D, 64 * kb, 32 * nb, Wo_t, D, 32 * nb, scr, lane); continue; } r -= I_O;
        if (r < I_UP) { const int kb = r / 176, nb = r % 176; const int cc = 32 * nb; const int dr = (cc < FF) ? (256 * (cc / 128) + (cc % 128)) : (256 * ((cc - FF) / 128) + 128 + ((cc - FF) % 128));
            p0_transpose_item(w_up, 2 * FF, 64 * kb, cc, Wup_t, D, dr, scr, lane); continue; } r -= I_UP;
        if (r < I_DN) { const int kb = r / 32, nb = r % 32; p0_transpose_item(w_down, D, 64 * kb, 32 * nb, Wdn_t, FF, 32 * nb, scr, lane); continue; } r -= I_DN;
        {
            const int kb = r / 32, nb = r % 32, k0 = 64 * kb, n = 8 * nb + (lane >> 3), c = lane & 7;
            float g[16], o[8];
#pragma unroll
            for (int rr = 0; rr < 16; ++rr) g[rr] = w_gate[rr * 256 + n];
#pragma unroll
            for (int i = 0; i < 8; ++i) { const float* wr_ = w_in + (size_t)(k0 + 8 * c + i) * INW + 3072;
                const f32x4 a0 = *(const f32x4*)(wr_), a1 = *(const f32x4*)(wr_ + 4), a2 = *(const f32x4*)(wr_ + 8), a3 = *(const f32x4*)(wr_ + 12);
                float s = 0.f;
#pragma unroll
                for (int q = 0; q < 4; ++q) { s += a0[q] * g[q]; s += a1[q] * g[4 + q]; s += a2[q] * g[8 + q]; s += a3[q] * g[12 + q]; }
                o[i] = s; }
            v4u w; w.x = pk2(o[0], o[1]); w.y = pk2(o[2], o[3]); w.z = pk2(o[4], o[5]); w.w = pk2(o[6], o[7]);
            *(GAS v4u*)(Win_t + (size_t)(3072 + n) * D + k0 + 8 * c) = w;
        }
    }
}
__device__ __forceinline__ void ln16(f32x4 (&v)[4]) {
    float s = 0.f;
#pragma unroll
    for (int j = 0; j < 4; ++j) s += (v[j].x + v[j].y) + (v[j].z + v[j].w);
    const float mean = wave_sum(s) * (1.f / D); float s2 = 0.f;
#pragma unroll
    for (int j = 0; j < 4; ++j) { v[j] = v[j] - mean; s2 += (v[j].x * v[j].x + v[j].y * v[j].y) + (v[j].z * v[j].z + v[j].w * v[j].w); }
    const float rstd = 1.f / sqrtf(wave_sum(s2) * (1.f / D) + LN_EPS);
#pragma unroll
    for (int j = 0; j < 4; ++j) v[j] = v[j] * rstd;
}
__device__ __forceinline__ void p0b_adaln1(Frame& F) {
    const int b = F.vcu >> 5, tid = F.tid, lane = F.lane;
    const float* MODP = (const float*)(F.ws + WS_MODP); float* MOD = (float*)(F.ws + WS_MOD);
    LAS float* sv = (LAS float*)(F.lds + RING_OFF);
    const bool writer = (F.vcu & 31) == 0; const float* b_ada = ARG_IN(F, I_BADA); const float* x = ARG_IN(F, I_X);
    for (int j = tid; j < (writer ? 6144 : 2048); j += NWAVES * 64) { float v = b_ada[j];
#pragma unroll
        for (int ks = 0; ks < 16; ++ks) v += MODP[(size_t)(ks * 8 + b) * 6144 + j];
        if (j < 2048) sv[j] = (j >= 1024) ? 1.0f + v : v;
        if (writer) MOD[b * 6144 + j] = v; }
    __syncthreads();
    f32x4 shf[4], scl[4];
#pragma unroll
    for (int j = 0; j < 4; ++j) { shf[j] = *(const LAS f32x4*)(sv + 4 * lane + 256 * j); scl[j] = *(const LAS f32x4*)(sv + 1024 + 4 * lane + 256 * j); }
    bf16* XN = (bf16*)(F.ws + WS_XN);
    for (int r = 0; r < 16; ++r) { const size_t row = (size_t)F.vcu * 128 + F.wave * 16 + r;
        const GAS f32x4* xr = (const GAS f32x4*)(x + row * D) + lane; f32x4 v[4];
#pragma unroll
        for (int j = 0; j < 4; ++j) v[j] = xr[64 * j];
        ln16(v);
        GAS unsigned long long* o8 = (GAS unsigned long long*)(XN + row * D) + lane;
#pragma unroll
        for (int j = 0; j < 4; ++j) { const f32x4 u = v[j] * scl[j] + shf[j]; o8[64 * j] = (unsigned long long)pk2(u.x, u.y) | ((unsigned long long)pk2(u.z, u.w) << 32); } }
    __syncthreads();
}
__device__ __forceinline__ void p3_kmean(Frame& F) {
    const int gw = F.vcu * NWAVES + F.wave, NGW = F.G * NWAVES, lane = F.lane;
    const bf16* KA = (const bf16*)(F.ws + WS_KA); float* KMEAN = (float*)(F.ws + WS_KMEAN);
    for (int it = gw; it < BATCH * 16 * 8; it += NGW) {
        const int h = it & 7, blk = (it >> 3) & 15, b = it >> 7, c = lane & 7, rg = lane >> 3;
        const bf16* p = KA + ((size_t)b * SEQ + blk * 256 + rg) * AW + 64 * h + 8 * c; float a[8];
#pragma unroll
        for (int j = 0; j < 8; ++j) a[j] = 0.f;
#pragma unroll 8
        for (int i = 0; i < 32; ++i) { const bf16x8 q = *(const bf16x8*)(p + (size_t)(8 * i) * AW);
#pragma unroll
            for (int j = 0; j < 8; ++j) a[j] += bf2f(q[j]); }
#pragma unroll
        for (int j = 0; j < 8; ++j) { a[j] += __shfl_xor(a[j], 8); a[j] += __shfl_xor(a[j], 16); a[j] += __shfl_xor(a[j], 32); }
        if (lane < 8) { float* o = KMEAN + ((size_t)(b * 8 + h) * 16 + blk) * 64 + 8 * c;
            *(f32x4*)o = (f32x4){a[0], a[1], a[2], a[3]} * (1.f / 256.f); *(f32x4*)(o + 4) = (f32x4){a[4], a[5], a[6], a[7]} * (1.f / 256.f); }
    }
}
__device__ __forceinline__ gla::Tensors gla_tensors(Frame& F) {
    gla::Tensors T; T.LOGA = (const float*)(F.ws + WS_LOGA); T.QG = (const bf16*)(F.ws + WS_QG); T.KG = (const bf16*)(F.ws + WS_KG); T.VG = (const bf16*)(F.ws + WS_VG); T.GG = (const bf16*)(F.ws + WS_GG);
    T.MIX = (bf16*)(F.ws + WS_MIX); T.FG = (float*)(F.ws + WS_KV); T.BLAST = (float*)(F.ws + WS_DEC); T.gng = ARG_IN(F, I_GLAG); return T;
}
__device__ __forceinline__ void p4b_ln1_adaln2(Frame& F) {
    const int b = F.vcu >> 5, lane = F.lane; const float* MOD = (const float*)(F.ws + WS_MOD) + b * 6144;
    f32x4 g1[4], lg[4], lb[4], scl[4], shf[4]; const float* ln1_g = ARG_IN(F, I_LN1G); const float* ln1_b = ARG_IN(F, I_LN1B); const float* x = ARG_IN(F, I_X);
#pragma unroll
    for (int j = 0; j < 4; ++j) { const int c = 4 * lane + 256 * j; g1[j] = *(const f32x4*)(MOD + 2048 + c); lg[j] = *(const f32x4*)(ln1_g + c); lb[j] = *(const f32x4*)(ln1_b + c);
        shf[j] = *(const f32x4*)(MOD + 3072 + c); scl[j] = *(const f32x4*)(MOD + 4096 + c) + 1.0f; }
    const bf16* Y1 = (const bf16*)(F.ws + WS_Y1); float* X1 = (float*)(F.ws + WS_X1); bf16* XN = (bf16*)(F.ws + WS_XN);
    for (int r = 0; r < 16; ++r) { const size_t row = (size_t)F.vcu * 128 + F.wave * 16 + r;
        const GAS f32x4* xr = (const GAS f32x4*)(x + row * D) + lane; const GAS unsigned long long* yr = (const GAS unsigned long long*)(Y1 + row * D) + lane; f32x4 v[4];
#pragma unroll
        for (int j = 0; j < 4; ++j) { const unsigned long long yw = yr[64 * j]; const f32x4 y = (f32x4){bf2f((unsigned short)yw), bf2f((unsigned short)(yw >> 16)), bf2f((unsigned short)(yw >> 32)), bf2f((unsigned short)(yw >> 48))};
            v[j] = xr[64 * j] * ALPHA + g1[j] * y; }
        ln16(v);
        GAS f32x4* x1r = (GAS f32x4*)(X1 + row * D) + lane;
#pragma unroll
        for (int j = 0; j < 4; ++j) { v[j] = v[j] * lg[j] + lb[j]; x1r[64 * j] = v[j]; }
        ln16(v);
        GAS unsigned long long* o8 = (GAS unsigned long long*)(XN + row * D) + lane;
#pragma unroll
        for (int j = 0; j < 4; ++j) { const f32x4 u = v[j] * scl[j] + shf[j]; o8[64 * j] = (unsigned long long)pk2(u.x, u.y) | ((unsigned long long)pk2(u.z, u.w) << 32); } }
}
__device__ __forceinline__ void p5b_fixup(Frame& F) {
    const float* HALO = (const float*)(F.ws + WS_HALO); const float* FIXS = (const float*)(F.ws + WS_FIXS); const float* FIXV = (const float*)(F.ws + WS_FIXV); bf16* ACT = (bf16*)(F.ws + WS_ACT);
    const int nthr = F.G * NWAVES * 64; const float* conv_w = ARG_IN(F, I_CONVW);
    for (int e = F.vcu * NWAVES * 64 + F.tid; e < 128 * 2 * FF; e += nthr) {
        const int ch = e % FF, rr = (e / FF) & 1, pm = e / (2 * FF);
        if ((pm & 15) == 0) continue;
        const float h14 = HALO[((size_t)(pm - 1) * 2 + 0) * FF + ch], h15 = HALO[((size_t)(pm - 1) * 2 + 1) * FF + ch];
        const float w0 = conv_w[ch], w1 = conv_w[FF + ch];
        const float extra = rr == 0 ? (w0 * h14 + w1 * h15) : (w0 * h15);
        const float cv = FIXS[((size_t)pm * 2 + rr) * FF + ch] + extra;
        ACT[((size_t)pm * 256 + rr) * FF + ch] = (bf16)f2bf(pg8::gelu1(cv) * FIXV[((size_t)pm * 2 + rr) * FF + ch]);
    }
}
__device__ __forceinline__ void p6b_ln2(Frame& F) {
    const int b = F.vcu >> 5, lane = F.lane; const float* MOD = (const float*)(F.ws + WS_MOD) + b * 6144;
    f32x4 g2[4], lg[4], lb[4]; const float* ln2_g = ARG_IN(F, I_LN2G); const float* ln2_b = ARG_IN(F, I_LN2B); float* outp = ARG_OUT(F);
#pragma unroll
    for (int j = 0; j < 4; ++j) { const int c = 4 * lane + 256 * j; g2[j] = *(const f32x4*)(MOD + 5120 + c); lg[j] = *(const f32x4*)(ln2_g + c); lb[j] = *(const f32x4*)(ln2_b + c); }
    const bf16* Y2 = (const bf16*)(F.ws + WS_Y2); const float* X1 = (const float*)(F.ws + WS_X1);
    for (int r = 0; r < 16; ++r) { const size_t row = (size_t)F.vcu * 128 + F.wave * 16 + r;
        const GAS f32x4* xr = (const GAS f32x4*)(X1 + row * D) + lane; const GAS unsigned long long* yr = (const GAS unsigned long long*)(Y2 + row * D) + lane; f32x4 v[4];
#pragma unroll
        for (int j = 0; j < 4; ++j) { const unsigned long long yw = yr[64 * j]; const f32x4 y = (f32x4){bf2f((unsigned short)yw), bf2f((unsigned short)(yw >> 16)), bf2f((unsigned short)(yw >> 32)), bf2f((unsigned short)(yw >> 48))};
            v[j] = xr[64 * j] * ALPHA + g2[j] * y; }
        ln16(v);
        GAS f32x4* orow = (GAS f32x4*)(outp + row * D) + lane;
#pragma unroll
        for (int j = 0; j < 4; ++j) orow[64 * j] = v[j] * lg[j] + lb[j]; }
}

__global__ void __launch_bounds__(NWAVES * 64, 2) mk_fwd(Args args) {
    extern __shared__ __attribute__((aligned(16))) unsigned char lds[];
    Frame F;
    F.lds = (LAS unsigned char*)lds;
    F.MISC = (volatile LAS unsigned*)(F.lds + MISC_OFF);
    F.tid = threadIdx.x; F.lane = F.tid & 63; F.wave = __builtin_amdgcn_readfirstlane(F.tid >> 6);
    F.G = gridDim.x; { const int bx = blockIdx.x; F.vcu = (F.G % 8 == 0) ? (bx % 8) * (F.G / 8) + bx / 8 : bx; }
    F.ws = args.ws; F.ctl = (gu32*)(args.ws + WS_CTL); F.argp = (const CAS Args*)__builtin_amdgcn_kernarg_segment_ptr();
    for (int u = F.tid; u < (LDS_BYTES - LDSCTL_OFF) / 4; u += NWAVES * 64) ((LAS unsigned*)(F.lds + LDSCTL_OFF))[u] = 0u;
    __syncthreads();
    XcdBarrier bar; bar.bar = (unsigned*)(F.ctl + CW_BAR); bar.x = 0; bar.st = nullptr;
    if (N_LAUNCHES == 1) bar = xcd_barrier_post((unsigned*)(F.ctl + CW_BAR), F.MISC + 8);
#define GRID_BAR(seam) do { if (N_LAUNCHES != 1) { if (F.tid == 0) __hip_atomic_store(F.ctl + CW_TMO, 0xBADBA0u | (unsigned)(seam), RLX_AGENT); } else { xcd_barrier(bar); } } while (0)
    const int lo = args.ph_lo, hi = args.ph_hi;
#ifndef MK_PHASE_MASK
#define MK_PHASE_MASK 0x7ff
#endif
#define IN(k) (((MK_PHASE_MASK >> (k)) & 1) && lo <= (k) && (k) < hi)
#define BOTH(k) (IN(k) && IN((k) + 1))
    bf16* XN = (bf16*)(F.ws + WS_XN);
    if (IN(0)) { p0a_prologue(F); if (BOTH(0)) GRID_BAR(0); }
    if (IN(1)) { p0b_adaln1(F); if (BOTH(1)) GRID_BAR(1); }
    if (IN(2)) {
        pg8::Gemm g{XN, (const bf16*)(F.ws + WS_WIN), M, NIN, D}; pg8::StaticOrder S; S.init(M, NIN, F.G, (int)blockIdx.x);
        pg8::EpiInProj E{(bf16*)(F.ws + WS_QA), (bf16*)(F.ws + WS_KA), (bf16*)(F.ws + WS_VA), (bf16*)(F.ws + WS_QG), (bf16*)(F.ws + WS_KG), (bf16*)(F.ws + WS_VG), (bf16*)(F.ws + WS_GG), (float*)(F.ws + WS_LOGA), ARG_IN(F, I_BGATE), attn_body::C2};
        pg8::gemm_phase<pg8::EpiInProj, pg8::StaticOrder, PG8_ALIGN, PG8_SP2>(F.lds + RING_OFF, g, S, E);
        if (BOTH(2)) GRID_BAR(2);
    }
    if (IN(3)) { p3_kmean(F); { const gla::Tensors T = gla_tensors(F); for (int it = F.vcu; it < BATCH * NGH * 8; it += F.G) gla::group<false>((gla::lptr)F.lds, T, it >> 3, it & 7); } if (BOTH(3)) GRID_BAR(3); }
    if (IN(4)) {
        { const gla::Tensors T = gla_tensors(F); for (int it = F.vcu; it < BATCH * NGH * 8; it += F.G) gla::group<true>((gla::lptr)F.lds, T, it >> 3, it & 7); }
        const attn_body::AttnTensors AT{(const attn_body::bf16*)(F.ws + WS_QA), (const attn_body::bf16*)(F.ws + WS_KA), (const attn_body::bf16*)(F.ws + WS_VA), (attn_body::bf16*)(F.ws + WS_MIX), (const float*)(F.ws + WS_KMEAN), ARG_IN(F, I_ATTNG)};
        const attn_body::StaticOrder S((int)F.G, (int)blockIdx.x);
        attn_body::attn_phase<attn_body::StaticOrder>((char*)lds + RING_OFF, AT, S);
        if (BOTH(4)) GRID_BAR(4);
    }
    if (IN(5)) {
        pg8::Gemm g{(const bf16*)(F.ws + WS_MIX), (const bf16*)(F.ws + WS_WO), M, D, D}; pg8::StaticOrder S; S.init(M, D, F.G, (int)blockIdx.x);
        pg8::EpiBf16<0> E{(bf16*)(F.ws + WS_Y1), D, nullptr, 0, 0, 1.f};
        pg8::gemm_phase<pg8::EpiBf16<0>, pg8::StaticOrder, PG8_ALIGN, PG8_SP2>(F.lds + RING_OFF, g, S, E);
        if (BOTH(5)) GRID_BAR(5);
    }
    if (IN(6)) { p4b_ln1_adaln2(F); if (BOTH(6)) GRID_BAR(6); }
    if (IN(7)) {
        pg8::Gemm g{XN, (const bf16*)(F.ws + WS_WUP), M, 2 * FF, D}; pg8::StaticOrder S; S.init(M, 2 * FF, F.G, (int)blockIdx.x);
        pg8::EpiConvGlu E{(bf16*)(F.ws + WS_ACT), ARG_IN(F, I_BUP), ARG_IN(F, I_CONVW), ARG_IN(F, I_CONVB), (float*)(F.ws + WS_HALO), (float*)(F.ws + WS_FIXS), (float*)(F.ws + WS_FIXV), (LAS float*)(F.lds + HTAB_OFF)};
        pg8::gemm_phase<pg8::EpiConvGlu, pg8::StaticOrder, true, PG8_SP2>(F.lds + RING_OFF, g, S, E);
        if (BOTH(7)) GRID_BAR(7);
    }
    if (IN(8)) { p5b_fixup(F); if (BOTH(8)) GRID_BAR(8); }
    if (IN(9)) {
        pg8::Gemm g{(const bf16*)(F.ws + WS_ACT), (const bf16*)(F.ws + WS_WDN), M, D, FF}; pg8::StaticOrder S; S.init(M, D, F.G, (int)blockIdx.x);
        pg8::EpiBf16<0> E{(bf16*)(F.ws + WS_Y2), D, nullptr, 0, 0, 1.f};
        pg8::gemm_phase<pg8::EpiBf16<0>, pg8::StaticOrder, PG8_ALIGN, PG8_SP2>(F.lds + RING_OFF, g, S, E);
        if (BOTH(9)) GRID_BAR(9);
    }
    if (IN(10)) { p6b_ln2(F); }
#undef IN
#undef BOTH
}

extern "C" void kernel_launch(void* const* d_in, const int* in_sizes, int n_in, void* d_out, int out_size, void* d_ws, size_t ws_size, hipStream_t stream) {
    static int grid = 0;
    if (grid == 0) {
        if (n_in != 19 || in_sizes[0] != M * D || out_size != M * D || ws_size < WS_END) { fprintf(stderr, "kernel_launch: built for 19 inputs, x/out of %d floats, >= %zu bytes of workspace; got n_in %d, in0 %d, out %d, ws %zu; nothing launched\n", M * D, (size_t)WS_END, n_in, n_in > 0 ? in_sizes[0] : -1, out_size, ws_size); grid = -1; return; }
        int dev = 0, cus = 0, per_cu = 0;
        if (hipGetDevice(&dev) != hipSuccess || hipDeviceGetAttribute(&cus, hipDeviceAttributeMultiprocessorCount, dev) != hipSuccess) { fprintf(stderr, "kernel_launch: device query failed\n"); grid = -1; return; }
        if (hipFuncSetAttribute((const void*)mk_fwd, hipFuncAttributeMaxDynamicSharedMemorySize, LDS_BYTES) != hipSuccess) { fprintf(stderr, "kernel_launch: hipFuncSetAttribute failed\n"); grid = -1; return; }
        if (hipOccupancyMaxActiveBlocksPerMultiprocessor(&per_cu, (const void*)mk_fwd, NWAVES * 64, LDS_BYTES) != hipSuccess || per_cu < 1)
            fprintf(stderr, "kernel_launch: note: the occupancy query reports %d workgroups per CU\n", per_cu);
        (void)hipGetLastError();
        grid = cus;
        if (grid != 256) { fprintf(stderr, "kernel_launch: this kernel's row split needs exactly 256 CUs, got %d; nothing launched\n", grid); grid = -1; return; }
    }
    if (grid < 0) return;
    if (hipMemsetAsync((char*)d_ws + WS_CTL, 0, CTL_ZERO_BYTES, stream) != hipSuccess) { fprintf(stderr, "kernel_launch: hipMemsetAsync failed\n"); return; }
    Args a{};
    for (int i = 0; i < 19; ++i) a.in[i] = (const float*)d_in[i];
    a.out = (float*)d_out; a.ws = (unsigned char*)d_ws;
    for (int li = 0; li < N_LAUNCHES; ++li) {
        a.ph_lo = (N_LAUNCHES == 1) ? 0 : li; a.ph_hi = (N_LAUNCHES == 1) ? N_PHASES : li + 1; a.li = li;
        hipLaunchKernelGGL(mk_fwd, dim3(grid), dim3(NWAVES * 64), LDS_BYTES, stream, a);
        const hipError_t le = hipPeekAtLastError();
        if (le != hipSuccess) { fprintf(stderr, "kernel_launch: launch %d failed: %s\n", li, hipGetErrorName(le)); break; }
    }
}
```

```cpp
#include <hip/hip_runtime.h>
#include <cstdio>
#include <cstdint>
namespace pg8 {
#define PG8_LAS __attribute__((address_space(3)))
typedef unsigned short bf16_t;
typedef short bf16x8 __attribute__((ext_vector_type(8)));
typedef float f32x4 __attribute__((ext_vector_type(4)));
typedef unsigned u32x4 __attribute__((ext_vector_type(4)));
constexpr int BM = 256, BK = 64, HALF = 128, HTB = HALF * BK * 2  , STAGE_BYTES = 8 * HTB, NXCD = 8, WGM = 8;

__host__ __device__ __forceinline__ int lds_byte(int r, int c) { const int st = (r >> 4) * 2 + (c >> 5), rr = r & 15, cc = c & 31, ob = rr * 64 + cc * 2; return st * 1024 + (ob ^ (((ob >> 9) & 1) << 5)); }
__host__ __device__ __forceinline__ void stage_rc(int b, int& R, int& C) { const int st = b / 1024, sb = b % 1024, swz = sb ^ (((sb >> 9) & 1) << 5); R = (st >> 1) * 16 + swz / 64; C = (st & 1) * 32 + (swz % 64) / 2; }
__host__ __device__ __forceinline__ int perm32(int rho) { const int n = rho >> 4, i = rho & 15; return 8 * (i >> 2) + 4 * n + (i & 3); }

struct Unit { int pm, pn; };
struct Gemm { const bf16_t* A; const bf16_t* Bt; int M, N, K; };

struct StaticOrder {
    int nM, nN, nwg, G, c;
    __host__ __device__ void init(int M, int N, int G_, int c_) { nM = M / BM; nN = N / BM; nwg = nM * nN; G = G_; c = c_; }
    __host__ __device__ bool next(int i, Unit& u) const {
        const long L = (long)i * G + c; if (L >= nwg) return false;
        int wgid = (int)L; { const int q = nwg / NXCD, r = nwg % NXCD, xcd = wgid % NXCD, off = wgid / NXCD; wgid = (xcd < r ? xcd * (q + 1) : r * (q + 1) + (xcd - r) * q) + off; }
        const int nig = WGM * nN, gid = wgid / nig, fm = gid * WGM, gsz = (nM - fm) < WGM ? (nM - fm) : WGM;
        u.pm = fm + ((wgid % nig) % gsz); u.pn = (wgid % nig) / gsz; return true;
    }
    __device__ __forceinline__ void a_ready(const Unit&) const {}
    __device__ __forceinline__ void done(const Unit&) const {}
};

__device__ __forceinline__ unsigned cvt_pk_bf16(float lo, float hi) { unsigned r; asm volatile("v_cvt_pk_bf16_f32 %0, %1, %2" : "=v"(r) : "v"(lo), "v"(hi)); return r; }
typedef float f32x2 __attribute__((ext_vector_type(2)));
__device__ __forceinline__ f32x2 gelu_pk(f32x2 v) {
    const f32x2 av = __builtin_elementwise_abs(v), d = av * 0.2316418882f + 1.0f;
    f32x2 t; t.x = __builtin_amdgcn_rcpf(d.x); t.y = __builtin_amdgcn_rcpf(d.y);
    f32x2 q = t * 0.5307027145f + (-0.7265760135f); q = q * t + 0.7107068705f; q = q * t + (-0.142248368f); q = q * t + 0.127414796f; q = q * t;
    const f32x2 s = (v * v) * (-0.72134752044f);
    f32x2 e; e.x = __builtin_amdgcn_exp2f(s.x); e.y = __builtin_amdgcn_exp2f(s.y);
    const f32x2 m = v * (q * e), r = v - m;
    f32x2 o; o.x = v.x < 0.f ? m.x : r.x; o.y = v.y < 0.f ? m.y : r.y; return o;
}

template <int ACT  > struct EpiBf16 {
    static constexpr bool PERM = true, AFTER_DRAIN = false; static_assert(ACT == 0 || ACT == 1, "EpiBf16: ACT is 0 (none) or 1 (gelu_pk)");
    bf16_t* O; int ldc; const float* bias; int split_cols; size_t split_stride; float scale0;
    __device__ __forceinline__ void operator()(const f32x4 (&acc)[2][2][4][2], const Unit& u, int wr, int wc, int fr, int fq) const {
        const int row0 = u.pm * BM + wr * 64 + fr; int colt = u.pn * BM; bf16_t* base = O;
        float sc = 1.f; if (split_cols) { const int t = colt / split_cols; base += (size_t)t * split_stride; colt -= t * split_cols; if (t == 0) sc = scale0; }
        const int col0 = colt + wc * 32 + 8 * fq, bcol0 = u.pn * BM + wc * 32 + 8 * fq;
        f32x4 bv[2][2];
#pragma unroll
        for (int bj = 0; bj < 2; ++bj)
#pragma unroll
            for (int n = 0; n < 2; ++n) bv[bj][n] = bias ? *(const f32x4*)(bias + bcol0 + bj * HALF + 4 * n) : (f32x4){0.f, 0.f, 0.f, 0.f};
#pragma unroll
        for (int ai = 0; ai < 2; ++ai)
#pragma unroll
            for (int m = 0; m < 4; ++m) { bf16_t* rowp = base + (size_t)(row0 + ai * HALF + m * 16) * ldc + col0;
#pragma unroll
                for (int bj = 0; bj < 2; ++bj) { f32x4 v0 = acc[ai][bj][m][0] + bv[bj][0], v1 = acc[ai][bj][m][1] + bv[bj][1];
                    if (ACT == 1) { f32x2 a = gelu_pk((f32x2){v0[0], v0[1]}), b = gelu_pk((f32x2){v0[2], v0[3]}), c = gelu_pk((f32x2){v1[0], v1[1]}), d = gelu_pk((f32x2){v1[2], v1[3]});
                        v0 = (f32x4){a.x, a.y, b.x, b.y}; v1 = (f32x4){c.x, c.y, d.x, d.y}; }
                    v0 = v0 * sc; v1 = v1 * sc; u32x4 w; w.x = cvt_pk_bf16(v0[0], v0[1]); w.y = cvt_pk_bf16(v0[2], v0[3]); w.z = cvt_pk_bf16(v1[0], v1[1]); w.w = cvt_pk_bf16(v1[2], v1[3]);
                    *(u32x4*)(rowp + bj * HALF) = w; } }
    }
};

template <class Epi, class Sched, bool ALIGN_EPI = false, bool SP2 = false>
__device__ __forceinline__ void gemm_phase(PG8_LAS unsigned char* lds, const Gemm g, const Sched& S, const Epi& E) {
    const int tid = threadIdx.x, wid = __builtin_amdgcn_readfirstlane(tid >> 6), lane = tid & 63, wr = wid >> 2, wc = wid & 3, fr = lane & 15, fq = lane >> 4;
    const int K = g.K, nt = K / BK;
    unsigned voffA[2], voffB[2];
#pragma unroll
    for (int i = 0; i < 2; ++i) { int R, C; stage_rc(tid * 16 + i * 8192, R, C); const int Rb = Epi::PERM ? ((R & ~31) + perm32(R & 31)) : R;
        voffA[i] = (unsigned)(R * K + C) * 2u; voffB[i] = (unsigned)(Rb * K + C) * 2u; }
    const size_t kstep = (size_t)(BK * 2);
    const size_t hstep = (size_t)HALF * K * 2;
    const size_t tstep = 2 * hstep;
    const unsigned ldsw = (unsigned)wid * 1024u;
    const int aoff = lds_byte(wr * 64 + fr, fq * 8), boff = lds_byte(wc * 32 + fr, fq * 8);
#define PG8_SA(b, h) (((b) * 2 + (h)) * HTB)
#define PG8_SB(b, h) ((4 + (b) * 2 + (h)) * HTB)
#define PG8_STAGE(bufoff, gbase, voff) do { _Pragma("unroll") for (int _i = 0; _i < 2; ++_i) \
        __builtin_amdgcn_global_load_lds((const unsigned*)((const char*)(gbase) + (voff)[_i]), (PG8_LAS unsigned*)(lds + (bufoff) + ldsw + _i * 8192), 16, 0, 0); } while (0)
#define PG8_LDA(dst, b, h) do { _Pragma("unroll") for (int m = 0; m < 4; ++m) _Pragma("unroll") for (int k = 0; k < 2; ++k) dst[m][k] = *(const PG8_LAS bf16x8*)(lds + PG8_SA(b, h) + aoff + m * 2048 + k * 1024); } while (0)
#define PG8_LDB(dst, b, h) do { _Pragma("unroll") for (int n = 0; n < 2; ++n) _Pragma("unroll") for (int k = 0; k < 2; ++k) dst[n][k] = *(const PG8_LAS bf16x8*)(lds + PG8_SB(b, h) + boff + n * 2048 + k * 1024); } while (0)
#define PG8_MMA(ai, bj, At, Bt) do { __builtin_amdgcn_s_setprio(1); _Pragma("unroll") for (int m = 0; m < 4; ++m) _Pragma("unroll") for (int n = 0; n < 2; ++n) _Pragma("unroll") for (int k = 0; k < 2; ++k) \
        acc[ai][bj][m][n] = __builtin_amdgcn_mfma_f32_16x16x32_bf16(Bt[n][k], At[m][k], acc[ai][bj][m][n], 0, 0, 0); __builtin_amdgcn_s_setprio(0); } while (0)
#define PG8_WAIT_V(n) asm volatile("s_waitcnt vmcnt(" #n ")" ::: "memory")
#define PG8_WAIT_L(n) asm volatile("s_waitcnt lgkmcnt(" #n ")" ::: "memory")
#define PG8_BAR __builtin_amdgcn_s_barrier()
#define PG8_SCHED __builtin_amdgcn_sched_barrier(0)
    Unit cur, nxt; int ui = 0;
    if (!S.next(0, cur)) return;
    f32x4 acc[2][2][4][2];
#pragma unroll
    for (int a = 0; a < 2; ++a)
#pragma unroll
        for (int b = 0; b < 2; ++b)
#pragma unroll
            for (int m = 0; m < 4; ++m)
#pragma unroll
                for (int n = 0; n < 2; ++n) acc[a][b][m][n] = (f32x4){0.f, 0.f, 0.f, 0.f};
    bf16x8 At[4][2], B0[2][2], B1[2][2];
    const char* cA = (const char*)g.A + (size_t)cur.pm * tstep; const char* cB = (const char*)g.Bt + (size_t)cur.pn * tstep;
    S.a_ready(cur);
    if constexpr (SP2) {
        PG8_STAGE(PG8_SB(0, 0), cB, voffB); PG8_STAGE(PG8_SB(0, 1), cB + hstep, voffB); PG8_STAGE(PG8_SA(0, 0), cA, voffA); PG8_STAGE(PG8_SA(0, 1), cA + hstep, voffA);
        if (wr == 1) PG8_BAR;
        PG8_WAIT_V(2); PG8_BAR;
        PG8_STAGE(PG8_SB(1, 0), cB + kstep, voffB); PG8_STAGE(PG8_SA(1, 0), cA + kstep, voffA); PG8_STAGE(PG8_SB(1, 1), cB + hstep + kstep, voffB);
        PG8_WAIT_V(6); PG8_BAR;
    } else {
        PG8_STAGE(PG8_SB(0, 0), cB, voffB); PG8_STAGE(PG8_SA(0, 0), cA, voffA); PG8_STAGE(PG8_SB(0, 1), cB + hstep, voffB); PG8_STAGE(PG8_SA(0, 1), cA + hstep, voffA);
        if (wr == 1) PG8_BAR;
        PG8_WAIT_V(4); PG8_BAR;
        PG8_STAGE(PG8_SB(1, 0), cB + kstep, voffB); PG8_STAGE(PG8_SA(1, 0), cA + kstep, voffA); PG8_STAGE(PG8_SB(1, 1), cB + hstep + kstep, voffB);
        PG8_WAIT_V(6); PG8_BAR;
    }
    for (;;) {
        const bool has_next = S.next(ui + 1, nxt);
        const char* nA = has_next ? (const char*)g.A + (size_t)nxt.pm * tstep : cA; const char* nB = has_next ? (const char*)g.Bt + (size_t)nxt.pn * tstep : cB;
        for (int t = 0; t < nt; t += 2) {
            const bool last = (t == nt - 2);
            const char* a1 = cA + (size_t)(t + 1) * kstep;
            const char* a2 = last ? nA : cA + (size_t)(t + 2) * kstep; const char* b2 = last ? nB : cB + (size_t)(t + 2) * kstep;
            const char* a3 = a2 + kstep; const char* b3 = b2 + kstep;
            if (last && has_next) S.a_ready(nxt);
            if constexpr (SP2) {
            PG8_LDB(B0, 0, 0); PG8_LDB(B1, 0, 1); PG8_SCHED; PG8_LDA(At, 0, 0); PG8_STAGE(PG8_SA(1, 1), a1 + hstep, voffA);
            PG8_WAIT_V(8); PG8_WAIT_L(0); PG8_BAR; PG8_MMA(0, 0, At, B0); PG8_MMA(0, 1, At, B1); PG8_BAR; PG8_SCHED;
            PG8_LDA(At, 0, 1); PG8_STAGE(PG8_SB(0, 0), b2, voffB); PG8_STAGE(PG8_SB(0, 1), b2 + hstep, voffB); PG8_STAGE(PG8_SA(0, 0), a2, voffA);
            PG8_WAIT_V(8); PG8_WAIT_L(0); PG8_BAR; PG8_MMA(1, 0, At, B0); PG8_MMA(1, 1, At, B1); PG8_BAR; PG8_SCHED;
            PG8_LDB(B0, 1, 0); PG8_LDB(B1, 1, 1); PG8_SCHED; PG8_LDA(At, 1, 0); PG8_STAGE(PG8_SA(0, 1), a2 + hstep, voffA);
            PG8_WAIT_V(8); PG8_WAIT_L(0); PG8_BAR; PG8_MMA(0, 0, At, B0); PG8_MMA(0, 1, At, B1); PG8_BAR; PG8_SCHED;
            PG8_LDA(At, 1, 1); PG8_STAGE(PG8_SB(1, 0), b3, voffB); PG8_STAGE(PG8_SB(1, 1), b3 + hstep, voffB); PG8_STAGE(PG8_SA(1, 0), a3, voffA);
            PG8_WAIT_V(8); PG8_WAIT_L(0); PG8_BAR; PG8_MMA(1, 0, At, B0); PG8_MMA(1, 1, At, B1); PG8_BAR; PG8_SCHED;
            } else {
            PG8_LDB(B0, 0, 0); PG8_SCHED; PG8_LDA(At, 0, 0); PG8_STAGE(PG8_SA(1, 1), a1 + hstep, voffA);
            PG8_WAIT_L(8); PG8_BAR; PG8_WAIT_L(0); PG8_MMA(0, 0, At, B0); PG8_BAR; PG8_SCHED;
            PG8_LDB(B1, 0, 1); PG8_STAGE(PG8_SB(0, 0), b2, voffB);
            PG8_BAR; PG8_WAIT_L(0); PG8_MMA(0, 1, At, B1); PG8_BAR;
            PG8_LDA(At, 0, 1); PG8_STAGE(PG8_SA(0, 0), a2, voffA);
            PG8_BAR; PG8_WAIT_L(0); PG8_MMA(1, 0, At, B0); PG8_BAR; PG8_SCHED;
            PG8_STAGE(PG8_SB(0, 1), b2 + hstep, voffB);
            PG8_WAIT_V(6); PG8_BAR; PG8_MMA(1, 1, At, B1); PG8_BAR;
            PG8_LDB(B0, 1, 0); PG8_SCHED; PG8_LDA(At, 1, 0); PG8_STAGE(PG8_SA(0, 1), a2 + hstep, voffA);
            PG8_WAIT_L(8); PG8_BAR; PG8_WAIT_L(0); PG8_MMA(0, 0, At, B0); PG8_BAR; PG8_SCHED;
            PG8_LDB(B1, 1, 1); PG8_STAGE(PG8_SB(1, 0), b3, voffB);
            PG8_BAR; PG8_WAIT_L(0); PG8_MMA(0, 1, At, B1); PG8_BAR;
            PG8_LDA(At, 1, 1); PG8_STAGE(PG8_SA(1, 0), a3, voffA);
            PG8_BAR; PG8_WAIT_L(0); PG8_MMA(1, 0, At, B0); PG8_BAR; PG8_SCHED;
            PG8_STAGE(PG8_SB(1, 1), b3 + hstep, voffB);
            PG8_WAIT_V(6); PG8_BAR; PG8_MMA(1, 1, At, B1); PG8_BAR;
            }
        }
        if constexpr (ALIGN_EPI) { if (wr == 0) PG8_BAR; }
        if constexpr (!Epi::AFTER_DRAIN) { E(acc, cur, wr, wc, fr, fq); S.done(cur); }
        if (!has_next) break;
#pragma unroll
        for (int a = 0; a < 2; ++a)
#pragma unroll
            for (int b = 0; b < 2; ++b)
#pragma unroll
                for (int m = 0; m < 4; ++m)
#pragma unroll
                    for (int n = 0; n < 2; ++n) acc[a][b][m][n] = (f32x4){0.f, 0.f, 0.f, 0.f};
        cur = nxt; cA = nA; cB = nB; ++ui;
        if constexpr (ALIGN_EPI) { if (wr == 1) PG8_BAR; }
    }
    PG8_WAIT_V(0);
    if constexpr (!ALIGN_EPI) { if (wr == 0) PG8_BAR; }
    PG8_BAR;
    if constexpr (Epi::AFTER_DRAIN) { E.fused(acc, cur, wr, wc, fr, fq, lds, wid, lane); S.done(cur); }
#undef PG8_SA
#undef PG8_SB
#undef PG8_STAGE
#undef PG8_LDA
#undef PG8_LDB
#undef PG8_MMA
#undef PG8_WAIT_V
#undef PG8_WAIT_L
#undef PG8_BAR
#undef PG8_SCHED
}
}

#ifndef PG8_SP2
#define PG8_SP2 true
#endif
#ifndef PG8_ALIGN
#define PG8_ALIGN true
#endif
namespace pg8 {
__device__ __forceinline__ float gelu1(float v) {
    const float av = __builtin_fabsf(v), t = __builtin_amdgcn_rcpf(av * 0.2316418882f + 1.0f);
    float q = t * 0.5307027145f + (-0.7265760135f); q = q * t + 0.7107068705f; q = q * t + (-0.142248368f); q = q * t + 0.127414796f; q = q * t;
    const float e = __builtin_amdgcn_exp2f((v * v) * (-0.72134752044f));
    const float m = v * (q * e), r = v - m; return v < 0.f ? m : r;
}
struct EpiInProj {
    static constexpr bool PERM = true, AFTER_DRAIN = false;
    bf16_t *QA, *KA, *VA, *QG, *KG, *VG, *GG; float* LOGA; const float* bgate; float qscale;
    __device__ __forceinline__ void operator()(f32x4 (&acc)[2][2][4][2], const Unit& u, int wr, int wc, int fr, int fq) const {
        const int pn = u.pn; const int row0 = u.pm * BM + wr * 64 + fr;
        if (pn < 12) {
            bf16_t* base; int ldc, colt; float sc = 1.f;
            if (pn < 2) { base = QA; ldc = 512; colt = pn * 256; sc = qscale; }
            else if (pn < 4) { base = KA; ldc = 512; colt = (pn - 2) * 256; }
            else if (pn < 6) { base = VA; ldc = 512; colt = (pn - 4) * 256; }
            else if (pn == 6) { base = QG; ldc = 256; colt = 0; }
            else if (pn == 7) { base = KG; ldc = 256; colt = 0; }
            else if (pn < 10) { base = VG; ldc = 512; colt = (pn - 8) * 256; }
            else { base = GG; ldc = 512; colt = (pn - 10) * 256; }
            const int col0 = colt + wc * 32 + 8 * fq;
#pragma unroll
            for (int ai = 0; ai < 2; ++ai)
#pragma unroll
                for (int m = 0; m < 4; ++m) { bf16_t* rowp = base + (size_t)(row0 + ai * HALF + m * 16) * ldc + col0;
#pragma unroll
                    for (int bj = 0; bj < 2; ++bj) { const f32x4 v0 = acc[ai][bj][m][0] * sc, v1 = acc[ai][bj][m][1] * sc;
                        u32x4 w; w.x = cvt_pk_bf16(v0[0], v0[1]); w.y = cvt_pk_bf16(v0[2], v0[3]); w.z = cvt_pk_bf16(v1[0], v1[1]); w.w = cvt_pk_bf16(v1[2], v1[3]);
                        *(u32x4*)(rowp + bj * HALF) = w; } }
        } else {
            const int col0 = wc * 32 + 8 * fq;
            f32x4 bv[2][2];
#pragma unroll
            for (int bj = 0; bj < 2; ++bj)
#pragma unroll
                for (int n = 0; n < 2; ++n) bv[bj][n] = *(const f32x4*)(bgate + col0 + bj * HALF + 4 * n);
#pragma unroll
            for (int ai = 0; ai < 2; ++ai)
#pragma unroll
                for (int m = 0; m < 4; ++m) { float* rowp = LOGA + (size_t)(row0 + ai * HALF + m * 16) * 256 + col0;
#pragma unroll
                    for (int bj = 0; bj < 2; ++bj)
#pragma unroll
                        for (int n = 0; n < 2; ++n) { const f32x4 z = acc[ai][bj][m][n] + bv[bj][n]; f32x4 la;
#pragma unroll
                            for (int j = 0; j < 4; ++j) la[j] = (__builtin_fminf(z[j], 0.f) - __logf(1.0f + __expf(-__builtin_fabsf(z[j])))) * 0.0625f;
                            *(f32x4*)(rowp + bj * HALF + 4 * n) = la; } }
        }
    }
};
struct EpiConvGlu {
    static constexpr bool PERM = true, AFTER_DRAIN = false;
    bf16_t* ACT; const float* bup; const float* cw; const float* cb; float* HALO; float* FIXS; float* FIXV; PG8_LAS float* H;
    __device__ __forceinline__ void operator()(f32x4 (&acc)[2][2][4][2], const Unit& u, int wr, int wc, int fr, int fq) const {
        constexpr int FFD = 2816; typedef unsigned u32x2 __attribute__((ext_vector_type(2)));
        const int lane = fr + 16 * fq, chl = wc * 32 + 8 * fq, ch0 = u.pn * 128 + chl;
        {   f32x4 bv[2], bg[2];
#pragma unroll
            for (int n = 0; n < 2; ++n) { bv[n] = *(const f32x4*)(bup + ch0 + 4 * n); bg[n] = *(const f32x4*)(bup + FFD + ch0 + 4 * n); }
#pragma unroll
            for (int ai = 0; ai < 2; ++ai)
#pragma unroll
                for (int m = 0; m < 4; ++m)
#pragma unroll
                    for (int n = 0; n < 2; ++n) { acc[ai][1][m][n] += bg[n]; acc[ai][0][m][n] += bv[n]; } }
        if (fr >= 14) {
#pragma unroll
            for (int ai = 0; ai < 2; ++ai) { const int bnd = 2 * ai + wr + 1;
#pragma unroll
                for (int n = 0; n < 2; ++n) {
                    if (bnd < 4) *(PG8_LAS f32x4*)(H + (bnd * 2 + (fr - 14)) * 128 + chl + 4 * n) = acc[ai][1][3][n];
                    else *(f32x4*)(HALO + ((size_t)u.pm * 2 + (fr - 14)) * FFD + ch0 + 4 * n) = acc[ai][1][3][n]; } }
        }
        asm volatile("s_waitcnt lgkmcnt(0)" ::: "memory"); __builtin_amdgcn_s_barrier(); asm volatile("" ::: "memory");
        const int l1 = (lane & 48) | ((fr + 15) & 15), l2 = (lane & 48) | ((fr + 14) & 15), l14 = (lane & 48) | 14, l15 = (lane & 48) | 15;
#pragma unroll
        for (int n = 0; n < 2; ++n) {
            const f32x4 w0 = *(const f32x4*)(cw + ch0 + 4 * n), w1 = *(const f32x4*)(cw + FFD + ch0 + 4 * n), w2 = *(const f32x4*)(cw + 2 * FFD + ch0 + 4 * n), cbv = *(const f32x4*)(cb + ch0 + 4 * n);
#pragma unroll
            for (int ai = 0; ai < 2; ++ai)
#pragma unroll
                for (int m = 0; m < 4; ++m) {
                    f32x4 p14, p15;
                    if (m == 0) { const int bnd = 2 * ai + wr;
                        if (bnd == 0) { p14 = (f32x4){0.f, 0.f, 0.f, 0.f}; p15 = p14; }
                        else { p14 = *(const PG8_LAS f32x4*)(H + (bnd * 2 + 0) * 128 + chl + 4 * n); p15 = *(const PG8_LAS f32x4*)(H + (bnd * 2 + 1) * 128 + chl + 4 * n); }
                    } else {
#pragma unroll
                        for (int j = 0; j < 4; ++j) { p14[j] = __shfl(acc[ai][1][m - 1][n][j], l14); p15[j] = __shfl(acc[ai][1][m - 1][n][j], l15); }
                    }
                    const size_t row = (size_t)u.pm * BM + ai * HALF + wr * 64 + m * 16 + fr;
                    const f32x4 cur = acc[ai][1][m][n]; f32x4 s1, s2;
#pragma unroll
                    for (int j = 0; j < 4; ++j) { s1[j] = __shfl(cur[j], l1); s2[j] = __shfl(cur[j], l2); }
                    const f32x4 pr1 = (fr == 0) ? p15 : s1, pr2 = (fr == 0) ? p14 : ((fr == 1) ? p15 : s2);
                    const f32x4 cv = w0 * pr2 + w1 * pr1 + w2 * cur + cbv, hv = acc[ai][0][m][n];
                    const f32x2 ga = gelu_pk((f32x2){cv[0], cv[1]}), gb = gelu_pk((f32x2){cv[2], cv[3]});
                    u32x2 w; w.x = cvt_pk_bf16(ga.x * hv[0], ga.y * hv[1]); w.y = cvt_pk_bf16(gb.x * hv[2], gb.y * hv[3]);
                    *(u32x2*)(ACT + row * FFD + ch0 + 4 * n) = w;
                    if (ai == 0 && m == 0) { if (wr == 0 && fr < 2) { *(f32x4*)(FIXS + ((size_t)u.pm * 2 + fr) * FFD + ch0 + 4 * n) = cv; *(f32x4*)(FIXV + ((size_t)u.pm * 2 + fr) * FFD + ch0 + 4 * n) = hv; } }
                }
        }
    }
};
}
#include <hip/hip_bf16.h>
#include <cmath>
namespace attn_body {
using bf16=__hip_bfloat16;
using bf16x8=__attribute__((ext_vector_type(8)))short;
using s16x4=__attribute__((ext_vector_type(4)))short;
using f32x16=__attribute__((ext_vector_type(16)))float;
using u32x4=__attribute__((ext_vector_type(4)))unsigned;
using f32x4_t=__attribute__((ext_vector_type(4)))float;
constexpr int BATCH=8,NHEAD=8,SEQ=4096,D=64,DM=NHEAD*D,ODM=1024;
constexpr int NW=8,QBLK=32,QB=QBLK*NW,KVBLK=64,NQB=SEQ/QB;
constexpr int ATTN_UNIT_ROWS=QB;
__device__ __forceinline__ int crow(int r,int hi){return (r&3)+8*(r>>2)+4*hi;}
#define SBAR() __builtin_amdgcn_sched_barrier(0)
__device__ __forceinline__ void cmask(f32x16&p0,f32x16&p1,int jb,int qrel,int hi){
  const float NEG=-INFINITY; int kb=64*jb+4*hi;
  #pragma unroll
  for(int r=0;r<16;++r){int kv=kb+(r&3)+8*(r>>2); if(kv>qrel)p0[r]=NEG; if(kv+32>qrel)p1[r]=NEG;}
}

constexpr int NSLOT=3, SLOTB=8192;
constexpr int LDS_K=0, LDS_V=NSLOT*SLOTB, LDS_WS=2*NSLOT*SLOTB, LDS_OST=LDS_WS+NW*64*4, LDS_KM=LDS_OST+NW*8192, LDS_BYTES=LDS_KM+16*64*4;
constexpr float C2=0.125f*1.4426950408889634f;
__device__ __forceinline__ void glds16(const void*gsrc,unsigned lds_dst){unsigned keep;
  asm volatile("s_mov_b32 %0, m0\n\ts_mov_b32 m0, %2\n\ts_nop 0\n\tglobal_load_lds_dwordx4 %1, off\n\ts_mov_b32 m0, %0":"=&s"(keep):"v"(gsrc),"s"(lds_dst):"memory");}
__device__ __forceinline__ float max3f(float a,float b,float c){float r;asm("v_max3_f32 %0, %1, %2, %3":"=v"(r):"v"(a),"v"(b),"v"(c));return r;}
__device__ __forceinline__ float max2f(float a,float b){float r;asm("v_max_f32_e32 %0, %1, %2":"=v"(r):"v"(a),"v"(b));return r;}
__device__ __forceinline__ float fadd_s(float a,float b){float r;asm("v_add_f32_e32 %0, %1, %2":"=v"(r):"v"(a),"v"(b));return r;}
__device__ __forceinline__ float fsub_s(float a,float b){float r;asm("v_sub_f32_e32 %0, %1, %2":"=v"(r):"v"(a),"v"(b));return r;}
typedef float f32x2_t __attribute__((ext_vector_type(2))); typedef __bf16 bf16x2_t __attribute__((ext_vector_type(2)));
__device__ __forceinline__ unsigned cvtpk_s(float lo,float hi){f32x2_t v={lo,hi};bf16x2_t b=__builtin_convertvector(v,bf16x2_t);return __builtin_bit_cast(unsigned,b);}
#define WAIT_BAR(N) asm volatile("s_waitcnt vmcnt(" #N ") lgkmcnt(0)\n\ts_barrier":::"memory")

__device__ __forceinline__ void qkt(f32x16&p0,f32x16&p1,const char*Kslot,const bf16x8*qr,const f32x16&negm,int r32,int hi){
  const char*kb=Kslot+hi*1024+r32*16;
  #pragma unroll
  for(int d0=0;d0<4;++d0){
    const bf16x8 b0=*reinterpret_cast<const bf16x8*>(kb+d0*2048);
    const bf16x8 b1=*reinterpret_cast<const bf16x8*>(kb+d0*2048+512);
    if(d0==0){p0=__builtin_amdgcn_mfma_f32_32x32x16_bf16(b0,qr[0],negm,0,0,0);p1=__builtin_amdgcn_mfma_f32_32x32x16_bf16(b1,qr[0],negm,0,0,0);}
    else{p0=__builtin_amdgcn_mfma_f32_32x32x16_bf16(b0,qr[d0],p0,0,0,0);p1=__builtin_amdgcn_mfma_f32_32x32x16_bf16(b1,qr[d0],p1,0,0,0);}}
}
typedef __attribute__((address_space(3))) const char* lds_cptr;
typedef short v4i16_t __attribute__((ext_vector_type(4)));
__device__ __forceinline__ void kload8(bf16x8*kf,lds_cptr kp){
  kf[0]=*(const __attribute__((address_space(3))) bf16x8*)(kp);      kf[1]=*(const __attribute__((address_space(3))) bf16x8*)(kp+512);
  kf[2]=*(const __attribute__((address_space(3))) bf16x8*)(kp+2048); kf[3]=*(const __attribute__((address_space(3))) bf16x8*)(kp+2560);
  kf[4]=*(const __attribute__((address_space(3))) bf16x8*)(kp+4096); kf[5]=*(const __attribute__((address_space(3))) bf16x8*)(kp+4608);
  kf[6]=*(const __attribute__((address_space(3))) bf16x8*)(kp+6144); kf[7]=*(const __attribute__((address_space(3))) bf16x8*)(kp+6656);
}
__device__ __forceinline__ void kload2(bf16x8*kf,lds_cptr kp,int j){ kf[2*j]=*(const __attribute__((address_space(3))) bf16x8*)(kp+j*2048); kf[2*j+1]=*(const __attribute__((address_space(3))) bf16x8*)(kp+j*2048+512); }
__device__ __forceinline__ s16x4 vtr(lds_cptr p){ return __builtin_bit_cast(s16x4,__builtin_amdgcn_ds_read_tr16_b64_v4i16((__attribute__((address_space(3))) v4i16_t*)p)); }
__device__ __forceinline__ float rowmax(const f32x16&p0,const f32x16&p1){
  float a=max3f(p0[0],p0[1],p1[0]),b=max3f(p0[2],p0[3],p1[1]);a=max3f(a,p1[2],p1[3]);
  #pragma unroll
  for(int r=4;r<16;r+=4){a=max3f(a,p0[r],p0[r+1]);b=max3f(b,p0[r+2],p0[r+3]);a=max3f(a,p1[r],p1[r+1]);b=max3f(b,p1[r+2],p1[r+3]);}
  const float m=max2f(a,b);
  auto rr=__builtin_amdgcn_permlane32_swap(__float_as_uint(m),__float_as_uint(m),false,false);
  return max2f(__uint_as_float(rr[0]),__uint_as_float(rr[1]));
}
__device__ __forceinline__ void pv(f32x16*o,int vb,bf16x8 pa0,bf16x8 pa1,bf16x8 pa2,bf16x8 pa3){
  #pragma unroll
  for(int d0=0;d0<2;++d0){s16x4 lo[4],hi[4];
    #pragma unroll
    for(int ks=0;ks<4;++ks){
      asm volatile("ds_read_b64_tr_b16 %0,%1 offset:%c2":"=&v"(lo[ks]):"v"(vb),"i"(d0*4096+ks*1024):"memory");
      asm volatile("ds_read_b64_tr_b16 %0,%1 offset:%c2":"=&v"(hi[ks]):"v"(vb),"i"(d0*4096+ks*1024+512):"memory");}
    asm volatile("s_waitcnt lgkmcnt(0)":::"memory");SBAR();
    #define PK(k) (bf16x8){lo[k][0],lo[k][1],lo[k][2],lo[k][3],hi[k][0],hi[k][1],hi[k][2],hi[k][3]}
    o[d0]=__builtin_amdgcn_mfma_f32_32x32x16_bf16(pa0,PK(0),o[d0],0,0,0);
    o[d0]=__builtin_amdgcn_mfma_f32_32x32x16_bf16(pa1,PK(1),o[d0],0,0,0);
    o[d0]=__builtin_amdgcn_mfma_f32_32x32x16_bf16(pa2,PK(2),o[d0],0,0,0);
    o[d0]=__builtin_amdgcn_mfma_f32_32x32x16_bf16(pa3,PK(3),o[d0],0,0,0);
    #undef PK
  }
}

#ifndef ATTN_STORE16
#define ATTN_STORE16(p,v) (*(u32x4*)(p)=(v))
#endif
template<int THRL> __device__ __forceinline__ void attn_unit(int b,int h,int qb,const bf16*Q,const bf16* K,const bf16* V,bf16*O,const float*KMEAN,const float*GN,char*shm){
  int tid=threadIdx.x; asm volatile("":"+v"(tid));
  const int lane=tid&63,r32=lane&31,hi=lane>>5; const int wid=__builtin_amdgcn_readfirstlane(tid>>6);
  const long rowbase=(long)b*SEQ; const int q0=qb*QB;
  const bf16*Qw=Q+(rowbase+q0+wid*QBLK)*DM+h*D;
  const bf16*Kh=K+rowbase*DM+h*D,*Vh=V+rowbase*DM+h*D;
  const unsigned lds0=(unsigned)(uintptr_t)shm;
  float*kmf=(float*)(shm+LDS_KM);
  float*wsf=(float*)(shm+LDS_WS)+wid*64;
  const bf16*ksrc=Kh+(long)lane*DM+wid*8;
  const bf16*vsrc=Vh+(long)(16*(wid&3)+(lane>>2))*DM+(wid>>2)*32+(lane&3)*8;
  const unsigned kdst=lds0+LDS_K+wid*1024, vdst=lds0+LDS_V+wid*1024;
  #define DMA_K(t,slot) glds16(ksrc+(long)(t)*KVBLK*DM,(unsigned)__builtin_amdgcn_readfirstlane(kdst+(slot)))
  #define DMA_V(t,slot) glds16(vsrc+(long)(t)*KVBLK*DM,(unsigned)__builtin_amdgcn_readfirstlane(vdst+(slot)))
  const int vb0=(int)(lds0+LDS_V)+((lane>>4)&1)*32+(lane&3)*8+(4*hi+((lane&15)>>2))*64;
  const char*Kbase=shm+LDS_K; bf16x8 kf[8];
  const lds_cptr shm3=(lds_cptr)shm; const lds_cptr kp0=shm3+LDS_K+hi*1024+r32*16; const lds_cptr vp0=shm3+LDS_V+((lane>>4)&1)*32+(lane&3)*8+(4*hi+((lane&15)>>2))*64;
  const int NT=(q0+QB)/KVBLK;
  DMA_K(0,0);DMA_V(0,0);DMA_K(1,SLOTB);
  bf16x8 qr[4];
  #pragma unroll
  for(int d0=0;d0<4;++d0)qr[d0]=*reinterpret_cast<const bf16x8*>(&Qw[(long)r32*DM+d0*16+hi*8]);
  unsigned selmask=1u<<qb;
  { float qf[32];
    #pragma unroll
    for(int d0=0;d0<4;++d0){
      #pragma unroll
      for(int j=0;j<8;++j)qf[d0*8+j]=__uint_as_float(((unsigned)(unsigned short)qr[d0][j])<<16);}
    float sc[15];
    #pragma unroll
    for(int n=0;n<15;++n){ float a=-INFINITY;
      if(n<qb){ a=0.f;
        #pragma unroll
        for(int d0=0;d0<4;++d0){ const f32x4_t k0=*(const f32x4_t*)(kmf+n*64+d0*16+hi*8), k1=*(const f32x4_t*)(kmf+n*64+d0*16+hi*8+4);
          a+=qf[d0*8+0]*k0[0]; a+=qf[d0*8+1]*k0[1]; a+=qf[d0*8+2]*k0[2]; a+=qf[d0*8+3]*k0[3];
          a+=qf[d0*8+4]*k1[0]; a+=qf[d0*8+5]*k1[1]; a+=qf[d0*8+6]*k1[2]; a+=qf[d0*8+7]*k1[3]; }
        a+=__shfl_xor(a,32); }
      sc[n]=a; }
    #pragma unroll
    for(int k=0;k<3;++k){ if(k<qb){ float best=-INFINITY; int bi=0;
        #pragma unroll
        for(int n=0;n<15;++n){ const bool ok=(n<qb)&&!((selmask>>n)&1u)&&(sc[n]>best); best=ok?sc[n]:best; bi=ok?n:bi; }
        selmask|=1u<<bi; } } }
  float mhat=0.f,l_reg=0.f;f32x16 o[2];o[0]=f32x16{};o[1]=f32x16{};
  #define CINIT(t,C0,C1) { const float cv_=((selmask>>((t)>>2))&1u)?-mhat:-1e30f; _Pragma("unroll") for(int r=0;r<16;++r){C0[r]=cv_;C1[r]=cv_;} } asm volatile("":"+v"(C0),"+v"(C1));
  selmask|=(unsigned)(wid*QBLK+r32)<<16;
  #define qrel ((int)(selmask>>16))
  #define CMASK(P0,P1,t) do{int jb_=(t)-(NT-4); if(jb_>=0)cmask(P0,P1,jb_,qrel,hi);}while(0)
  bool resc=false;
  #define START(P0,P1) do{ const float rm=rowmax(P0,P1); resc=false; \
    { const float dl=(rm<-1e29f)?0.f:rm; mhat=fadd_s(mhat,dl);     \
      _Pragma("unroll") for(int r=0;r<16;++r){P0[r]=fsub_s(P0[r],dl);P1[r]=fsub_s(P1[r],dl);} } \
    _Pragma("unroll") for(int r=0;r<16;++r)P0[r]=__builtin_amdgcn_exp2f(P0[r]); }while(0)
  #define RESC() do{ if(resc){ asm volatile("s_waitcnt lgkmcnt(0)":::"memory"); \
      _Pragma("unroll") for(int d_=0;d_<2;++d_) _Pragma("unroll") for(int r=0;r<16;++r)o[d_][r]*=wsf[crow(r,hi)]; } }while(0)
  f32x16 pA0,pA1,pB0,pB1;
  int sl_prev=0,sl_cur=0,sl_next=SLOTB;
  #define ROT() do{sl_prev=sl_cur;sl_cur=sl_next;sl_next=(sl_next==(NSLOT-1)*SLOTB)?0:sl_next+SLOTB;}while(0)
  DMA_K(2,2*SLOTB);
  WAIT_BAR(3);
  { f32x16 cA_,cB_; CINIT(0,cA_,cB_); qkt(pA0,pA1,Kbase,qr,cA_,r32,hi); } asm volatile("s_nop 15\n\ts_nop 7":"+v"(pA0),"+v"(pA1));CMASK(pA0,pA1,0);
  START(pA0,pA1);
  _Pragma("unroll") for(int r=0;r<16;++r)pA1[r]=__builtin_amdgcn_exp2f(pA1[r]);
  WAIT_BAR(0);
  DMA_K(3,0);DMA_V(1,SLOTB);
  ROT();
  kload8(kf,kp0+sl_cur);
  WAIT_BAR(2);
  s16x4 vlo[8],vhi[8]; u32x4 pw0,pw1,pw2,pw3;
  #define PKW(P,B) cvtpk_s(P[B],P[B+1])
  #define PAF(k) __builtin_bit_cast(bf16x8,pw##k)
  #define VFR(i) (bf16x8){vlo[i][0],vlo[i][1],vlo[i][2],vlo[i][3],vhi[i][0],vhi[i][1],vhi[i][2],vhi[i][3]}
  #define PIN(x) asm volatile("":"+v"(x))
  #define MX3(a,b,c) __builtin_fmaxf(__builtin_fmaxf((a),(b)),(c))
  #define GAPA(MF,A0,A1,A2,A3,W0,W1,PW) do{ MF; sacc+=A0; sacc+=A1; sacc+=A2; sacc+=A3; PIN(sacc); W0; W1; PIN(PW); SBAR(); }while(0)
  #define EX(v) __builtin_amdgcn_exp2f(v)
  #define GAPB(MF,X,B) do{ MF; X[B]=EX(X[B]); X[B+1]=EX(X[B+1]); X[B+2]=EX(X[B+2]); X[B+3]=EX(X[B+3]); PIN(X); SBAR(); }while(0)
  #define VRD(i) do{ vlo[i]=vtr(vp_+(((i)>>2)*4096+((i)&3)*1024)); vhi[i]=vtr(vp_+(((i)>>2)*4096+((i)&3)*1024+512)); }while(0)
  #define KRD(G,j) do{ if(G){ kload2(kf,kp0+sl_next,j); SBAR(); } }while(0)
  #define STEP(C0,C1,P0,P1,t,GK,GV,GL) do{ SBAR(); \
    CINIT(t,C0,C1); SBAR(); \
    const lds_cptr vp_=vp0+sl_prev; \
    VRD(0); SBAR(); float sacc=(P0[0]+P0[1]); \
    GAPA(C0=__builtin_amdgcn_mfma_f32_32x32x16_bf16(kf[0],qr[0],C0,0,0,0), P0[2],P0[3],P0[4],P0[5],     pw0[0]=PKW(P0,0), pw0[1]=PKW(P0,2), pw0); \
    VRD(4); SBAR(); GAPA(C1=__builtin_amdgcn_mfma_f32_32x32x16_bf16(kf[1],qr[0],C1,0,0,0), P0[6],P0[7],P0[8],P0[9],     pw0[2]=PKW(P0,4), pw0[3]=PKW(P0,6), pw0); \
    VRD(1); SBAR(); GAPA(C0=__builtin_amdgcn_mfma_f32_32x32x16_bf16(kf[2],qr[1],C0,0,0,0),   P0[10],P0[11],P0[12],P0[13], pw1[0]=PKW(P0,8), pw1[1]=PKW(P0,10), pw1); \
    VRD(5); SBAR(); GAPA(C1=__builtin_amdgcn_mfma_f32_32x32x16_bf16(kf[3],qr[1],C1,0,0,0),   P0[14],P0[15],P1[0],P1[1],   pw1[2]=PKW(P0,12),pw1[3]=PKW(P0,14), pw1); \
    VRD(2); SBAR(); GAPA(C0=__builtin_amdgcn_mfma_f32_32x32x16_bf16(kf[4],qr[2],C0,0,0,0),   P1[2],P1[3],P1[4],P1[5],     pw2[0]=PKW(P1,0), pw2[1]=PKW(P1,2), pw2); \
    VRD(6); SBAR(); GAPA(C1=__builtin_amdgcn_mfma_f32_32x32x16_bf16(kf[5],qr[2],C1,0,0,0),   P1[6],P1[7],P1[8],P1[9],     pw2[2]=PKW(P1,4), pw2[3]=PKW(P1,6), pw2); \
    VRD(3); SBAR(); GAPA(C0=__builtin_amdgcn_mfma_f32_32x32x16_bf16(kf[6],qr[3],C0,0,0,0),   P1[10],P1[11],P1[12],P1[13], pw3[0]=PKW(P1,8), pw3[1]=PKW(P1,10), pw3); \
    VRD(7); SBAR(); GAPA(C1=__builtin_amdgcn_mfma_f32_32x32x16_bf16(kf[7],qr[3],C1,0,0,0),   P1[14],P1[15],0.f,0.f,       pw3[2]=PKW(P1,12),pw3[3]=PKW(P1,14), pw3); \
    l_reg+=sacc; \
    if(GK){DMA_K((t)+3,sl_cur);} if(GV){DMA_V((t)+1,sl_next);} \
    CMASK(C0,C1,t); \
    { float a=MX3(C0[0],C0[1],C1[0]),b=MX3(C0[2],C0[3],C1[1]); a=MX3(a,C1[2],C1[3]); \
      _Pragma("unroll") for(int r=4;r<16;r+=4){a=MX3(a,C0[r],C0[r+1]);b=MX3(b,C0[r+2],C0[r+3]);a=MX3(a,C1[r],C1[r+1]);b=MX3(b,C1[r+2],C1[r+3]);} \
      float rm=__builtin_fmaxf(a,b); { auto rr=__builtin_amdgcn_permlane32_swap(__float_as_uint(rm),__float_as_uint(rm),false,false); rm=__builtin_fmaxf(__uint_as_float(rr[0]),__uint_as_float(rr[1])); } \
      resc=false; \
      if(__builtin_expect(__any(rm>(float)THRL),0)){ const float dl=__builtin_fmaxf(rm,0.f); mhat+=dl; \
        _Pragma("unroll") for(int r=0;r<16;++r){C0[r]-=dl;C1[r]-=dl;} \
        const float f=__builtin_amdgcn_exp2f(-dl); l_reg*=f; if(hi==0)wsf[r32]=f; resc=true; } } \
    SBAR(); \
    GAPB(o[0]=__builtin_amdgcn_mfma_f32_32x32x16_bf16(PAF(0),VFR(0),o[0],0,0,0), C0,0); \
    GAPB(o[1]=__builtin_amdgcn_mfma_f32_32x32x16_bf16(PAF(0),VFR(4),o[1],0,0,0), C0,4); \
    KRD(GL,0); GAPB(o[0]=__builtin_amdgcn_mfma_f32_32x32x16_bf16(PAF(1),VFR(1),o[0],0,0,0), C0,8); \
    KRD(GL,1); GAPB(o[1]=__builtin_amdgcn_mfma_f32_32x32x16_bf16(PAF(1),VFR(5),o[1],0,0,0), C0,12); \
    KRD(GL,2); GAPB(o[0]=__builtin_amdgcn_mfma_f32_32x32x16_bf16(PAF(2),VFR(2),o[0],0,0,0), C1,0); \
    KRD(GL,3); GAPB(o[1]=__builtin_amdgcn_mfma_f32_32x32x16_bf16(PAF(2),VFR(6),o[1],0,0,0), C1,4); \
    GAPB(o[0]=__builtin_amdgcn_mfma_f32_32x32x16_bf16(PAF(3),VFR(3),o[0],0,0,0), C1,8); \
    GAPB(o[1]=__builtin_amdgcn_mfma_f32_32x32x16_bf16(PAF(3),VFR(7),o[1],0,0,0), C1,12); \
    }while(0)
  int t=1;
  #undef CMASK
  #define CMASK(P0,P1,t) do{}while(0)
  for(;t+5<NT;t+=2){
    STEP(pB0,pB1,pA0,pA1,t,true,true,true);     WAIT_BAR(2); RESC(); ROT();
    STEP(pA0,pA1,pB0,pB1,t+1,true,true,true);   WAIT_BAR(2); RESC(); ROT();
  }
  #undef CMASK
  #define CMASK(P0,P1,t) do{int jb_=(t)-(NT-4); if(jb_>=0)cmask(P0,P1,jb_,qrel,hi);}while(0)
  #define ENDW(tt) do{ if((tt)+3<NT){WAIT_BAR(2);} else if((tt)+2<NT){WAIT_BAR(1);} else {WAIT_BAR(0);} }while(0)
  for(;t+1<NT;t+=2){
    STEP(pB0,pB1,pA0,pA1,t,(t+3<NT),(t+1<NT),(t+1<NT));       ENDW(t);   RESC(); ROT();
    STEP(pA0,pA1,pB0,pB1,t+1,(t+4<NT),(t+2<NT),(t+2<NT));     ENDW(t+1); RESC(); ROT();
  }
  STEP(pB0,pB1,pA0,pA1,NT-1,false,false,false); RESC();
  { float sacc=pB0[0]+pB0[1]; _Pragma("unroll") for(int r=2;r<16;++r)sacc+=pB0[r]; _Pragma("unroll") for(int r=0;r<16;++r)sacc+=pB1[r]; l_reg+=sacc;
    pw0=(u32x4){PKW(pB0,0),PKW(pB0,2),PKW(pB0,4),PKW(pB0,6)};pw1=(u32x4){PKW(pB0,8),PKW(pB0,10),PKW(pB0,12),PKW(pB0,14)};pw2=(u32x4){PKW(pB1,0),PKW(pB1,2),PKW(pB1,4),PKW(pB1,6)};pw3=(u32x4){PKW(pB1,8),PKW(pB1,10),PKW(pB1,12),PKW(pB1,14)};
    SBAR(); pv(o,vb0+sl_cur,PAF(0),PAF(1),PAF(2),PAF(3)); }
  #undef PKW
  #undef PAF
  #undef VFR
  #undef PIN
  #undef MX3
  #undef GAPA
  #undef GAPB
  #undef EX
  #undef VRD
  #undef KRD
  #undef STEP
  #undef ENDW
  {auto rr=__builtin_amdgcn_permlane32_swap(__float_as_uint(l_reg),__float_as_uint(l_reg),false,false);l_reg=__uint_as_float(rr[0])+__uint_as_float(rr[1]);}
  if(hi==0)wsf[32+r32]=l_reg;asm volatile("s_waitcnt lgkmcnt(0)":::"memory");
  float rli[16];
  #pragma unroll
  for(int r=0;r<16;++r)rli[r]=__builtin_amdgcn_rcpf(wsf[32+crow(r,hi)]);
  bf16*Ow=O+(rowbase+q0+wid*QBLK)*ODM+h*D;
  { float*stg=(float*)(shm+LDS_OST)+wid*2048;
    #pragma unroll
    for(int r=0;r<16;++r){const int orow=crow(r,hi);
      #pragma unroll
      for(int d0=0;d0<2;++d0)stg[orow*64+d0*32+r32]=o[d0][r]*rli[r];}
    asm volatile("s_waitcnt lgkmcnt(0)":::"memory");
    const int ch=lane&7; const f32x4_t g0=*(const f32x4_t*)(GN+h*D+ch*8), g1=*(const f32x4_t*)(GN+h*D+ch*8+4);
    #pragma unroll
    for(int i=0;i<4;++i){const int row=i*8+(lane>>3); f32x4_t a=*(const f32x4_t*)(stg+row*64+ch*8), c=*(const f32x4_t*)(stg+row*64+ch*8+4);
      float ss=(a[0]*a[0]+a[1]*a[1])+(a[2]*a[2]+a[3]*a[3])+(c[0]*c[0]+c[1]*c[1])+(c[2]*c[2]+c[3]*c[3]);
      ss+=__shfl_xor(ss,1); ss+=__shfl_xor(ss,2); ss+=__shfl_xor(ss,4);
      const float rs=1.0f/sqrtf(ss*(1.0f/64.0f)+1e-5f); a=a*rs*g0; c=c*rs*g1;
      u32x4 v; v[0]=cvtpk_s(a[0],a[1]); v[1]=cvtpk_s(a[2],a[3]); v[2]=cvtpk_s(c[0],c[1]); v[3]=cvtpk_s(c[2],c[3]);
      ATTN_STORE16(Ow+(long)row*ODM+ch*8,v);} }
  asm volatile("s_waitcnt lgkmcnt(0)\n\ts_barrier":::"memory");
  #undef DMA_K
  #undef DMA_V
  #undef CMASK
  #undef START
  #undef RESC
  #undef ROT
  #undef CINIT
  #undef qrel
}
constexpr int ATTN_LDS_BYTES=LDS_BYTES;
struct AttnTensors { const bf16* Q; const bf16* K; const bf16* V; bf16* O; const float* KMEAN; const float* GN; };
struct AttnUnit { int bh; int qb; };
struct StaticOrder {
  int vcu;
  __device__ __forceinline__ explicit StaticOrder(int grid,int block):vcu((block%8)*(grid/8)+block/8){}
  __device__ __forceinline__ bool next(int i,AttnUnit&u)const{ if(i>=4)return false; const int s=vcu&3; u.bh=vcu>>2; u.qb=(i==0)?s:(i==1)?7-s:(i==2)?8+s:15-s; return true; }
  __device__ __forceinline__ void a_ready(const AttnUnit&)const{}
  __device__ __forceinline__ void done(const AttnUnit&)const{}
};
template<class Sched,int THRL=8> __device__ __forceinline__ void attn_phase(char*lds,const AttnTensors&T,const Sched&S){
  AttnUnit u;
  if(S.next(0,u)){ const float*kmg=T.KMEAN+(long)u.bh*16*64; float*kmf=(float*)(lds+LDS_KM); for(int i=threadIdx.x;i<16*64;i+=NW*64)kmf[i]=kmg[i]; }
  __syncthreads();
  for(int i=0;S.next(i,u);++i){ S.a_ready(u); attn_unit<THRL>(u.bh/NHEAD,u.bh%NHEAD,u.qb,T.Q,T.K,T.V,T.O,T.KMEAN,T.GN,lds); S.done(u); }
}
#undef SBAR
#undef WAIT_BAR
}
namespace gla {
typedef short bf16x8 __attribute__((ext_vector_type(8)));
typedef short s16x4 __attribute__((ext_vector_type(4)));
typedef float f32x16 __attribute__((ext_vector_type(16)));
typedef float f32x4 __attribute__((ext_vector_type(4)));
typedef unsigned u32x4 __attribute__((ext_vector_type(4)));
typedef unsigned u32x2 __attribute__((ext_vector_type(2)));
typedef short v4i16_t __attribute__((ext_vector_type(4)));
typedef __attribute__((address_space(3))) unsigned char* lptr;
#define GL_LAS __attribute__((address_space(3)))
constexpr int AREA = 32768, KD_OFF = 0, QD_OFF = 8192, VV_OFF = 16384;
constexpr int TAIL_OFF = 136192;
constexpr int EL_OFF = TAIL_OFF, SSQ_OFF = TAIL_OFF + 1024, DT_OFF = TAIL_OFF + 3072;
__device__ __forceinline__ int crow(int r, int hi) { return (r & 3) + 8 * (r >> 2) + 4 * hi; }
__device__ __forceinline__ s16x4 vtr(lptr p) { return __builtin_bit_cast(s16x4, __builtin_amdgcn_ds_read_tr16_b64_v4i16((GL_LAS v4i16_t*)p)); }
__device__ __forceinline__ bf16x8 cat(s16x4 a, s16x4 b) { return (bf16x8){a[0], a[1], a[2], a[3], b[0], b[1], b[2], b[3]}; }
__device__ __forceinline__ unsigned cvtpk(float lo, float hi) { typedef float f2 __attribute__((ext_vector_type(2))); typedef __bf16 b2 __attribute__((ext_vector_type(2))); f2 v = {lo, hi}; b2 b = __builtin_convertvector(v, b2); return __builtin_bit_cast(unsigned, b); }
__device__ __forceinline__ bf16x8 pack8(const f32x16& x, int s) { u32x4 w; w[0] = cvtpk(x[8 * s + 0], x[8 * s + 1]); w[1] = cvtpk(x[8 * s + 2], x[8 * s + 3]); w[2] = cvtpk(x[8 * s + 4], x[8 * s + 5]); w[3] = cvtpk(x[8 * s + 6], x[8 * s + 7]); return __builtin_bit_cast(bf16x8, w); }
__device__ __forceinline__ float b2f(unsigned short v) { return __uint_as_float(((unsigned)v) << 16); }
#define GL_MFMA(a, b, c) __builtin_amdgcn_mfma_f32_32x32x16_bf16(a, b, c, 0, 0, 0)

struct Tensors { const float* LOGA; const unsigned short *QG, *KG, *VG, *GG; unsigned short* MIX; float* FG; float* BLAST; const float* gng; };

template <bool FULL> __device__ __forceinline__ void group(lptr lds, const Tensors& T, int bh, int g) {
    int tid = threadIdx.x; asm volatile("" : "+v"(tid));
    const int lane = tid & 63, r32 = lane & 31, hi = lane >> 5, wid = __builtin_amdgcn_readfirstlane(tid >> 6), p = wid >> 1, hf = wid & 1;
    const int b = bh >> 2, h = bh & 3;
    const lptr area = lds + p * AREA;
    GL_LAS float* EL = (GL_LAS float*)(lds + EL_OFF) + p * 64;
    f32x16 S[2][2];
#pragma unroll
    for (int i = 0; i < 2; ++i)
#pragma unroll
        for (int j = 0; j < 2; ++j) S[i][j] = f32x16{};
    if (FULL && p == 0) {
        GL_LAS float* DT = (GL_LAS float*)(lds + DT_OFF) + hf * 64;
#pragma unroll 1
        for (int gp = 0; gp < g; ++gp) {
            float s = 0.f;
#pragma unroll
            for (int n = 0; n < 8; ++n) s += T.BLAST[(size_t)(bh * 64 + gp * 8 + n) * 64 + lane];
            const float* fg = T.FG + ((size_t)(bh * 8 + gp) * 2 + hf) * 4096 + lane * 4;
            f32x4 fa[16];
#pragma unroll
            for (int k = 0; k < 16; ++k) fa[k] = *(const f32x4*)(fg + k * 256);
            DT[lane] = __expf(s);
            asm volatile("s_waitcnt lgkmcnt(0)" ::: "memory");
#pragma unroll
            for (int db = 0; db < 2; ++db)
#pragma unroll
                for (int vb = 0; vb < 2; ++vb)
#pragma unroll
                    for (int q = 0; q < 4; ++q) { const f32x4 f = fa[(2 * db + vb) * 4 + q]; const f32x4 d = *(const GL_LAS f32x4*)(DT + 32 * db + 8 * q + 4 * hi);
#pragma unroll
                        for (int i = 0; i < 4; ++i) S[db][vb][4 * q + i] = S[db][vb][4 * q + i] * d[i] + f[i]; }
            asm volatile("s_waitcnt lgkmcnt(0)" ::: "memory");
        }
    }
    const int trb = (4 * hi + ((lane & 15) >> 2)) * 128 + (16 * ((lane >> 4) & 1) + 4 * (lane & 3)) * 2;
    const int rowb = r32 * 128 + 16 * hi;
    const int prmb = r32 * 128 + 8 * hi;
    for (int rd = 0; rd < 2; ++rd) {
        const int n = 8 * g + 4 * rd + p; const size_t T0 = (size_t)b * 4096 + 64 * n;
        u32x4 vq[8];
        { const unsigned short* vp = T.VG + (T0 + (lane >> 3)) * 512 + 128 * h + 64 * hf + 8 * (lane & 7);
#pragma unroll
            for (int i = 0; i < 8; ++i) vq[i] = *(const u32x4*)(vp + (size_t)i * 8 * 512); }
        if (hf == 0 || FULL) {
            const float* la = T.LOGA + T0 * 256 + 64 * h + lane; const unsigned short* kq = (hf == 0 ? T.KG : T.QG) + T0 * 256 + 64 * h + lane;
            const lptr img = area + (hf == 0 ? KD_OFF : QD_OFF) + lane * 2; float run = 0.f;
            float lvA[16], lvB[16]; unsigned short kvA[16], kvB[16];
#define GL_LOAD(LV, KV, t0) _Pragma("unroll") for (int i = 0; i < 16; ++i) { LV[i] = la[(size_t)((t0) + i) * 256]; KV[i] = kq[(size_t)((t0) + i) * 256]; }
#define GL_PROC(LV, KV, t0) _Pragma("unroll") for (int i = 0; i < 16; ++i) { run += LV[i]; const float e = __expf(hf == 0 ? -run : run); const float v = b2f(KV[i]) * e * (hf == 0 ? 1.0f : 0.125f); \
                *(GL_LAS unsigned short*)(img + ((t0) + i) * 128) = (unsigned short)(cvtpk(v, v) & 0xffffu); } asm volatile("" : "+v"(la), "+v"(kq), "+v"(run));
            GL_LOAD(lvA, kvA, 0) GL_LOAD(lvB, kvB, 16)
            GL_PROC(lvA, kvA, 0) GL_LOAD(lvA, kvA, 32)
            GL_PROC(lvB, kvB, 16) GL_LOAD(lvB, kvB, 48)
            GL_PROC(lvA, kvA, 32) GL_PROC(lvB, kvB, 48)
#undef GL_LOAD
#undef GL_PROC
            if (hf == 0) { EL[lane] = __expf(run); if (!FULL) T.BLAST[(size_t)(bh * 64 + n) * 64 + lane] = run; }
        }
        {
            const lptr vi = area + VV_OFF + hf * 8192 + (lane >> 3) * 128 + (lane & 7) * 16;
#pragma unroll
            for (int i = 0; i < 8; ++i) *(GL_LAS u32x4*)(vi + i * 1024) = vq[i];
        }
        __syncthreads();
        const lptr vv = area + VV_OFF + hf * 8192 + trb;
        f32x16 o[2][2];
        if (FULL) {
            bf16x8 PA[3][2];
#pragma unroll
            for (int c = 0; c < 3; ++c) { const int kb = c >> 1, qb = (c + 1) >> 1; f32x16 X = f32x16{};
#pragma unroll
                for (int s = 0; s < 4; ++s) { const bf16x8 a = *(const GL_LAS bf16x8*)(area + KD_OFF + kb * 4096 + rowb + s * 32), bq = *(const GL_LAS bf16x8*)(area + QD_OFF + qb * 4096 + rowb + s * 32);
                    X = GL_MFMA(a, bq, X); }
                if (kb == qb) {
#pragma unroll
                    for (int r = 0; r < 16; ++r) X[r] = (crow(r, hi) <= r32) ? X[r] : 0.f; }
                PA[c][0] = pack8(X, 0); PA[c][1] = pack8(X, 1); }
#pragma unroll
            for (int i = 0; i < 2; ++i)
#pragma unroll
                for (int j = 0; j < 2; ++j) o[i][j] = f32x16{};
#pragma unroll
            for (int vb = 0; vb < 2; ++vb)
#pragma unroll
                for (int sg = 0; sg < 4; ++sg) { const bf16x8 vf = cat(vtr(vv + vb * 64 + sg * 2048), vtr(vv + vb * 64 + sg * 2048 + 1024));
                    if (sg < 2) { o[0][vb] = GL_MFMA(PA[0][sg], vf, o[0][vb]); o[1][vb] = GL_MFMA(PA[1][sg], vf, o[1][vb]); }
                    else o[1][vb] = GL_MFMA(PA[2][sg - 2], vf, o[1][vb]); }
        }
#pragma unroll 1
        for (int s = 0; s < 4; ++s) {
            if (p == s) {
                if (FULL) {
#pragma unroll
                    for (int sg = 0; sg < 4; ++sg) { const bf16x8 sf0 = pack8(S[sg >> 1][0], sg & 1), sf1 = pack8(S[sg >> 1][1], sg & 1);
#pragma unroll
                        for (int qb = 0; qb < 2; ++qb) { const lptr qa = area + QD_OFF + qb * 4096 + prmb + sg * 32;
                            const bf16x8 af = cat(*(const GL_LAS s16x4*)(qa), *(const GL_LAS s16x4*)(qa + 16));
                            o[qb][0] = GL_MFMA(af, sf0, o[qb][0]); o[qb][1] = GL_MFMA(af, sf1, o[qb][1]); } }
                }
#pragma unroll
                for (int sg = 0; sg < 4; ++sg) { const bf16x8 v0 = cat(vtr(vv + sg * 2048), vtr(vv + sg * 2048 + 1024)), v1 = cat(vtr(vv + 64 + sg * 2048), vtr(vv + 64 + sg * 2048 + 1024));
#pragma unroll
                    for (int db = 0; db < 2; ++db) { const lptr ka = area + KD_OFF + trb + db * 64 + sg * 2048; const bf16x8 kf = cat(vtr(ka), vtr(ka + 1024));
                        S[db][0] = GL_MFMA(kf, v0, S[db][0]); S[db][1] = GL_MFMA(kf, v1, S[db][1]); } }
#pragma unroll
                for (int db = 0; db < 2; ++db)
#pragma unroll
                    for (int q = 0; q < 4; ++q) { const f32x4 e = *(const GL_LAS f32x4*)(EL + 32 * db + 8 * q + 4 * hi);
#pragma unroll
                        for (int i = 0; i < 4; ++i) { S[db][0][4 * q + i] *= e[i]; S[db][1][4 * q + i] *= e[i]; } }
            }
            __syncthreads();
            const bool last = (rd == 1 && s == 3);
            const lptr hand = lds + ((s == 3) ? 0 : s) * AREA;
            if (p == s && !last) {
#pragma unroll
                for (int bi = 0; bi < 4; ++bi)
#pragma unroll
                    for (int q = 0; q < 4; ++q) { const lptr d = hand + ((bi < 2) ? (hf == 0 ? KD_OFF : QD_OFF) : (VV_OFF + hf * 8192)) + ((bi & 1) * 4 + q) * 1024 + lane * 16;
                        *(GL_LAS f32x4*)d = (f32x4){S[bi >> 1][bi & 1][4 * q], S[bi >> 1][bi & 1][4 * q + 1], S[bi >> 1][bi & 1][4 * q + 2], S[bi >> 1][bi & 1][4 * q + 3]}; }
            }
            if (!FULL && last && p == 3) {
                float* fg = T.FG + ((size_t)(bh * 8 + g) * 2 + hf) * 4096;
#pragma unroll
                for (int bi = 0; bi < 4; ++bi)
#pragma unroll
                    for (int q = 0; q < 4; ++q) *(f32x4*)(fg + (bi * 4 + q) * 256 + lane * 4) = (f32x4){S[bi >> 1][bi & 1][4 * q], S[bi >> 1][bi & 1][4 * q + 1], S[bi >> 1][bi & 1][4 * q + 2], S[bi >> 1][bi & 1][4 * q + 3]};
            }
            const bool epi = FULL && ((s >= 1 && p == s - 1) || (s == 3 && p == 3));
            const lptr stg = area + VV_OFF + hf * 8192; GL_LAS float* SSQ = (GL_LAS float*)(lds + SSQ_OFF) + p * 128;
            if (epi) {
#pragma unroll
                for (int qb = 0; qb < 2; ++qb)
#pragma unroll
                    for (int vb = 0; vb < 2; ++vb)
#pragma unroll
                        for (int r = 0; r < 16; ++r) *(GL_LAS unsigned short*)(stg + (32 * qb + crow(r, hi)) * 128 + (32 * vb + r32) * 2) = (unsigned short)(cvtpk(o[qb][vb][r], o[qb][vb][r]) & 0xffffu);
                asm volatile("s_waitcnt lgkmcnt(0)" ::: "memory");
#pragma unroll
                for (int i = 0; i < 8; ++i) { const int t = i * 8 + (lane >> 3); const bf16x8 w = *(const GL_LAS bf16x8*)(stg + t * 128 + (lane & 7) * 16); float ss = 0.f;
#pragma unroll
                    for (int j = 0; j < 8; ++j) { const float x = b2f((unsigned short)w[j]); ss += x * x; }
                    ss += __shfl_xor(ss, 1); ss += __shfl_xor(ss, 2); ss += __shfl_xor(ss, 4);
                    if ((lane & 7) == 0) SSQ[hf * 64 + t] = ss; }
            }
            __syncthreads();
            if (!last && p == ((s + 1) & 3) && (s < 3 || rd == 0)) {
#pragma unroll
                for (int bi = 0; bi < 4; ++bi)
#pragma unroll
                    for (int q = 0; q < 4; ++q) { const lptr d = hand + ((bi < 2) ? (hf == 0 ? KD_OFF : QD_OFF) : (VV_OFF + hf * 8192)) + ((bi & 1) * 4 + q) * 1024 + lane * 16; const f32x4 x = *(const GL_LAS f32x4*)d;
#pragma unroll
                        for (int i = 0; i < 4; ++i) S[bi >> 1][bi & 1][4 * q + i] = x[i]; }
            }
            if (epi) {
                const size_t Te = (size_t)b * 4096 + 64 * n; float gn[8];
#pragma unroll
                for (int j = 0; j < 8; ++j) gn[j] = T.gng[128 * h + 64 * hf + 8 * (lane & 7) + j];
#pragma unroll
                for (int i = 0; i < 8; ++i) { const int t = i * 8 + (lane >> 3); const float tot = SSQ[t] + SSQ[64 + t]; const float rs = 1.0f / sqrtf(tot * (1.0f / 128.0f) + 1e-5f);
                    const bf16x8 w = *(const GL_LAS bf16x8*)(stg + t * 128 + (lane & 7) * 16); const bf16x8 gg = *(const bf16x8*)(T.GG + (Te + t) * 512 + 128 * h + 64 * hf + 8 * (lane & 7)); float r[8];
#pragma unroll
                    for (int j = 0; j < 8; ++j) { const float gv = b2f((unsigned short)gg[j]); r[j] = b2f((unsigned short)w[j]) * rs * gn[j] * (gv / (1.0f + __expf(-gv))); }
                    u32x4 ov; ov[0] = cvtpk(r[0], r[1]); ov[1] = cvtpk(r[2], r[3]); ov[2] = cvtpk(r[4], r[5]); ov[3] = cvtpk(r[6], r[7]);
                    *(u32x4*)(T.MIX + (Te + t) * 1024 + 512 + 128 * h + 64 * hf + 8 * (lane & 7)) = ov; }
            }
        }
        __syncthreads();
    }
}
#undef GL_MFMA
#undef GL_LAS
}
#define GAS __attribute__((address_space(1)))
#define LAS __attribute__((address_space(3)))
typedef unsigned short bf16;
typedef unsigned v4u __attribute__((ext_vector_type(4)));
typedef float f32x4 __attribute__((ext_vector_type(4)));
typedef short bf16x8 __attribute__((ext_vector_type(8)));
typedef GAS unsigned gu32;
typedef GAS unsigned long long gu64;
#define RLX_AGENT __ATOMIC_RELAXED, __HIP_MEMORY_SCOPE_AGENT
#define LDS_WAIT() asm volatile("s_waitcnt lgkmcnt(0)" ::: "memory")
#define VM_WAIT() asm volatile("s_waitcnt vmcnt(0)" ::: "memory")
__device__ __forceinline__ unsigned long long rt() { return __builtin_amdgcn_s_memrealtime(); }
__device__ __forceinline__ unsigned f2bf(float f) { unsigned u = __builtin_bit_cast(unsigned, f); return (u + 0x7fffu + ((u >> 16) & 1u)) >> 16; }
__device__ __forceinline__ unsigned pk2(float lo, float hi) { return f2bf(lo) | (f2bf(hi) << 16); }

#define XB_TMO      128
#define XB_XCNT(j)  (256  + 64 * (j))
#define XB_XSUB(j)  (1280 + 64 * (j))
#define XB_XGEN(j)  (2304 + 64 * (j))
#define XB_TOP      3328
#define XB_TOPGEN   3392
#define XCD_BAR_WORDS 3456
#define XB_SPIN_CAP (1u << 18)

__device__ __forceinline__ unsigned xb_ld(unsigned* p)              { return __hip_atomic_load(p, __ATOMIC_RELAXED, __HIP_MEMORY_SCOPE_AGENT); }
__device__ __forceinline__ unsigned xb_add(unsigned* p, unsigned v) { return __hip_atomic_fetch_add(p, v, __ATOMIC_RELAXED, __HIP_MEMORY_SCOPE_AGENT); }
__device__ __forceinline__ unsigned xb_xcc_id() { return (unsigned)__builtin_amdgcn_s_getreg((3 << 11) | 20) & 0xFu; }
#define XB_SPIN(cond, bar) do { unsigned _sp = 0; while (cond) { __builtin_amdgcn_s_sleep(1); \
    if ((++_sp & 255u) == 0u) { if (xb_ld(&(bar)[XB_TMO])) break; if (_sp > XB_SPIN_CAP) { atomicAdd(&(bar)[XB_TMO], 1u); break; } } } } while (0)

struct XcdBarrier {
    unsigned* bar; unsigned x;
    volatile LAS unsigned* st;
};

__device__ __forceinline__ XcdBarrier xcd_barrier_post(unsigned* bar, volatile LAS unsigned* st) {
    XcdBarrier b; b.bar = bar; b.x = xb_xcc_id(); b.st = st;
    if (threadIdx.x == 0) (void)xb_add(&bar[XB_XCNT(b.x)], 1u);
    return b;
}
__device__ __forceinline__ void xcd_barrier_complete(unsigned* bar, unsigned x, unsigned& nloc, unsigned& nx) {
    const unsigned G = gridDim.x * gridDim.y * gridDim.z;
    unsigned sum, cnt, mine, sp = 0u;
    for (;;) {
        sum = 0u; cnt = 0u; mine = 0u;
#pragma unroll
        for (unsigned j = 0; j < 16; ++j) { const unsigned c = xb_ld(&bar[XB_XCNT(j)]); sum += c; cnt += (c > 0u) ? 1u : 0u; mine = (j == x) ? c : mine; }
        if (sum == G) break;
        __builtin_amdgcn_s_sleep(1);
        if ((++sp & 255u) == 0u) { if (xb_ld(&bar[XB_TMO])) break; if (sp > XB_SPIN_CAP) { atomicAdd(&bar[XB_TMO], 1u); break; } }
    }
    nloc = mine > 0u ? mine : 1u; nx = cnt > 0u ? cnt : 1u;
}

__device__ __forceinline__ void xcd_barrier(const XcdBarrier& b) {
    asm volatile("s_waitcnt vmcnt(0)" ::: "memory");
    __syncthreads();
    if (threadIdx.x == 0) {
        unsigned* bar = b.bar;
        __builtin_amdgcn_s_waitcnt(0);
        unsigned nloc = b.st[0], nx = b.st[1];
        if (nloc == 0u) { xcd_barrier_complete(bar, b.x, nloc, nx); b.st[0] = nloc; b.st[1] = nx; }
        const unsigned old = xb_add(&bar[XB_XSUB(b.x)], 1u);
        const unsigned gen = old / nloc;
        if (old + 1u == (gen + 1u) * nloc) {
            __builtin_amdgcn_fence(__ATOMIC_RELEASE, "agent");
            asm volatile("s_waitcnt vmcnt(0)" ::: "memory");
            const unsigned og = xb_add(&bar[XB_TOP], 1u);
            const unsigned tg = og / nx;
            if (og + 1u == (tg + 1u) * nx) xb_add(&bar[XB_TOPGEN], 1u);
            else XB_SPIN(xb_ld(&bar[XB_TOPGEN]) == tg, bar);
            __builtin_amdgcn_fence(__ATOMIC_ACQUIRE, "agent");
            xb_add(&bar[XB_XGEN(b.x)], 1u);
            asm volatile("s_waitcnt vmcnt(0)" ::: "memory");
        } else {
            XB_SPIN(xb_ld(&bar[XB_XGEN(b.x)]) == gen, bar);
            __builtin_amdgcn_fence(__ATOMIC_ACQUIRE, "agent");
            asm volatile("s_waitcnt vmcnt(0)" ::: "memory");
        }
    }
    __syncthreads();
}

constexpr int NWAVES = 8;
#ifndef MK_N_LAUNCHES
#define MK_N_LAUNCHES 1
#endif
constexpr int N_PHASES = 11;
constexpr int N_LAUNCHES = MK_N_LAUNCHES;
static_assert(N_LAUNCHES == 1 || N_LAUNCHES == N_PHASES, "MK_N_LAUNCHES is 1 or 11");

constexpr int BATCH = 8, SEQ = 4096, D = 1024, M = BATCH * SEQ;
constexpr int AW = 512, GKW = 256, GVW = 512, FF = 2816, INW = 3088;
constexpr int NIN = 3328;
constexpr int NGH = 4, GDK = 64, GDV = 128, GCH = 64, NCH = SEQ / GCH;
constexpr float LN_EPS = 1e-5f, ALPHA = 1.189207115002721f;

constexpr size_t MiB = 1u << 20;
constexpr size_t WS_CTL = 0, CTL_ZERO_BYTES = 1 * MiB;
constexpr size_t WS_MODP = 1 * MiB;
constexpr size_t WS_MOD = 4 * MiB;
constexpr size_t WS_KMEAN = 4 * MiB + 256 * 1024;
constexpr size_t WS_DEC = 4 * MiB + 512 * 1024;
constexpr size_t WS_HALO = 5 * MiB, WS_FIXS = 8 * MiB, WS_FIXV = 11 * MiB;
constexpr size_t WS_WIN = 14 * MiB, WS_WO = 21 * MiB, WS_WUP = 23 * MiB, WS_WDN = 34 * MiB;
constexpr size_t WS_XN = 40 * MiB;
constexpr size_t WS_QA = 104 * MiB, WS_KA = 136 * MiB, WS_VA = 168 * MiB, WS_QG = 200 * MiB, WS_KG = 216 * MiB, WS_VG = 232 * MiB, WS_GG = 264 * MiB, WS_LOGA = 296 * MiB;
constexpr size_t WS_KV = 328 * MiB;
constexpr size_t WS_MIX = 392 * MiB;
constexpr size_t WS_Y1 = 104 * MiB;
constexpr size_t WS_X1 = 328 * MiB;
constexpr size_t WS_ACT = 104 * MiB;
constexpr size_t WS_Y2 = 40 * MiB;
constexpr size_t WS_END = 456 * MiB;
static_assert(WS_X1 + (size_t)M * D * 2 <= WS_MIX && WS_ACT + (size_t)M * FF * 2 <= WS_X1 && WS_MIX + (size_t)M * D * 2 <= WS_END && WS_LOGA + (size_t)M * 256 * 4 <= WS_KV && WS_WDN + (size_t)D * FF * 2 <= WS_XN, "d_ws map");
constexpr int CW_TMO = 0, CW_CODE = 1;
constexpr int CW_BAR = 4096;

constexpr int RING_OFF = 0, RING_BYTES = 131072;
constexpr int LDSCTL_OFF = RING_BYTES, MISC_OFF = LDSCTL_OFF + 320;
constexpr int HTAB_OFF = 132096;
constexpr int LDS_BYTES = 147456;
static_assert(MISC_OFF + 128 <= HTAB_OFF && HTAB_OFF + 4096 <= LDS_BYTES && attn_body::ATTN_LDS_BYTES <= RING_BYTES, "LDS map");

#define CAS __attribute__((address_space(4)))
struct Args { const float* in[19]; float* out; unsigned char* ws; int ph_lo, ph_hi, li, pad; };
struct Frame {
    LAS unsigned char* lds;
    volatile LAS unsigned* MISC;
    gu32* ctl;
    int tid, lane, wave;
    int vcu, G;
    unsigned char* ws;
    const CAS Args* argp;
};
#define ARG_IN(F, k) ({ const CAS Args* p_ = (F).argp; asm volatile("" : "+s"(p_)); p_->in[k]; })
#define ARG_OUT(F) ({ const CAS Args* p_ = (F).argp; asm volatile("" : "+s"(p_)); p_->out; })
enum { I_X = 0, I_C, I_WADA, I_BADA, I_WIN, I_WGATE, I_BGATE, I_ATTNG, I_GLAG, I_WO, I_LN1G, I_LN1B, I_WUP, I_BUP, I_CONVW, I_CONVB, I_WDOWN, I_LN2G, I_LN2B };
__device__ __forceinline__ float bf2f(unsigned short v) { return __uint_as_float(((unsigned)v) << 16); }
__device__ __forceinline__ float wave_sum(float v) {
#pragma unroll
    for (int o = 1; o < 64; o <<= 1) v += __shfl_xor(v, o);
    return v;
}
__device__ __forceinline__ float silu_f(float v) { return v / (1.0f + __expf(-v)); }

__device__ __forceinline__ void p0_transpose_item(const float* W, int pitch, int k0, int n0, bf16* WT, int Kd, int drow0, LAS float* scr, int lane) {
#pragma unroll 8
    for (int i = 0; i < 32; ++i) { const int kk = 2 * i + (lane >> 5); scr[kk * 33 + (lane & 31)] = W[(size_t)(k0 + kk) * pitch + n0 + (lane & 31)]; }
    LDS_WAIT(); asm volatile("" ::: "memory");
    const int c = lane & 7;
#pragma unroll
    for (int j = 0; j < 4; ++j) { const int n = (lane >> 3) + 8 * j; const LAS float* s = scr + (8 * c) * 33 + n;
        v4u o; o.x = pk2(s[0 * 33], s[1 * 33]); o.y = pk2(s[2 * 33], s[3 * 33]); o.z = pk2(s[4 * 33], s[5 * 33]); o.w = pk2(s[6 * 33], s[7 * 33]);
        *(GAS v4u*)(WT + (size_t)(drow0 + n) * Kd + k0 + 8 * c) = o; }
    LDS_WAIT(); asm volatile("" ::: "memory");
}
__device__ __forceinline__ void p0a_prologue(Frame& F) {
    LAS float* scr = (LAS float*)(F.lds + RING_OFF + F.wave * 16384);
    const int gw = F.vcu * NWAVES + F.wave, NGW = F.G * NWAVES, lane = F.lane;
    bf16* Win_t = (bf16*)(F.ws + WS_WIN); bf16* Wo_t = (bf16*)(F.ws + WS_WO); bf16* Wup_t = (bf16*)(F.ws + WS_WUP); bf16* Wdn_t = (bf16*)(F.ws + WS_WDN);
    float* MODP = (float*)(F.ws + WS_MODP);
    const float* c_in = ARG_IN(F, I_C); const float* w_ada = ARG_IN(F, I_WADA); const float* w_in = ARG_IN(F, I_WIN); const float* w_gate = ARG_IN(F, I_WGATE);
    const float* w_o = ARG_IN(F, I_WO); const float* w_up = ARG_IN(F, I_WUP); const float* w_down = ARG_IN(F, I_WDOWN);
    constexpr int I_MOD = 96 * 16, I_IN = 16 * 96, I_O = 16 * 32, I_UP = 16 * 176, I_DN = 44 * 32, I_CB = 16 * 32;
    constexpr int NITEMS = I_MOD + I_IN + I_O + I_UP + I_DN + I_CB;
    for (int it = gw; it < NITEMS; it += NGW) {
        int r = it;
        if (r < I_MOD) {
            const int cg = r % 96, ks = r / 96;
            float sv[8], acc[8];
#pragma unroll
            for (int b = 0; b < 8; ++b) { sv[b] = silu_f(c_in[b * 1024 + 64 * ks + lane]); acc[b] = 0.f; }
            const float* wp = w_ada + (size_t)(64 * ks) * 6144 + 64 * cg + lane;
#pragma unroll 4
            for (int kk = 0; kk < 64; ++kk) { const float w = wp[(size_t)kk * 6144];
#pragma unroll
                for (int b = 0; b < 8; ++b) acc[b] += __int_as_float(__builtin_amdgcn_readlane(__float_as_int(sv[b]), kk)) * w; }
#pragma unroll
            for (int b = 0; b < 8; ++b) MODP[(size_t)(ks * 8 + b) * 6144 + 64 * cg + lane] = acc[b];
            continue; }
        r -= I_MOD;
        if (r < I_IN) { const int kb = r / 96, nb = r % 96; p0_transpose_item(w_in, INW, 64 * kb, 32 * nb, Win_t, D, 32 * nb, scr, lane); continue; } r -= I_IN;
        if (r < I_O) { const int kb = r / 32, nb = r % 32; p0_transpose_item(w_o, D, 64 * kb, 32 * nb, Wo_t, D, 32 * nb, scr, lane); continue; } r -= I_O;
        if (r < I_UP) { const int kb = r / 176, nb = r % 176; const int cc = 32 * nb; const int dr = (cc < FF) ? (256 * (cc / 128) + (cc % 128)) : (256 * ((cc - FF) / 128) + 128 + ((cc - FF) % 128));
            p0_transpose_item(w_up, 2 * FF, 64 * kb, cc, Wup_t, D, dr, scr, lane); continue; } r -= I_UP;
        if (r < I_DN) { const int kb = r / 32, nb = r % 32; p0_transpose_item(w_down, D, 64 * kb, 32 * nb, Wdn_t, FF, 32 * nb, scr, lane); continue; } r -= I_DN;
        {
            const int kb = r / 32, nb = r % 32, k0 = 64 * kb, n = 8 * nb + (lane >> 3), c = lane & 7;
            float g[16], o[8];
#pragma unroll
            for (int rr = 0; rr < 16; ++rr) g[rr] = w_gate[rr * 256 + n];
#pragma unroll
            for (int i = 0; i < 8; ++i) { const float* wr_ = w_in + (size_t)(k0 + 8 * c + i) * INW + 3072;
                const f32x4 a0 = *(const f32x4*)(wr_), a1 = *(const f32x4*)(wr_ + 4), a2 = *(const f32x4*)(wr_ + 8), a3 = *(const f32x4*)(wr_ + 12);
                float s = 0.f;
#pragma unroll
                for (int q = 0; q < 4; ++q) { s += a0[q] * g[q]; s += a1[q] * g[4 + q]; s += a2[q] * g[8 + q]; s += a3[q] * g[12 + q]; }
                o[i] = s; }
            v4u w; w.x = pk2(o[0], o[1]); w.y = pk2(o[2], o[3]); w.z = pk2(o[4], o[5]); w.w = pk2(o[6], o[7]);
            *(GAS v4u*)(Win_t + (size_t)(3072 + n) * D + k0 + 8 * c) = w;
        }
    }
}
__device__ __forceinline__ void ln16(f32x4 (&v)[4]) {
    float s = 0.f;
#pragma unroll
    for (int j = 0; j < 4; ++j) s += (v[j].x + v[j].y) + (v[j].z + v[j].w);
    const float mean = wave_sum(s) * (1.f / D); float s2 = 0.f;
#pragma unroll
    for (int j = 0; j < 4; ++j) { v[j] = v[j] - mean; s2 += (v[j].x * v[j].x + v[j].y * v[j].y) + (v[j].z * v[j].z + v[j].w * v[j].w); }
    const float rstd = 1.f / sqrtf(wave_sum(s2) * (1.f / D) + LN_EPS);
#pragma unroll
    for (int j = 0; j < 4; ++j) v[j] = v[j] * rstd;
}
__device__ __forceinline__ void p0b_adaln1(Frame& F) {
    const int b = F.vcu >> 5, tid = F.tid, lane = F.lane;
    const float* MODP = (const float*)(F.ws + WS_MODP); float* MOD = (float*)(F.ws + WS_MOD);
    LAS float* sv = (LAS float*)(F.lds + RING_OFF);
    const bool writer = (F.vcu & 31) == 0; const float* b_ada = ARG_IN(F, I_BADA); const float* x = ARG_IN(F, I_X);
    for (int j = tid; j < (writer ? 6144 : 2048); j += NWAVES * 64) { float v = b_ada[j];
#pragma unroll
        for (int ks = 0; ks < 16; ++ks) v += MODP[(size_t)(ks * 8 + b) * 6144 + j];
        if (j < 2048) sv[j] = (j >= 1024) ? 1.0f + v : v;
        if (writer) MOD[b * 6144 + j] = v; }
    __syncthreads();
    f32x4 shf[4], scl[4];
#pragma unroll
    for (int j = 0; j < 4; ++j) { shf[j] = *(const LAS f32x4*)(sv + 4 * lane + 256 * j); scl[j] = *(const LAS f32x4*)(sv + 1024 + 4 * lane + 256 * j); }
    bf16* XN = (bf16*)(F.ws + WS_XN);
    for (int r0 = 0; r0 < 16; r0 += 4) { const size_t row0 = (size_t)F.vcu * 128 + F.wave * 16 + r0; f32x4 v[4][4];
#pragma unroll
        for (int q = 0; q < 4; ++q) { const GAS f32x4* xr = (const GAS f32x4*)(x + (row0 + q) * D) + lane;
#pragma unroll
            for (int j = 0; j < 4; ++j) v[q][j] = xr[64 * j]; }
#pragma unroll
        for (int q = 0; q < 4; ++q) { ln16(v[q]);
            GAS unsigned long long* o8 = (GAS unsigned long long*)(XN + (row0 + q) * D) + lane;
#pragma unroll
            for (int j = 0; j < 4; ++j) { const f32x4 u = v[q][j] * scl[j] + shf[j]; o8[64 * j] = (unsigned long long)pk2(u.x, u.y) | ((unsigned long long)pk2(u.z, u.w) << 32); } } }
    __syncthreads();
}
__device__ __forceinline__ void p3_kmean(Frame& F) {
    const int gw = F.vcu * NWAVES + F.wave, NGW = F.G * NWAVES, lane = F.lane;
    const bf16* KA = (const bf16*)(F.ws + WS_KA); float* KMEAN = (float*)(F.ws + WS_KMEAN);
    for (int it = gw; it < BATCH * 16 * 8; it += NGW) {
        const int h = it & 7, blk = (it >> 3) & 15, b = it >> 7, c = lane & 7, rg = lane >> 3;
        const bf16* p = KA + ((size_t)b * SEQ + blk * 256 + rg) * AW + 64 * h + 8 * c; float a[8];
#pragma unroll
        for (int j = 0; j < 8; ++j) a[j] = 0.f;
#pragma unroll 8
        for (int i = 0; i < 32; ++i) { const bf16x8 q = *(const bf16x8*)(p + (size_t)(8 * i) * AW);
#pragma unroll
            for (int j = 0; j < 8; ++j) a[j] += bf2f(q[j]); }
#pragma unroll
        for (int j = 0; j < 8; ++j) { a[j] += __shfl_xor(a[j], 8); a[j] += __shfl_xor(a[j], 16); a[j] += __shfl_xor(a[j], 32); }
        if (lane < 8) { float* o = KMEAN + ((size_t)(b * 8 + h) * 16 + blk) * 64 + 8 * c;
            *(f32x4*)o = (f32x4){a[0], a[1], a[2], a[3]} * (1.f / 256.f); *(f32x4*)(o + 4) = (f32x4){a[4], a[5], a[6], a[7]} * (1.f / 256.f); }
    }
}
__device__ __forceinline__ gla::Tensors gla_tensors(Frame& F) {
    gla::Tensors T; T.LOGA = (const float*)(F.ws + WS_LOGA); T.QG = (const bf16*)(F.ws + WS_QG); T.KG = (const bf16*)(F.ws + WS_KG); T.VG = (const bf16*)(F.ws + WS_VG); T.GG = (const bf16*)(F.ws + WS_GG);
    T.MIX = (bf16*)(F.ws + WS_MIX); T.FG = (float*)(F.ws + WS_KV); T.BLAST = (float*)(F.ws + WS_DEC); T.gng = ARG_IN(F, I_GLAG); return T;
}
__device__ __forceinline__ void p4b_ln1_adaln2(Frame& F) {
    const int b = F.vcu >> 5, lane = F.lane; const float* MOD = (const float*)(F.ws + WS_MOD) + b * 6144;
    f32x4 g1[4], lg[4], lb[4], scl[4], shf[4]; const float* ln1_g = ARG_IN(F, I_LN1G); const float* ln1_b = ARG_IN(F, I_LN1B); const float* x = ARG_IN(F, I_X);
#pragma unroll
    for (int j = 0; j < 4; ++j) { const int c = 4 * lane + 256 * j; g1[j] = *(const f32x4*)(MOD + 2048 + c); lg[j] = *(const f32x4*)(ln1_g + c); lb[j] = *(const f32x4*)(ln1_b + c);
        shf[j] = *(const f32x4*)(MOD + 3072 + c); scl[j] = *(const f32x4*)(MOD + 4096 + c) + 1.0f; }
    const bf16* Y1 = (const bf16*)(F.ws + WS_Y1); bf16* X1 = (bf16*)(F.ws + WS_X1); bf16* XN = (bf16*)(F.ws + WS_XN);
    for (int r0 = 0; r0 < 16; r0 += 4) { const size_t row0 = (size_t)F.vcu * 128 + F.wave * 16 + r0; f32x4 xv[4][4]; unsigned long long yv[4][4];
#pragma unroll
        for (int q = 0; q < 4; ++q) { const GAS f32x4* xr = (const GAS f32x4*)(x + (row0 + q) * D) + lane; const GAS unsigned long long* yr = (const GAS unsigned long long*)(Y1 + (row0 + q) * D) + lane;
#pragma unroll
            for (int j = 0; j < 4; ++j) { xv[q][j] = xr[64 * j]; yv[q][j] = yr[64 * j]; } }
#pragma unroll
        for (int q = 0; q < 4; ++q) { f32x4 v[4];
#pragma unroll
            for (int j = 0; j < 4; ++j) { const unsigned long long yw = yv[q][j]; const f32x4 y = (f32x4){bf2f((unsigned short)yw), bf2f((unsigned short)(yw >> 16)), bf2f((unsigned short)(yw >> 32)), bf2f((unsigned short)(yw >> 48))};
                v[j] = xv[q][j] * ALPHA + g1[j] * y; }
            ln16(v);
            GAS unsigned long long* x1r = (GAS unsigned long long*)(X1 + (row0 + q) * D) + lane;
#pragma unroll
            for (int j = 0; j < 4; ++j) { v[j] = v[j] * lg[j] + lb[j]; x1r[64 * j] = (unsigned long long)pk2(v[j].x, v[j].y) | ((unsigned long long)pk2(v[j].z, v[j].w) << 32); }
            ln16(v);
            GAS unsigned long long* o8 = (GAS unsigned long long*)(XN + (row0 + q) * D) + lane;
#pragma unroll
            for (int j = 0; j < 4; ++j) { const f32x4 u = v[j] * scl[j] + shf[j]; o8[64 * j] = (unsigned long long)pk2(u.x, u.y) | ((unsigned long long)pk2(u.z, u.w) << 32); } } }
}
__device__ __forceinline__ void p5b_fixup(Frame& F) {
    const float* HALO = (const float*)(F.ws + WS_HALO); const float* FIXS = (const float*)(F.ws + WS_FIXS); const float* FIXV = (const float*)(F.ws + WS_FIXV); bf16* ACT = (bf16*)(F.ws + WS_ACT);
    const int nthr = F.G * NWAVES * 64; const float* conv_w = ARG_IN(F, I_CONVW);
    for (int e = F.vcu * NWAVES * 64 + F.tid; e < 128 * 2 * FF; e += nthr) {
        const int ch = e % FF, rr = (e / FF) & 1, pm = e / (2 * FF);
        if ((pm & 15) == 0) continue;
        const float h14 = HALO[((size_t)(pm - 1) * 2 + 0) * FF + ch], h15 = HALO[((size_t)(pm - 1) * 2 + 1) * FF + ch];
        const float w0 = conv_w[ch], w1 = conv_w[FF + ch];
        const float extra = rr == 0 ? (w0 * h14 + w1 * h15) : (w0 * h15);
        const float cv = FIXS[((size_t)pm * 2 + rr) * FF + ch] + extra;
        ACT[((size_t)pm * 256 + rr) * FF + ch] = (bf16)f2bf(pg8::gelu1(cv) * FIXV[((size_t)pm * 2 + rr) * FF + ch]);
    }
}
__device__ __forceinline__ void p6b_ln2(Frame& F) {
    const int b = F.vcu >> 5, lane = F.lane; const float* MOD = (const float*)(F.ws + WS_MOD) + b * 6144;
    f32x4 g2[4], lg[4], lb[4]; const float* ln2_g = ARG_IN(F, I_LN2G); const float* ln2_b = ARG_IN(F, I_LN2B); float* outp = ARG_OUT(F);
#pragma unroll
    for (int j = 0; j < 4; ++j) { const int c = 4 * lane + 256 * j; g2[j] = *(const f32x4*)(MOD + 5120 + c); lg[j] = *(const f32x4*)(ln2_g + c); lb[j] = *(const f32x4*)(ln2_b + c); }
    const bf16* Y2 = (const bf16*)(F.ws + WS_Y2); const bf16* X1 = (const bf16*)(F.ws + WS_X1);
    for (int r0 = 0; r0 < 16; r0 += 4) { const size_t row0 = (size_t)F.vcu * 128 + F.wave * 16 + r0; unsigned long long xv[4][4], yv[4][4];
#pragma unroll
        for (int q = 0; q < 4; ++q) { const GAS unsigned long long* xr = (const GAS unsigned long long*)(X1 + (row0 + q) * D) + lane; const GAS unsigned long long* yr = (const GAS unsigned long long*)(Y2 + (row0 + q) * D) + lane;
#pragma unroll
            for (int j = 0; j < 4; ++j) { xv[q][j] = xr[64 * j]; yv[q][j] = yr[64 * j]; } }
#pragma unroll
      for (int q = 0; q < 4; ++q) { const size_t row = row0 + q; f32x4 v[4];
#pragma unroll
        for (int j = 0; j < 4; ++j) { const unsigned long long yw = yv[q][j]; const f32x4 y = (f32x4){bf2f((unsigned short)yw), bf2f((unsigned short)(yw >> 16)), bf2f((unsigned short)(yw >> 32)), bf2f((unsigned short)(yw >> 48))};
            const unsigned long long xw = xv[q][j]; const f32x4 x1 = (f32x4){bf2f((unsigned short)xw), bf2f((unsigned short)(xw >> 16)), bf2f((unsigned short)(xw >> 32)), bf2f((unsigned short)(xw >> 48))};
            v[j] = x1 * ALPHA + g2[j] * y; }
        ln16(v);
        GAS f32x4* orow = (GAS f32x4*)(outp + row * D) + lane;
#if defined(MK_PROBE_A)
        if (F.vcu == 0) { const unsigned long long ta0 = __hip_atomic_load((gu64*)(F.ctl + 64) + MK_PROBE_A, RLX_AGENT), ta1 = __hip_atomic_load((gu64*)(F.ctl + 64) + MK_PROBE_A + 1, RLX_AGENT);
            const unsigned long long tb0 = __hip_atomic_load((gu64*)(F.ctl + 64) + MK_PROBE_B, RLX_AGENT), tb1 = __hip_atomic_load((gu64*)(F.ctl + 64) + MK_PROBE_B + 1, RLX_AGENT);
            const float ua = (float)(ta1 - ta0) * 0.01f, ub = (float)(tb1 - tb0) * 0.0001f;
#pragma unroll
            for (int j = 0; j < 4; ++j) { f32x4 o = v[j] * lg[j] + lb[j] + ub; if (row == 0 && lane == 0 && j == 0) o.x += ua; orow[64 * j] = o; }
        } else
#endif
#pragma unroll
        for (int j = 0; j < 4; ++j) orow[64 * j] = v[j] * lg[j] + lb[j]; } }
}

__global__ void __launch_bounds__(NWAVES * 64, 2) mk_fwd(Args args) {
    extern __shared__ __attribute__((aligned(16))) unsigned char lds[];
    Frame F;
    F.lds = (LAS unsigned char*)lds;
    F.MISC = (volatile LAS unsigned*)(F.lds + MISC_OFF);
    F.tid = threadIdx.x; F.lane = F.tid & 63; F.wave = __builtin_amdgcn_readfirstlane(F.tid >> 6);
    F.G = gridDim.x; { const int bx = blockIdx.x; F.vcu = (F.G % 8 == 0) ? (bx % 8) * (F.G / 8) + bx / 8 : bx; }
    F.ws = args.ws; F.ctl = (gu32*)(args.ws + WS_CTL); F.argp = (const CAS Args*)__builtin_amdgcn_kernarg_segment_ptr();
    for (int u = F.tid; u < (LDS_BYTES - LDSCTL_OFF) / 4; u += NWAVES * 64) ((LAS unsigned*)(F.lds + LDSCTL_OFF))[u] = 0u;
    __syncthreads();
    XcdBarrier bar; bar.bar = (unsigned*)(F.ctl + CW_BAR); bar.x = 0; bar.st = nullptr;
    if (N_LAUNCHES == 1) bar = xcd_barrier_post((unsigned*)(F.ctl + CW_BAR), F.MISC + 8);
#if defined(MK_PROBE_A)
#define PROBE_STAMP(k) do { if (blockIdx.x == 0 && F.tid == 0) __hip_atomic_store((gu64*)(F.ctl + 64) + (k), (unsigned long long)__builtin_amdgcn_s_memrealtime(), RLX_AGENT); } while (0)
#else
#define PROBE_STAMP(k) do { } while (0)
#endif
#define GRID_BAR(seam) do { if (N_LAUNCHES != 1) { if (F.tid == 0) __hip_atomic_store(F.ctl + CW_TMO, 0xBADBA0u | (unsigned)(seam), RLX_AGENT); } else { xcd_barrier(bar); } PROBE_STAMP((seam) + 1); } while (0)
    const int lo = args.ph_lo, hi = args.ph_hi;
    PROBE_STAMP(0);
#ifndef MK_PHASE_MASK
#define MK_PHASE_MASK 0x7ff
#endif
#define IN(k) (((MK_PHASE_MASK >> (k)) & 1) && lo <= (k) && (k) < hi)
#define BOTH(k) (IN(k) && IN((k) + 1))
    bf16* XN = (bf16*)(F.ws + WS_XN);
    if (IN(0)) { p0a_prologue(F); if (BOTH(0)) GRID_BAR(0); }
    if (IN(1)) { p0b_adaln1(F); if (BOTH(1)) GRID_BAR(1); }
    if (IN(2)) {
        pg8::Gemm g{XN, (const bf16*)(F.ws + WS_WIN), M, NIN, D}; pg8::StaticOrder S; S.init(M, NIN, F.G, (int)blockIdx.x);
        pg8::EpiInProj E{(bf16*)(F.ws + WS_QA), (bf16*)(F.ws + WS_KA), (bf16*)(F.ws + WS_VA), (bf16*)(F.ws + WS_QG), (bf16*)(F.ws + WS_KG), (bf16*)(F.ws + WS_VG), (bf16*)(F.ws + WS_GG), (float*)(F.ws + WS_LOGA), ARG_IN(F, I_BGATE), attn_body::C2};
        pg8::gemm_phase<pg8::EpiInProj, pg8::StaticOrder, PG8_ALIGN, PG8_SP2>(F.lds + RING_OFF, g, S, E);
        if (BOTH(2)) GRID_BAR(2);
    }
    if (IN(3)) { p3_kmean(F); { const gla::Tensors T = gla_tensors(F); for (int it = F.vcu; it < BATCH * NGH * 8; it += F.G) gla::group<false>((gla::lptr)F.lds, T, it >> 3, it & 7); } if (BOTH(3)) GRID_BAR(3); }
    if (IN(4)) {
#if defined(MK_DUP_GLAC)
        for (int rep_ = ({ int r_ = 2; asm volatile("" : "+s"(r_)); r_; }); rep_ > 0; --rep_)
#endif
        { const gla::Tensors T = gla_tensors(F); for (int it = F.vcu; it < BATCH * NGH * 8; it += F.G) gla::group<true>((gla::lptr)F.lds, T, it >> 3, it & 7); }
        const attn_body::AttnTensors AT{(const attn_body::bf16*)(F.ws + WS_QA), (const attn_body::bf16*)(F.ws + WS_KA), (const attn_body::bf16*)(F.ws + WS_VA), (attn_body::bf16*)(F.ws + WS_MIX), (const float*)(F.ws + WS_KMEAN), ARG_IN(F, I_ATTNG)};
        const attn_body::StaticOrder S((int)F.G, (int)blockIdx.x);
        attn_body::attn_phase<attn_body::StaticOrder>((char*)lds + RING_OFF, AT, S);
        if (BOTH(4)) GRID_BAR(4);
    }
    if (IN(5)) {
        pg8::Gemm g{(const bf16*)(F.ws + WS_MIX), (const bf16*)(F.ws + WS_WO), M, D, D}; pg8::StaticOrder S; S.init(M, D, F.G, (int)blockIdx.x);
        pg8::EpiBf16<0> E{(bf16*)(F.ws + WS_Y1), D, nullptr, 0, 0, 1.f};
        pg8::gemm_phase<pg8::EpiBf16<0>, pg8::StaticOrder, PG8_ALIGN, PG8_SP2>(F.lds + RING_OFF, g, S, E);
        if (BOTH(5)) GRID_BAR(5);
    }
    if (IN(6)) { p4b_ln1_adaln2(F); if (BOTH(6)) GRID_BAR(6); }
    if (IN(7)) {
        pg8::Gemm g{XN, (const bf16*)(F.ws + WS_WUP), M, 2 * FF, D}; pg8::StaticOrder S; S.init(M, 2 * FF, F.G, (int)blockIdx.x);
        pg8::EpiConvGlu E{(bf16*)(F.ws + WS_ACT), ARG_IN(F, I_BUP), ARG_IN(F, I_CONVW), ARG_IN(F, I_CONVB), (float*)(F.ws + WS_HALO), (float*)(F.ws + WS_FIXS), (float*)(F.ws + WS_FIXV), (LAS float*)(F.lds + HTAB_OFF)};
        pg8::gemm_phase<pg8::EpiConvGlu, pg8::StaticOrder, true, PG8_SP2>(F.lds + RING_OFF, g, S, E);
        if (BOTH(7)) GRID_BAR(7);
    }
    if (IN(8)) { p5b_fixup(F); if (BOTH(8)) GRID_BAR(8); }
    if (IN(9)) {
        pg8::Gemm g{(const bf16*)(F.ws + WS_ACT), (const bf16*)(F.ws + WS_WDN), M, D, FF}; pg8::StaticOrder S; S.init(M, D, F.G, (int)blockIdx.x);
        pg8::EpiBf16<0> E{(bf16*)(F.ws + WS_Y2), D, nullptr, 0, 0, 1.f};
        pg8::gemm_phase<pg8::EpiBf16<0>, pg8::StaticOrder, PG8_ALIGN, PG8_SP2>(F.lds + RING_OFF, g, S, E);
        if (BOTH(9)) GRID_BAR(9);
    }
    if (IN(10)) { p6b_ln2(F); }
#undef IN
#undef BOTH
}

extern "C" void kernel_launch(void* const* d_in, const int* in_sizes, int n_in, void* d_out, int out_size, void* d_ws, size_t ws_size, hipStream_t stream) {
    static int grid = 0;
    if (grid == 0) {
        if (n_in != 19 || in_sizes[0] != M * D || out_size != M * D || ws_size < WS_END) { fprintf(stderr, "kernel_launch: built for 19 inputs, x/out of %d floats, >= %zu bytes of workspace; got n_in %d, in0 %d, out %d, ws %zu; nothing launched\n", M * D, (size_t)WS_END, n_in, n_in > 0 ? in_sizes[0] : -1, out_size, ws_size); grid = -1; return; }
        int dev = 0, cus = 0, per_cu = 0;
        if (hipGetDevice(&dev) != hipSuccess || hipDeviceGetAttribute(&cus, hipDeviceAttributeMultiprocessorCount, dev) != hipSuccess) { fprintf(stderr, "kernel_launch: device query failed\n"); grid = -1; return; }
        if (hipFuncSetAttribute((const void*)mk_fwd, hipFuncAttributeMaxDynamicSharedMemorySize, LDS_BYTES) != hipSuccess) { fprintf(stderr, "kernel_launch: hipFuncSetAttribute failed\n"); grid = -1; return; }
        if (hipOccupancyMaxActiveBlocksPerMultiprocessor(&per_cu, (const void*)mk_fwd, NWAVES * 64, LDS_BYTES) != hipSuccess || per_cu < 1)
            fprintf(stderr, "kernel_launch: note: the occupancy query reports %d workgroups per CU\n", per_cu);
        (void)hipGetLastError();
        grid = cus;
        if (grid != 256) { fprintf(stderr, "kernel_launch: this kernel's row split needs exactly 256 CUs, got %d; nothing launched\n", grid); grid = -1; return; }
    }
    if (grid < 0) return;
    if (hipMemsetAsync((char*)d_ws + WS_CTL, 0, CTL_ZERO_BYTES, stream) != hipSuccess) { fprintf(stderr, "kernel_launch: hipMemsetAsync failed\n"); return; }
    Args a{};
    for (int i = 0; i < 19; ++i) a.in[i] = (const float*)d_in[i];
    a.out = (float*)d_out; a.ws = (unsigned char*)d_ws;
    for (int li = 0; li < N_LAUNCHES; ++li) {
        a.ph_lo = (N_LAUNCHES == 1) ? 0 : li; a.ph_hi = (N_LAUNCHES == 1) ? N_PHASES : li + 1; a.li = li;
        hipLaunchKernelGGL(mk_fwd, dim3(grid), dim3(NWAVES * 64), LDS_BYTES, stream, a);
#if defined(MK_DUP_MASK)
        if (N_LAUNCHES != 1 && ((MK_DUP_MASK >> li) & 1)) hipLaunchKernelGGL(mk_fwd, dim3(grid), dim3(NWAVES * 64), LDS_BYTES, stream, a);
#endif
        const hipError_t le = hipPeekAtLastError();
        if (le != hipSuccess) { fprintf(stderr, "kernel_launch: launch %d failed: %s\n", li, hipGetErrorName(le)); break; }
    }
}
```

```cpp
#include <hip/hip_runtime.h>
#include <cstdio>
#include <cstdint>
namespace pg8 {
#define PG8_LAS __attribute__((address_space(3)))
typedef unsigned short bf16_t;
typedef short bf16x8 __attribute__((ext_vector_type(8)));
typedef float f32x4 __attribute__((ext_vector_type(4)));
typedef unsigned u32x4 __attribute__((ext_vector_type(4)));
constexpr int BM = 256, BK = 64, HALF = 128, HTB = HALF * BK * 2  , STAGE_BYTES = 8 * HTB, NXCD = 8, WGM = 8;

__host__ __device__ __forceinline__ int lds_byte(int r, int c) { const int st = (r >> 4) * 2 + (c >> 5), rr = r & 15, cc = c & 31, ob = rr * 64 + cc * 2; return st * 1024 + (ob ^ (((ob >> 9) & 1) << 5)); }
__host__ __device__ __forceinline__ void stage_rc(int b, int& R, int& C) { const int st = b / 1024, sb = b % 1024, swz = sb ^ (((sb >> 9) & 1) << 5); R = (st >> 1) * 16 + swz / 64; C = (st & 1) * 32 + (swz % 64) / 2; }
__host__ __device__ __forceinline__ int perm32(int rho) { const int n = rho >> 4, i = rho & 15; return 8 * (i >> 2) + 4 * n + (i & 3); }

struct Unit { int pm, pn; };
struct Gemm { const bf16_t* A; const bf16_t* Bt; int M, N, K; };

struct StaticOrder {
    int nM, nN, nwg, G, c;
    __host__ __device__ void init(int M, int N, int G_, int c_) { nM = M / BM; nN = N / BM; nwg = nM * nN; G = G_; c = c_; }
    __host__ __device__ bool next(int i, Unit& u) const {
        const long L = (long)i * G + c; if (L >= nwg) return false;
        int wgid = (int)L; { const int q = nwg / NXCD, r = nwg % NXCD, xcd = wgid % NXCD, off = wgid / NXCD; wgid = (xcd < r ? xcd * (q + 1) : r * (q + 1) + (xcd - r) * q) + off; }
        const int nig = WGM * nN, gid = wgid / nig, fm = gid * WGM, gsz = (nM - fm) < WGM ? (nM - fm) : WGM;
        u.pm = fm + ((wgid % nig) % gsz); u.pn = (wgid % nig) / gsz; return true;
    }
    __device__ __forceinline__ void a_ready(const Unit&) const {}
    __device__ __forceinline__ void done(const Unit&) const {}
};

__device__ __forceinline__ unsigned cvt_pk_bf16(float lo, float hi) { unsigned r; asm volatile("v_cvt_pk_bf16_f32 %0, %1, %2" : "=v"(r) : "v"(lo), "v"(hi)); return r; }
typedef float f32x2 __attribute__((ext_vector_type(2)));
__device__ __forceinline__ f32x2 gelu_pk(f32x2 v) {
    const f32x2 av = __builtin_elementwise_abs(v), d = av * 0.2316418882f + 1.0f;
    f32x2 t; t.x = __builtin_amdgcn_rcpf(d.x); t.y = __builtin_amdgcn_rcpf(d.y);
    f32x2 q = t * 0.5307027145f + (-0.7265760135f); q = q * t + 0.7107068705f; q = q * t + (-0.142248368f); q = q * t + 0.127414796f; q = q * t;
    const f32x2 s = (v * v) * (-0.72134752044f);
    f32x2 e; e.x = __builtin_amdgcn_exp2f(s.x); e.y = __builtin_amdgcn_exp2f(s.y);
    const f32x2 m = v * (q * e), r = v - m;
    f32x2 o; o.x = v.x < 0.f ? m.x : r.x; o.y = v.y < 0.f ? m.y : r.y; return o;
}

template <int ACT  > struct EpiBf16 {
    static constexpr bool PERM = true, AFTER_DRAIN = false; static_assert(ACT == 0 || ACT == 1, "EpiBf16: ACT is 0 (none) or 1 (gelu_pk)");
    bf16_t* O; int ldc; const float* bias; int split_cols; size_t split_stride; float scale0;
    __device__ __forceinline__ void operator()(const f32x4 (&acc)[2][2][4][2], const Unit& u, int wr, int wc, int fr, int fq) const {
        const int row0 = u.pm * BM + wr * 64 + fr; int colt = u.pn * BM; bf16_t* base = O;
        float sc = 1.f; if (split_cols) { const int t = colt / split_cols; base += (size_t)t * split_stride; colt -= t * split_cols; if (t == 0) sc = scale0; }
        const int col0 = colt + wc * 32 + 8 * fq, bcol0 = u.pn * BM + wc * 32 + 8 * fq;
        f32x4 bv[2][2];
#pragma unroll
        for (int bj = 0; bj < 2; ++bj)
#pragma unroll
            for (int n = 0; n < 2; ++n) bv[bj][n] = bias ? *(const f32x4*)(bias + bcol0 + bj * HALF + 4 * n) : (f32x4){0.f, 0.f, 0.f, 0.f};
#pragma unroll
        for (int ai = 0; ai < 2; ++ai)
#pragma unroll
            for (int m = 0; m < 4; ++m) { bf16_t* rowp = base + (size_t)(row0 + ai * HALF + m * 16) * ldc + col0;
#pragma unroll
                for (int bj = 0; bj < 2; ++bj) { f32x4 v0 = acc[ai][bj][m][0] + bv[bj][0], v1 = acc[ai][bj][m][1] + bv[bj][1];
                    if (ACT == 1) { f32x2 a = gelu_pk((f32x2){v0[0], v0[1]}), b = gelu_pk((f32x2){v0[2], v0[3]}), c = gelu_pk((f32x2){v1[0], v1[1]}), d = gelu_pk((f32x2){v1[2], v1[3]});
                        v0 = (f32x4){a.x, a.y, b.x, b.y}; v1 = (f32x4){c.x, c.y, d.x, d.y}; }
                    v0 = v0 * sc; v1 = v1 * sc; u32x4 w; w.x = cvt_pk_bf16(v0[0], v0[1]); w.y = cvt_pk_bf16(v0[2], v0[3]); w.z = cvt_pk_bf16(v1[0], v1[1]); w.w = cvt_pk_bf16(v1[2], v1[3]);
                    *(u32x4*)(rowp + bj * HALF) = w; } }
    }
};

template <class Epi, class Sched, bool ALIGN_EPI = false, bool SP2 = false>
__device__ __forceinline__ void gemm_phase(PG8_LAS unsigned char* lds, const Gemm g, const Sched& S, const Epi& E) {
    const int tid = threadIdx.x, wid = __builtin_amdgcn_readfirstlane(tid >> 6), lane = tid & 63, wr = wid >> 2, wc = wid & 3, fr = lane & 15, fq = lane >> 4;
    const int K = g.K, nt = K / BK;
    unsigned voffA[2], voffB[2];
#pragma unroll
    for (int i = 0; i < 2; ++i) { int R, C; stage_rc(tid * 16 + i * 8192, R, C); const int Rb = Epi::PERM ? ((R & ~31) + perm32(R & 31)) : R;
        voffA[i] = (unsigned)(R * K + C) * 2u; voffB[i] = (unsigned)(Rb * K + C) * 2u; }
    const size_t kstep = (size_t)(BK * 2);
    const size_t hstep = (size_t)HALF * K * 2;
    const size_t tstep = 2 * hstep;
    const unsigned ldsw = (unsigned)wid * 1024u;
    const int aoff = lds_byte(wr * 64 + fr, fq * 8), boff = lds_byte(wc * 32 + fr, fq * 8);
#define PG8_SA(b, h) (((b) * 2 + (h)) * HTB)
#define PG8_SB(b, h) ((4 + (b) * 2 + (h)) * HTB)
#define PG8_STAGE(bufoff, gbase, voff) do { _Pragma("unroll") for (int _i = 0; _i < 2; ++_i) \
        __builtin_amdgcn_global_load_lds((const unsigned*)((const char*)(gbase) + (voff)[_i]), (PG8_LAS unsigned*)(lds + (bufoff) + ldsw + _i * 8192), 16, 0, 0); } while (0)
#define PG8_LDA(dst, b, h) do { _Pragma("unroll") for (int m = 0; m < 4; ++m) _Pragma("unroll") for (int k = 0; k < 2; ++k) dst[m][k] = *(const PG8_LAS bf16x8*)(lds + PG8_SA(b, h) + aoff + m * 2048 + k * 1024); } while (0)
#define PG8_LDB(dst, b, h) do { _Pragma("unroll") for (int n = 0; n < 2; ++n) _Pragma("unroll") for (int k = 0; k < 2; ++k) dst[n][k] = *(const PG8_LAS bf16x8*)(lds + PG8_SB(b, h) + boff + n * 2048 + k * 1024); } while (0)
#define PG8_MMA(ai, bj, At, Bt) do { __builtin_amdgcn_s_setprio(1); _Pragma("unroll") for (int m = 0; m < 4; ++m) _Pragma("unroll") for (int n = 0; n < 2; ++n) _Pragma("unroll") for (int k = 0; k < 2; ++k) \
        acc[ai][bj][m][n] = __builtin_amdgcn_mfma_f32_16x16x32_bf16(Bt[n][k], At[m][k], acc[ai][bj][m][n], 0, 0, 0); __builtin_amdgcn_s_setprio(0); } while (0)
#define PG8_WAIT_V(n) asm volatile("s_waitcnt vmcnt(" #n ")" ::: "memory")
#define PG8_WAIT_L(n) asm volatile("s_waitcnt lgkmcnt(" #n ")" ::: "memory")
#define PG8_BAR __builtin_amdgcn_s_barrier()
#define PG8_SCHED __builtin_amdgcn_sched_barrier(0)
    Unit cur, nxt; int ui = 0;
    if (!S.next(0, cur)) return;
    f32x4 acc[2][2][4][2];
#pragma unroll
    for (int a = 0; a < 2; ++a)
#pragma unroll
        for (int b = 0; b < 2; ++b)
#pragma unroll
            for (int m = 0; m < 4; ++m)
#pragma unroll
                for (int n = 0; n < 2; ++n) acc[a][b][m][n] = (f32x4){0.f, 0.f, 0.f, 0.f};
    bf16x8 At[4][2], B0[2][2], B1[2][2];
    const char* cA = (const char*)g.A + (size_t)cur.pm * tstep; const char* cB = (const char*)g.Bt + (size_t)cur.pn * tstep;
    S.a_ready(cur);
    if constexpr (SP2) {
        PG8_STAGE(PG8_SB(0, 0), cB, voffB); PG8_STAGE(PG8_SB(0, 1), cB + hstep, voffB); PG8_STAGE(PG8_SA(0, 0), cA, voffA); PG8_STAGE(PG8_SA(0, 1), cA + hstep, voffA);
        if (wr == 1) PG8_BAR;
        PG8_WAIT_V(2); PG8_BAR;
        PG8_STAGE(PG8_SB(1, 0), cB + kstep, voffB); PG8_STAGE(PG8_SA(1, 0), cA + kstep, voffA); PG8_STAGE(PG8_SB(1, 1), cB + hstep + kstep, voffB);
        PG8_WAIT_V(6); PG8_BAR;
    } else {
        PG8_STAGE(PG8_SB(0, 0), cB, voffB); PG8_STAGE(PG8_SA(0, 0), cA, voffA); PG8_STAGE(PG8_SB(0, 1), cB + hstep, voffB); PG8_STAGE(PG8_SA(0, 1), cA + hstep, voffA);
        if (wr == 1) PG8_BAR;
        PG8_WAIT_V(4); PG8_BAR;
        PG8_STAGE(PG8_SB(1, 0), cB + kstep, voffB); PG8_STAGE(PG8_SA(1, 0), cA + kstep, voffA); PG8_STAGE(PG8_SB(1, 1), cB + hstep + kstep, voffB);
        PG8_WAIT_V(6); PG8_BAR;
    }
    for (;;) {
        const bool has_next = S.next(ui + 1, nxt);
        const char* nA = has_next ? (const char*)g.A + (size_t)nxt.pm * tstep : cA; const char* nB = has_next ? (const char*)g.Bt + (size_t)nxt.pn * tstep : cB;
        for (int t = 0; t < nt; t += 2) {
            const bool last = (t == nt - 2);
            const char* a1 = cA + (size_t)(t + 1) * kstep;
            const char* a2 = last ? nA : cA + (size_t)(t + 2) * kstep; const char* b2 = last ? nB : cB + (size_t)(t + 2) * kstep;
            const char* a3 = a2 + kstep; const char* b3 = b2 + kstep;
            if (last && has_next) S.a_ready(nxt);
            if constexpr (SP2) {
            PG8_LDB(B0, 0, 0); PG8_LDB(B1, 0, 1); PG8_SCHED; PG8_LDA(At, 0, 0); PG8_STAGE(PG8_SA(1, 1), a1 + hstep, voffA);
            PG8_WAIT_V(8); PG8_WAIT_L(0); PG8_BAR; PG8_MMA(0, 0, At, B0); PG8_MMA(0, 1, At, B1); PG8_BAR; PG8_SCHED;
            PG8_LDA(At, 0, 1); PG8_STAGE(PG8_SB(0, 0), b2, voffB); PG8_STAGE(PG8_SB(0, 1), b2 + hstep, voffB); PG8_STAGE(PG8_SA(0, 0), a2, voffA);
            PG8_WAIT_V(8); PG8_WAIT_L(0); PG8_BAR; PG8_MMA(1, 0, At, B0); PG8_MMA(1, 1, At, B1); PG8_BAR; PG8_SCHED;
            PG8_LDB(B0, 1, 0); PG8_LDB(B1, 1, 1); PG8_SCHED; PG8_LDA(At, 1, 0); PG8_STAGE(PG8_SA(0, 1), a2 + hstep, voffA);
            PG8_WAIT_V(8); PG8_WAIT_L(0); PG8_BAR; PG8_MMA(0, 0, At, B0); PG8_MMA(0, 1, At, B1); PG8_BAR; PG8_SCHED;
            PG8_LDA(At, 1, 1); PG8_STAGE(PG8_SB(1, 0), b3, voffB); PG8_STAGE(PG8_SB(1, 1), b3 + hstep, voffB); PG8_STAGE(PG8_SA(1, 0), a3, voffA);
            PG8_WAIT_V(8); PG8_WAIT_L(0); PG8_BAR; PG8_MMA(1, 0, At, B0); PG8_MMA(1, 1, At, B1); PG8_BAR; PG8_SCHED;
            } else {
            PG8_LDB(B0, 0, 0); PG8_SCHED; PG8_LDA(At, 0, 0); PG8_STAGE(PG8_SA(1, 1), a1 + hstep, voffA);
            PG8_WAIT_L(8); PG8_BAR; PG8_WAIT_L(0); PG8_MMA(0, 0, At, B0); PG8_BAR; PG8_SCHED;
            PG8_LDB(B1, 0, 1); PG8_STAGE(PG8_SB(0, 0), b2, voffB);
            PG8_BAR; PG8_WAIT_L(0); PG8_MMA(0, 1, At, B1); PG8_BAR;
            PG8_LDA(At, 0, 1); PG8_STAGE(PG8_SA(0, 0), a2, voffA);
            PG8_BAR; PG8_WAIT_L(0); PG8_MMA(1, 0, At, B0); PG8_BAR; PG8_SCHED;
            PG8_STAGE(PG8_SB(0, 1), b2 + hstep, voffB);
            PG8_WAIT_V(6); PG8_BAR; PG8_MMA(1, 1, At, B1); PG8_BAR;
            PG8_LDB(B0, 1, 0); PG8_SCHED; PG8_LDA(At, 1, 0); PG8_STAGE(PG8_SA(0, 1), a2 + hstep, voffA);
            PG8_WAIT_L(8); PG8_BAR; PG8_WAIT_L(0); PG8_MMA(0, 0, At, B0); PG8_BAR; PG8_SCHED;
            PG8_LDB(B1, 1, 1); PG8_STAGE(PG8_SB(1, 0), b3, voffB);
            PG8_BAR; PG8_WAIT_L(0); PG8_MMA(0, 1, At, B1); PG8_BAR;
            PG8_LDA(At, 1, 1); PG8_STAGE(PG8_SA(1, 0), a3, voffA);
            PG8_BAR; PG8_WAIT_L(0); PG8_MMA(1, 0, At, B0); PG8_BAR; PG8_SCHED;
            PG8_STAGE(PG8_SB(1, 1), b3 + hstep, voffB);
            PG8_WAIT_V(6); PG8_BAR; PG8_MMA(1, 1, At, B1); PG8_BAR;
            }
        }
        if constexpr (ALIGN_EPI) { if (wr == 0) PG8_BAR; }
        if constexpr (!Epi::AFTER_DRAIN) { E(acc, cur, wr, wc, fr, fq); S.done(cur); }
        if (!has_next) break;
#pragma unroll
        for (int a = 0; a < 2; ++a)
#pragma unroll
            for (int b = 0; b < 2; ++b)
#pragma unroll
                for (int m = 0; m < 4; ++m)
#pragma unroll
                    for (int n = 0; n < 2; ++n) acc[a][b][m][n] = (f32x4){0.f, 0.f, 0.f, 0.f};
        cur = nxt; cA = nA; cB = nB; ++ui;
        if constexpr (ALIGN_EPI) { if (wr == 1) PG8_BAR; }
    }
    PG8_WAIT_V(0);
    if constexpr (!ALIGN_EPI) { if (wr == 0) PG8_BAR; }
    PG8_BAR;
    if constexpr (Epi::AFTER_DRAIN) { E.fused(acc, cur, wr, wc, fr, fq, lds, wid, lane); S.done(cur); }
#undef PG8_SA
#undef PG8_SB
#undef PG8_STAGE
#undef PG8_LDA
#undef PG8_LDB
#undef PG8_MMA
#undef PG8_WAIT_V
#undef PG8_WAIT_L
#undef PG8_BAR
#undef PG8_SCHED
}
}

#ifndef PG8_SP2
#define PG8_SP2 true
#endif
#ifndef PG8_ALIGN
#define PG8_ALIGN true
#endif
namespace pg8 {
__device__ __forceinline__ float gelu1(float v) {
    const float av = __builtin_fabsf(v), t = __builtin_amdgcn_rcpf(av * 0.2316418882f + 1.0f);
    float q = t * 0.5307027145f + (-0.7265760135f); q = q * t + 0.7107068705f; q = q * t + (-0.142248368f); q = q * t + 0.127414796f; q = q * t;
    const float e = __builtin_amdgcn_exp2f((v * v) * (-0.72134752044f));
    const float m = v * (q * e), r = v - m; return v < 0.f ? m : r;
}
struct EpiInProj {
    static constexpr bool PERM = true, AFTER_DRAIN = false;
    bf16_t *QA, *KA, *VA, *QG, *KG, *VG, *GG; float* LOGA; const float* bgate; float qscale;
    __device__ __forceinline__ void operator()(f32x4 (&acc)[2][2][4][2], const Unit& u, int wr, int wc, int fr, int fq) const {
        const int pn = u.pn; const int row0 = u.pm * BM + wr * 64 + fr;
        if (pn < 12) {
            bf16_t* base; int ldc, colt; float sc = 1.f;
            if (pn < 2) { base = QA; ldc = 512; colt = pn * 256; sc = qscale; }
            else if (pn < 4) { base = KA; ldc = 512; colt = (pn - 2) * 256; }
            else if (pn < 6) { base = VA; ldc = 512; colt = (pn - 4) * 256; }
            else if (pn == 6) { base = QG; ldc = 256; colt = 0; }
            else if (pn == 7) { base = KG; ldc = 256; colt = 0; }
            else if (pn < 10) { base = VG; ldc = 512; colt = (pn - 8) * 256; }
            else { base = GG; ldc = 512; colt = (pn - 10) * 256; }
            const int col0 = colt + wc * 32 + 8 * fq;
#pragma unroll
            for (int ai = 0; ai < 2; ++ai)
#pragma unroll
                for (int m = 0; m < 4; ++m) { bf16_t* rowp = base + (size_t)(row0 + ai * HALF + m * 16) * ldc + col0;
#pragma unroll
                    for (int bj = 0; bj < 2; ++bj) { const f32x4 v0 = acc[ai][bj][m][0] * sc, v1 = acc[ai][bj][m][1] * sc;
                        u32x4 w; w.x = cvt_pk_bf16(v0[0], v0[1]); w.y = cvt_pk_bf16(v0[2], v0[3]); w.z = cvt_pk_bf16(v1[0], v1[1]); w.w = cvt_pk_bf16(v1[2], v1[3]);
                        *(u32x4*)(rowp + bj * HALF) = w; } }
        } else {
            const int col0 = wc * 32 + 8 * fq;
            f32x4 bv[2][2];
#pragma unroll
            for (int bj = 0; bj < 2; ++bj)
#pragma unroll
                for (int n = 0; n < 2; ++n) bv[bj][n] = *(const f32x4*)(bgate + col0 + bj * HALF + 4 * n);
#pragma unroll
            for (int ai = 0; ai < 2; ++ai)
#pragma unroll
                for (int m = 0; m < 4; ++m) { float* rowp = LOGA + (size_t)(row0 + ai * HALF + m * 16) * 256 + col0;
#pragma unroll
                    for (int bj = 0; bj < 2; ++bj)
#pragma unroll
                        for (int n = 0; n < 2; ++n) { const f32x4 z = acc[ai][bj][m][n] + bv[bj][n]; f32x4 la;
#pragma unroll
                            for (int j = 0; j < 4; ++j) la[j] = (__builtin_fminf(z[j], 0.f) - __logf(1.0f + __expf(-__builtin_fabsf(z[j])))) * 0.0625f;
                            *(f32x4*)(rowp + bj * HALF + 4 * n) = la; } }
        }
    }
};
struct EpiConvGlu {
    static constexpr bool PERM = true, AFTER_DRAIN = false;
    bf16_t* ACT; const float* bup; const float* cw; const float* cb; float* HALO; float* FIXS; float* FIXV; PG8_LAS float* H;
    __device__ __forceinline__ void operator()(f32x4 (&acc)[2][2][4][2], const Unit& u, int wr, int wc, int fr, int fq) const {
        constexpr int FFD = 2816; typedef unsigned u32x2 __attribute__((ext_vector_type(2)));
        const int lane = fr + 16 * fq, chl = wc * 32 + 8 * fq, ch0 = u.pn * 128 + chl;
        {   f32x4 bv[2], bg[2];
#pragma unroll
            for (int n = 0; n < 2; ++n) { bv[n] = *(const f32x4*)(bup + ch0 + 4 * n); bg[n] = *(const f32x4*)(bup + FFD + ch0 + 4 * n); }
#pragma unroll
            for (int ai = 0; ai < 2; ++ai)
#pragma unroll
                for (int m = 0; m < 4; ++m)
#pragma unroll
                    for (int n = 0; n < 2; ++n) { acc[ai][1][m][n] += bg[n]; acc[ai][0][m][n] += bv[n]; } }
        if (fr >= 14) {
#pragma unroll
            for (int ai = 0; ai < 2; ++ai) { const int bnd = 2 * ai + wr + 1;
#pragma unroll
                for (int n = 0; n < 2; ++n) {
                    if (bnd < 4) *(PG8_LAS f32x4*)(H + (bnd * 2 + (fr - 14)) * 128 + chl + 4 * n) = acc[ai][1][3][n];
                    else *(f32x4*)(HALO + ((size_t)u.pm * 2 + (fr - 14)) * FFD + ch0 + 4 * n) = acc[ai][1][3][n]; } }
        }
        asm volatile("s_waitcnt lgkmcnt(0)" ::: "memory"); __builtin_amdgcn_s_barrier(); asm volatile("" ::: "memory");
        const int l1 = (lane & 48) | ((fr + 15) & 15), l2 = (lane & 48) | ((fr + 14) & 15), l14 = (lane & 48) | 14, l15 = (lane & 48) | 15;
#pragma unroll
        for (int n = 0; n < 2; ++n) {
            const f32x4 w0 = *(const f32x4*)(cw + ch0 + 4 * n), w1 = *(const f32x4*)(cw + FFD + ch0 + 4 * n), w2 = *(const f32x4*)(cw + 2 * FFD + ch0 + 4 * n), cbv = *(const f32x4*)(cb + ch0 + 4 * n);
#pragma unroll
            for (int ai = 0; ai < 2; ++ai)
#pragma unroll
                for (int m = 0; m < 4; ++m) {
                    f32x4 p14, p15;
                    if (m == 0) { const int bnd = 2 * ai + wr;
                        if (bnd == 0) { p14 = (f32x4){0.f, 0.f, 0.f, 0.f}; p15 = p14; }
                        else { p14 = *(const PG8_LAS f32x4*)(H + (bnd * 2 + 0) * 128 + chl + 4 * n); p15 = *(const PG8_LAS f32x4*)(H + (bnd * 2 + 1) * 128 + chl + 4 * n); }
                    } else {
#pragma unroll
                        for (int j = 0; j < 4; ++j) { p14[j] = __shfl(acc[ai][1][m - 1][n][j], l14); p15[j] = __shfl(acc[ai][1][m - 1][n][j], l15); }
                    }
                    const size_t row = (size_t)u.pm * BM + ai * HALF + wr * 64 + m * 16 + fr;
                    const f32x4 cur = acc[ai][1][m][n]; f32x4 s1, s2;
#pragma unroll
                    for (int j = 0; j < 4; ++j) { s1[j] = __shfl(cur[j], l1); s2[j] = __shfl(cur[j], l2); }
                    const f32x4 pr1 = (fr == 0) ? p15 : s1, pr2 = (fr == 0) ? p14 : ((fr == 1) ? p15 : s2);
                    const f32x4 cv = w0 * pr2 + w1 * pr1 + w2 * cur + cbv, hv = acc[ai][0][m][n];
                    const f32x2 ga = gelu_pk((f32x2){cv[0], cv[1]}), gb = gelu_pk((f32x2){cv[2], cv[3]});
                    u32x2 w; w.x = cvt_pk_bf16(ga.x * hv[0], ga.y * hv[1]); w.y = cvt_pk_bf16(gb.x * hv[2], gb.y * hv[3]);
                    *(u32x2*)(ACT + row * FFD + ch0 + 4 * n) = w;
                    if (ai == 0 && m == 0) { if (wr == 0 && fr < 2) { *(f32x4*)(FIXS + ((size_t)u.pm * 2 + fr) * FFD + ch0 + 4 * n) = cv; *(f32x4*)(FIXV + ((size_t)u.pm * 2 + fr) * FFD + ch0 + 4 * n) = hv; } }
                }
        }
    }
};
}
#include <hip/hip_bf16.h>
#include <cmath>
namespace attn_body {
using bf16=__hip_bfloat16;
using bf16x8=__attribute__((ext_vector_type(8)))short;
using s16x4=__attribute__((ext_vector_type(4)))short;
using f32x16=__attribute__((ext_vector_type(16)))float;
using u32x4=__attribute__((ext_vector_type(4)))unsigned;
using f32x4_t=__attribute__((ext_vector_type(4)))float;
constexpr int BATCH=8,NHEAD=8,SEQ=4096,D=64,DM=NHEAD*D,ODM=1024;
constexpr int NW=8,QBLK=32,QB=QBLK*NW,KVBLK=64,NQB=SEQ/QB;
constexpr int ATTN_UNIT_ROWS=QB;
__device__ __forceinline__ int crow(int r,int hi){return (r&3)+8*(r>>2)+4*hi;}
#define SBAR() __builtin_amdgcn_sched_barrier(0)
__device__ __forceinline__ void cmask(f32x16&p0,f32x16&p1,int jb,int qrel,int hi){
  const float NEG=-INFINITY; int kb=64*jb+4*hi;
  #pragma unroll
  for(int r=0;r<16;++r){int kv=kb+(r&3)+8*(r>>2); if(kv>qrel)p0[r]=NEG; if(kv+32>qrel)p1[r]=NEG;}
}

constexpr int NSLOT=3, SLOTB=8192;
constexpr int LDS_K=0, LDS_V=NSLOT*SLOTB, LDS_WS=2*NSLOT*SLOTB, LDS_OST=LDS_WS+NW*64*4, LDS_KM=LDS_OST+NW*8192, LDS_BYTES=LDS_KM+8192;
constexpr float C2=0.125f*1.4426950408889634f;
__device__ __forceinline__ void glds16(const void*gsrc,unsigned lds_dst){unsigned keep;
  asm volatile("s_mov_b32 %0, m0\n\ts_mov_b32 m0, %2\n\ts_nop 0\n\tglobal_load_lds_dwordx4 %1, off\n\ts_mov_b32 m0, %0":"=&s"(keep):"v"(gsrc),"s"(lds_dst):"memory");}
__device__ __forceinline__ float max3f(float a,float b,float c){float r;asm("v_max3_f32 %0, %1, %2, %3":"=v"(r):"v"(a),"v"(b),"v"(c));return r;}
__device__ __forceinline__ float max2f(float a,float b){float r;asm("v_max_f32_e32 %0, %1, %2":"=v"(r):"v"(a),"v"(b));return r;}
__device__ __forceinline__ float fadd_s(float a,float b){float r;asm("v_add_f32_e32 %0, %1, %2":"=v"(r):"v"(a),"v"(b));return r;}
__device__ __forceinline__ float fsub_s(float a,float b){float r;asm("v_sub_f32_e32 %0, %1, %2":"=v"(r):"v"(a),"v"(b));return r;}
typedef float f32x2_t __attribute__((ext_vector_type(2))); typedef __bf16 bf16x2_t __attribute__((ext_vector_type(2)));
__device__ __forceinline__ unsigned cvtpk_s(float lo,float hi){f32x2_t v={lo,hi};bf16x2_t b=__builtin_convertvector(v,bf16x2_t);return __builtin_bit_cast(unsigned,b);}
#define WAIT_BAR(N) asm volatile("s_waitcnt vmcnt(" #N ") lgkmcnt(0)\n\ts_barrier":::"memory")

__device__ __forceinline__ void qkt(f32x16&p0,f32x16&p1,const char*Kslot,const bf16x8*qr,const f32x16&negm,int r32,int hi){
  const char*kb=Kslot+hi*1024+r32*16;
  #pragma unroll
  for(int d0=0;d0<4;++d0){
    const bf16x8 b0=*reinterpret_cast<const bf16x8*>(kb+d0*2048);
    const bf16x8 b1=*reinterpret_cast<const bf16x8*>(kb+d0*2048+512);
    if(d0==0){p0=__builtin_amdgcn_mfma_f32_32x32x16_bf16(b0,qr[0],negm,0,0,0);p1=__builtin_amdgcn_mfma_f32_32x32x16_bf16(b1,qr[0],negm,0,0,0);}
    else{p0=__builtin_amdgcn_mfma_f32_32x32x16_bf16(b0,qr[d0],p0,0,0,0);p1=__builtin_amdgcn_mfma_f32_32x32x16_bf16(b1,qr[d0],p1,0,0,0);}}
}
typedef __attribute__((address_space(3))) const char* lds_cptr;
typedef short v4i16_t __attribute__((ext_vector_type(4)));
__device__ __forceinline__ void kload8(bf16x8*kf,lds_cptr kp){
  kf[0]=*(const __attribute__((address_space(3))) bf16x8*)(kp);      kf[1]=*(const __attribute__((address_space(3))) bf16x8*)(kp+512);
  kf[2]=*(const __attribute__((address_space(3))) bf16x8*)(kp+2048); kf[3]=*(const __attribute__((address_space(3))) bf16x8*)(kp+2560);
  kf[4]=*(const __attribute__((address_space(3))) bf16x8*)(kp+4096); kf[5]=*(const __attribute__((address_space(3))) bf16x8*)(kp+4608);
  kf[6]=*(const __attribute__((address_space(3))) bf16x8*)(kp+6144); kf[7]=*(const __attribute__((address_space(3))) bf16x8*)(kp+6656);
}
__device__ __forceinline__ void kload2(bf16x8*kf,lds_cptr kp,int j){ kf[2*j]=*(const __attribute__((address_space(3))) bf16x8*)(kp+j*2048); kf[2*j+1]=*(const __attribute__((address_space(3))) bf16x8*)(kp+j*2048+512); }
__device__ __forceinline__ s16x4 vtr(lds_cptr p){ return __builtin_bit_cast(s16x4,__builtin_amdgcn_ds_read_tr16_b64_v4i16((__attribute__((address_space(3))) v4i16_t*)p)); }
__device__ __forceinline__ float rowmax(const f32x16&p0,const f32x16&p1){
  float a=max3f(p0[0],p0[1],p1[0]),b=max3f(p0[2],p0[3],p1[1]);a=max3f(a,p1[2],p1[3]);
  #pragma unroll
  for(int r=4;r<16;r+=4){a=max3f(a,p0[r],p0[r+1]);b=max3f(b,p0[r+2],p0[r+3]);a=max3f(a,p1[r],p1[r+1]);b=max3f(b,p1[r+2],p1[r+3]);}
  const float m=max2f(a,b);
  auto rr=__builtin_amdgcn_permlane32_swap(__float_as_uint(m),__float_as_uint(m),false,false);
  return max2f(__uint_as_float(rr[0]),__uint_as_float(rr[1]));
}
__device__ __forceinline__ void pv(f32x16*o,int vb,bf16x8 pa0,bf16x8 pa1,bf16x8 pa2,bf16x8 pa3){
  #pragma unroll
  for(int d0=0;d0<2;++d0){s16x4 lo[4],hi[4];
    #pragma unroll
    for(int ks=0;ks<4;++ks){
      asm volatile("ds_read_b64_tr_b16 %0,%1 offset:%c2":"=&v"(lo[ks]):"v"(vb),"i"(d0*4096+ks*1024):"memory");
      asm volatile("ds_read_b64_tr_b16 %0,%1 offset:%c2":"=&v"(hi[ks]):"v"(vb),"i"(d0*4096+ks*1024+512):"memory");}
    asm volatile("s_waitcnt lgkmcnt(0)":::"memory");SBAR();
    #define PK(k) (bf16x8){lo[k][0],lo[k][1],lo[k][2],lo[k][3],hi[k][0],hi[k][1],hi[k][2],hi[k][3]}
    o[d0]=__builtin_amdgcn_mfma_f32_32x32x16_bf16(pa0,PK(0),o[d0],0,0,0);
    o[d0]=__builtin_amdgcn_mfma_f32_32x32x16_bf16(pa1,PK(1),o[d0],0,0,0);
    o[d0]=__builtin_amdgcn_mfma_f32_32x32x16_bf16(pa2,PK(2),o[d0],0,0,0);
    o[d0]=__builtin_amdgcn_mfma_f32_32x32x16_bf16(pa3,PK(3),o[d0],0,0,0);
    #undef PK
  }
}

#ifndef ATTN_STORE16
#define ATTN_STORE16(p,v) (*(u32x4*)(p)=(v))
#endif
template<int THRL> __device__ __forceinline__ void attn_unit(int b,int h,int qb,const bf16*Q,const bf16* K,const bf16* V,bf16*O,const float*KMEAN,const float*GN,char*shm){
  int tid=threadIdx.x; asm volatile("":"+v"(tid));
  const int lane=tid&63,r32=lane&31,hi=lane>>5; const int wid=__builtin_amdgcn_readfirstlane(tid>>6);
  const long rowbase=(long)b*SEQ; const int q0=qb*QB;
  const bf16*Qw=Q+(rowbase+q0+wid*QBLK)*DM+h*D;
  const bf16*Kh=K+rowbase*DM+h*D,*Vh=V+rowbase*DM+h*D;
  const unsigned lds0=(unsigned)(uintptr_t)shm;
  float*wsf=(float*)(shm+LDS_WS)+wid*64;
  const bf16*ksrc=Kh+(long)lane*DM+wid*8;
  const bf16*vsrc=Vh+(long)(16*(wid&3)+(lane>>2))*DM+(wid>>2)*32+(lane&3)*8;
  const unsigned kdst=lds0+LDS_K+wid*1024, vdst=lds0+LDS_V+wid*1024;
  #define DMA_K(t,slot) glds16(ksrc+(long)(t)*KVBLK*DM,(unsigned)__builtin_amdgcn_readfirstlane(kdst+(slot)))
  #define DMA_V(t,slot) glds16(vsrc+(long)(t)*KVBLK*DM,(unsigned)__builtin_amdgcn_readfirstlane(vdst+(slot)))
  const int vb0=(int)(lds0+LDS_V)+((lane>>4)&1)*32+(lane&3)*8+(4*hi+((lane&15)>>2))*64;
  const char*Kbase=shm+LDS_K; bf16x8 kf[8];
  const lds_cptr shm3=(lds_cptr)shm; const lds_cptr kp0=shm3+LDS_K+hi*1024+r32*16; const lds_cptr vp0=shm3+LDS_V+((lane>>4)&1)*32+(lane&3)*8+(4*hi+((lane&15)>>2))*64;
  const int NT=(q0+QB)/KVBLK;
  DMA_K(0,0);DMA_V(0,0);DMA_K(1,SLOTB);
  bf16x8 qr[4];
  #pragma unroll
  for(int d0=0;d0<4;++d0)qr[d0]=*reinterpret_cast<const bf16x8*>(&Qw[(long)r32*DM+d0*16+hi*8]);
  unsigned selmask=1u<<qb;
  {
    f32x16 sp=f32x16{};
    #pragma unroll
    for(int d0=0;d0<4;++d0){ const bf16x8 ah=*reinterpret_cast<const bf16x8*>(shm+LDS_KM+(2*d0+hi)*512+r32*16), al=*reinterpret_cast<const bf16x8*>(shm+LDS_KM+4096+(2*d0+hi)*512+r32*16);
      sp=__builtin_amdgcn_mfma_f32_32x32x16_bf16(ah,qr[d0],sp,0,0,0); sp=__builtin_amdgcn_mfma_f32_32x32x16_bf16(al,qr[d0],sp,0,0,0); }
    float sc[16];
    #pragma unroll
    for(int r=0;r<8;++r){ auto rr=__builtin_amdgcn_permlane32_swap(__float_as_uint(sp[r]),__float_as_uint(sp[r]),false,false);
      sc[crow(r,0)]=__uint_as_float(rr[0]); sc[crow(r,1)]=__uint_as_float(rr[1]); }
    #pragma unroll
    for(int k=0;k<3;++k){ if(k<qb){ float best=-INFINITY; int bi=0;
        #pragma unroll
        for(int n=0;n<15;++n){ const bool ok=(n<qb)&&!((selmask>>n)&1u)&&(sc[n]>best); best=ok?sc[n]:best; bi=ok?n:bi; }
        selmask|=1u<<bi; } } }
  float mhat=0.f,l_reg=0.f;f32x16 o[2];o[0]=f32x16{};o[1]=f32x16{};
  f32x16 cinb;
  #define CINIT(t) do{ if(resc||(((t)&3)==0)){ const float cv_=((selmask>>((t)>>2))&1u)?-mhat:-1e30f; _Pragma("unroll") for(int r=0;r<16;++r)cinb[r]=cv_; asm volatile("":"+v"(cinb)); } }while(0)
  selmask|=(unsigned)(wid*QBLK+r32)<<16;
  #define qrel ((int)(selmask>>16))
  #define CMASK(P0,P1,t) do{int jb_=(t)-(NT-4); if(jb_>=0)cmask(P0,P1,jb_,qrel,hi);}while(0)
  bool resc=false;
  #define START(P0,P1) do{ const float rm=rowmax(P0,P1); resc=false; \
    { const float dl=(rm<-1e29f)?0.f:rm; mhat=fadd_s(mhat,dl);     \
      _Pragma("unroll") for(int r=0;r<16;++r){P0[r]=fsub_s(P0[r],dl);P1[r]=fsub_s(P1[r],dl);} } \
    _Pragma("unroll") for(int r=0;r<16;++r)P0[r]=__builtin_amdgcn_exp2f(P0[r]); resc=true;   }while(0)
  #define RESC() do{ if(resc){ asm volatile("s_waitcnt lgkmcnt(0)":::"memory"); \
      _Pragma("unroll") for(int d_=0;d_<2;++d_) _Pragma("unroll") for(int r=0;r<16;++r)o[d_][r]*=wsf[crow(r,hi)]; } }while(0)
  f32x16 pA0,pA1,pB0,pB1;
  int sl_prev=0,sl_cur=0,sl_next=SLOTB;
  #define ROT() do{sl_prev=sl_cur;sl_cur=sl_next;sl_next=(sl_next==(NSLOT-1)*SLOTB)?0:sl_next+SLOTB;}while(0)
  DMA_K(2,2*SLOTB);
  WAIT_BAR(3);
  resc=true; CINIT(0); qkt(pA0,pA1,Kbase,qr,cinb,r32,hi); asm volatile("s_nop 15\n\ts_nop 7":"+v"(pA0),"+v"(pA1));CMASK(pA0,pA1,0);
  START(pA0,pA1);
  _Pragma("unroll") for(int r=0;r<16;++r)pA1[r]=__builtin_amdgcn_exp2f(pA1[r]);
  WAIT_BAR(0);
  DMA_K(3,0);DMA_V(1,SLOTB);
  ROT();
  kload8(kf,kp0+sl_cur);
  WAIT_BAR(2);
  s16x4 vlo[8],vhi[8]; u32x4 pw0,pw1,pw2,pw3;
  #define PKW(P,B) cvtpk_s(P[B],P[B+1])
  #define PAF(k) __builtin_bit_cast(bf16x8,pw##k)
  #define VFR(i) (bf16x8){vlo[i][0],vlo[i][1],vlo[i][2],vlo[i][3],vhi[i][0],vhi[i][1],vhi[i][2],vhi[i][3]}
  #define PIN(x) asm volatile("":"+v"(x))
  #define MX3(a,b,c) __builtin_fmaxf(__builtin_fmaxf((a),(b)),(c))
  #define GAPA(MF,A0,A1,A2,A3,W0,W1,PW) do{ MF; sacc+=A0; sacc+=A1; sacc+=A2; sacc+=A3; PIN(sacc); W0; W1; PIN(PW); SBAR(); }while(0)
  #define EX(v) __builtin_amdgcn_exp2f(v)
  #define GAPB(MF,X,B) do{ MF; X[B]=EX(X[B]); X[B+1]=EX(X[B+1]); X[B+2]=EX(X[B+2]); X[B+3]=EX(X[B+3]); PIN(X); SBAR(); }while(0)
  #define VRD(i) do{ vlo[i]=vtr(vp_+(((i)>>2)*4096+((i)&3)*1024)); vhi[i]=vtr(vp_+(((i)>>2)*4096+((i)&3)*1024+512)); }while(0)
  #define KRD(G,j) do{ if(G){ kload2(kf,kp0+sl_next,j); SBAR(); } }while(0)
  #define STEP(C0,C1,P0,P1,t,GK,GV,GL) do{ SBAR(); \
    CINIT(t); SBAR(); \
    const lds_cptr vp_=vp0+sl_prev; \
    VRD(0); SBAR(); float sacc=(P0[0]+P0[1]); \
    GAPA(C0=__builtin_amdgcn_mfma_f32_32x32x16_bf16(kf[0],qr[0],cinb,0,0,0), P0[2],P0[3],P0[4],P0[5],     pw0[0]=PKW(P0,0), pw0[1]=PKW(P0,2), pw0); \
    VRD(4); SBAR(); GAPA(C1=__builtin_amdgcn_mfma_f32_32x32x16_bf16(kf[1],qr[0],cinb,0,0,0), P0[6],P0[7],P0[8],P0[9],     pw0[2]=PKW(P0,4), pw0[3]=PKW(P0,6), pw0); \
    VRD(1); SBAR(); GAPA(C0=__builtin_amdgcn_mfma_f32_32x32x16_bf16(kf[2],qr[1],C0,0,0,0),   P0[10],P0[11],P0[12],P0[13], pw1[0]=PKW(P0,8), pw1[1]=PKW(P0,10), pw1); \
    VRD(5); SBAR(); GAPA(C1=__builtin_amdgcn_mfma_f32_32x32x16_bf16(kf[3],qr[1],C1,0,0,0),   P0[14],P0[15],P1[0],P1[1],   pw1[2]=PKW(P0,12),pw1[3]=PKW(P0,14), pw1); \
    VRD(2); SBAR(); GAPA(C0=__builtin_amdgcn_mfma_f32_32x32x16_bf16(kf[4],qr[2],C0,0,0,0),   P1[2],P1[3],P1[4],P1[5],     pw2[0]=PKW(P1,0), pw2[1]=PKW(P1,2), pw2); \
    VRD(6); SBAR(); GAPA(C1=__builtin_amdgcn_mfma_f32_32x32x16_bf16(kf[5],qr[2],C1,0,0,0),   P1[6],P1[7],P1[8],P1[9],     pw2[2]=PKW(P1,4), pw2[3]=PKW(P1,6), pw2); \
    VRD(3); SBAR(); GAPA(C0=__builtin_amdgcn_mfma_f32_32x32x16_bf16(kf[6],qr[3],C0,0,0,0),   P1[10],P1[11],P1[12],P1[13], pw3[0]=PKW(P1,8), pw3[1]=PKW(P1,10), pw3); \
    VRD(7); SBAR(); GAPA(C1=__builtin_amdgcn_mfma_f32_32x32x16_bf16(kf[7],qr[3],C1,0,0,0),   P1[14],P1[15],0.f,0.f,       pw3[2]=PKW(P1,12),pw3[3]=PKW(P1,14), pw3); \
    l_reg+=sacc; \
    if(GK){DMA_K((t)+3,sl_cur);} if(GV){DMA_V((t)+1,sl_next);} \
    CMASK(C0,C1,t); \
    { float a=MX3(C0[0],C0[1],C1[0]),b=MX3(C0[2],C0[3],C1[1]); a=MX3(a,C1[2],C1[3]); \
      _Pragma("unroll") for(int r=4;r<16;r+=4){a=MX3(a,C0[r],C0[r+1]);b=MX3(b,C0[r+2],C0[r+3]);a=MX3(a,C1[r],C1[r+1]);b=MX3(b,C1[r+2],C1[r+3]);} \
      float rm=__builtin_fmaxf(a,b); { auto rr=__builtin_amdgcn_permlane32_swap(__float_as_uint(rm),__float_as_uint(rm),false,false); rm=__builtin_fmaxf(__uint_as_float(rr[0]),__uint_as_float(rr[1])); } \
      resc=false; \
      if(__builtin_expect(__any(rm>(float)THRL),0)){ const float dl=__builtin_fmaxf(rm,0.f); mhat+=dl; \
        _Pragma("unroll") for(int r=0;r<16;++r){C0[r]-=dl;C1[r]-=dl;} \
        const float f=__builtin_amdgcn_exp2f(-dl); l_reg*=f; if(hi==0)wsf[r32]=f; resc=true; } } \
    SBAR(); \
    GAPB(o[0]=__builtin_amdgcn_mfma_f32_32x32x16_bf16(PAF(0),VFR(0),o[0],0,0,0), C0,0); \
    GAPB(o[1]=__builtin_amdgcn_mfma_f32_32x32x16_bf16(PAF(0),VFR(4),o[1],0,0,0), C0,4); \
    KRD(GL,0); GAPB(o[0]=__builtin_amdgcn_mfma_f32_32x32x16_bf16(PAF(1),VFR(1),o[0],0,0,0), C0,8); \
    KRD(GL,1); GAPB(o[1]=__builtin_amdgcn_mfma_f32_32x32x16_bf16(PAF(1),VFR(5),o[1],0,0,0), C0,12); \
    KRD(GL,2); GAPB(o[0]=__builtin_amdgcn_mfma_f32_32x32x16_bf16(PAF(2),VFR(2),o[0],0,0,0), C1,0); \
    KRD(GL,3); GAPB(o[1]=__builtin_amdgcn_mfma_f32_32x32x16_bf16(PAF(2),VFR(6),o[1],0,0,0), C1,4); \
    GAPB(o[0]=__builtin_amdgcn_mfma_f32_32x32x16_bf16(PAF(3),VFR(3),o[0],0,0,0), C1,8); \
    GAPB(o[1]=__builtin_amdgcn_mfma_f32_32x32x16_bf16(PAF(3),VFR(7),o[1],0,0,0), C1,12); \
    }while(0)
  int t=1;
  #undef CMASK
  #define CMASK(P0,P1,t) do{}while(0)
  for(;t+5<NT;t+=2){
    STEP(pB0,pB1,pA0,pA1,t,true,true,true);     WAIT_BAR(2); RESC(); ROT();
    STEP(pA0,pA1,pB0,pB1,t+1,true,true,true);   WAIT_BAR(2); RESC(); ROT();
  }
  #undef CMASK
  #define CMASK(P0,P1,t) do{int jb_=(t)-(NT-4); if(jb_>=0)cmask(P0,P1,jb_,qrel,hi);}while(0)
  #define ENDW(tt) do{ if((tt)+3<NT){WAIT_BAR(2);} else if((tt)+2<NT){WAIT_BAR(1);} else {WAIT_BAR(0);} }while(0)
  for(;t+1<NT;t+=2){
    STEP(pB0,pB1,pA0,pA1,t,(t+3<NT),(t+1<NT),(t+1<NT));       ENDW(t);   RESC(); ROT();
    STEP(pA0,pA1,pB0,pB1,t+1,(t+4<NT),(t+2<NT),(t+2<NT));     ENDW(t+1); RESC(); ROT();
  }
  STEP(pB0,pB1,pA0,pA1,NT-1,false,false,false); RESC();
  { float sacc=pB0[0]+pB0[1]; _Pragma("unroll") for(int r=2;r<16;++r)sacc+=pB0[r]; _Pragma("unroll") for(int r=0;r<16;++r)sacc+=pB1[r]; l_reg+=sacc;
    pw0=(u32x4){PKW(pB0,0),PKW(pB0,2),PKW(pB0,4),PKW(pB0,6)};pw1=(u32x4){PKW(pB0,8),PKW(pB0,10),PKW(pB0,12),PKW(pB0,14)};pw2=(u32x4){PKW(pB1,0),PKW(pB1,2),PKW(pB1,4),PKW(pB1,6)};pw3=(u32x4){PKW(pB1,8),PKW(pB1,10),PKW(pB1,12),PKW(pB1,14)};
    SBAR(); pv(o,vb0+sl_cur,PAF(0),PAF(1),PAF(2),PAF(3)); }
  #undef PKW
  #undef PAF
  #undef VFR
  #undef PIN
  #undef MX3
  #undef GAPA
  #undef GAPB
  #undef EX
  #undef VRD
  #undef KRD
  #undef STEP
  #undef ENDW
  {auto rr=__builtin_amdgcn_permlane32_swap(__float_as_uint(l_reg),__float_as_uint(l_reg),false,false);l_reg=__uint_as_float(rr[0])+__uint_as_float(rr[1]);}
  if(hi==0)wsf[32+r32]=l_reg;asm volatile("s_waitcnt lgkmcnt(0)":::"memory");
  float rli[16];
  #pragma unroll
  for(int r=0;r<16;++r)rli[r]=__builtin_amdgcn_rcpf(wsf[32+crow(r,hi)]);
  bf16*Ow=O+(rowbase+q0+wid*QBLK)*ODM+h*D;
  { float*stg=(float*)(shm+LDS_OST)+wid*2048;
    #pragma unroll
    for(int r=0;r<16;++r){const int orow=crow(r,hi);
      #pragma unroll
      for(int d0=0;d0<2;++d0)stg[orow*64+d0*32+r32]=o[d0][r]*rli[r];}
    asm volatile("s_waitcnt lgkmcnt(0)":::"memory");
    const int ch=lane&7; const f32x4_t g0=*(const f32x4_t*)(GN+h*D+ch*8), g1=*(const f32x4_t*)(GN+h*D+ch*8+4);
    #pragma unroll
    for(int i=0;i<4;++i){const int row=i*8+(lane>>3); f32x4_t a=*(const f32x4_t*)(stg+row*64+ch*8), c=*(const f32x4_t*)(stg+row*64+ch*8+4);
      float ss=(a[0]*a[0]+a[1]*a[1])+(a[2]*a[2]+a[3]*a[3])+(c[0]*c[0]+c[1]*c[1])+(c[2]*c[2]+c[3]*c[3]);
      ss+=__shfl_xor(ss,1); ss+=__shfl_xor(ss,2); ss+=__shfl_xor(ss,4);
      const float rs=1.0f/sqrtf(ss*(1.0f/64.0f)+1e-5f); a=a*rs*g0; c=c*rs*g1;
      u32x4 v; v[0]=cvtpk_s(a[0],a[1]); v[1]=cvtpk_s(a[2],a[3]); v[2]=cvtpk_s(c[0],c[1]); v[3]=cvtpk_s(c[2],c[3]);
      ATTN_STORE16(Ow+(long)row*ODM+ch*8,v);} }
  asm volatile("s_waitcnt lgkmcnt(0)\n\ts_barrier":::"memory");
  #undef DMA_K
  #undef DMA_V
  #undef CMASK
  #undef START
  #undef RESC
  #undef ROT
  #undef CINIT
  #undef qrel
}
constexpr int ATTN_LDS_BYTES=LDS_BYTES;
struct AttnTensors { const bf16* Q; const bf16* K; const bf16* V; bf16* O; const float* KMEAN; const float* GN; };
struct AttnUnit { int bh; int qb; };
struct StaticOrder {
  int vcu;
  __device__ __forceinline__ explicit StaticOrder(int grid,int block):vcu((block%8)*(grid/8)+block/8){}
  __device__ __forceinline__ bool next(int i,AttnUnit&u)const{ if(i>=4)return false; const int s=vcu&3; u.bh=vcu>>2; u.qb=(i==0)?s:(i==1)?7-s:(i==2)?8+s:15-s; return true; }
  __device__ __forceinline__ void a_ready(const AttnUnit&)const{}
  __device__ __forceinline__ void done(const AttnUnit&)const{}
};
template<class Sched,int THRL=8> __device__ __forceinline__ void attn_phase(char*lds,const AttnTensors&T,const Sched&S){
  AttnUnit u;
  if(S.next(0,u)){ const float*kmg=T.KMEAN+(long)u.bh*16*64; unsigned short*imh=(unsigned short*)(lds+LDS_KM),*iml=(unsigned short*)(lds+LDS_KM+4096);
    for(int i=threadIdx.x;i<2048;i+=NW*64){imh[i]=0;iml[i]=0;}
    __syncthreads();
    for(int i=threadIdx.x;i<16*64;i+=NW*64){ const int n=i>>6,d=i&63; const float v=kmg[i]; const unsigned hb=cvtpk_s(v,v)&0xffffu; const float vh=__uint_as_float(hb<<16); const unsigned lb=cvtpk_s(v-vh,v-vh)&0xffffu;
      const int off=(d>>3)*256+n*8+(d&7); imh[off]=(unsigned short)hb; iml[off]=(unsigned short)lb; } }
  __syncthreads();
  for(int i=0;S.next(i,u);++i){ S.a_ready(u); attn_unit<THRL>(u.bh/NHEAD,u.bh%NHEAD,u.qb,T.Q,T.K,T.V,T.O,T.KMEAN,T.GN,lds); S.done(u); }
}
#undef SBAR
#undef WAIT_BAR
}
namespace gla {
typedef short bf16x8 __attribute__((ext_vector_type(8)));
typedef short s16x4 __attribute__((ext_vector_type(4)));
typedef float f32x16 __attribute__((ext_vector_type(16)));
typedef float f32x4 __attribute__((ext_vector_type(4)));
typedef unsigned u32x4 __attribute__((ext_vector_type(4)));
typedef unsigned u32x2 __attribute__((ext_vector_type(2)));
typedef short v4i16_t __attribute__((ext_vector_type(4)));
typedef __attribute__((address_space(3))) unsigned char* lptr;
#define GL_LAS __attribute__((address_space(3)))
constexpr int AREA = 32768, KD_OFF = 0, QD_OFF = 8192, VV_OFF = 16384;
constexpr int TAIL_OFF = 136192;
constexpr int EL_OFF = TAIL_OFF, SSQ_OFF = TAIL_OFF + 1024, DT_OFF = TAIL_OFF + 3072;
__device__ __forceinline__ int crow(int r, int hi) { return (r & 3) + 8 * (r >> 2) + 4 * hi; }
__device__ __forceinline__ s16x4 vtr(lptr p) { return __builtin_bit_cast(s16x4, __builtin_amdgcn_ds_read_tr16_b64_v4i16((GL_LAS v4i16_t*)p)); }
__device__ __forceinline__ bf16x8 cat(s16x4 a, s16x4 b) { return (bf16x8){a[0], a[1], a[2], a[3], b[0], b[1], b[2], b[3]}; }
__device__ __forceinline__ unsigned cvtpk(float lo, float hi) { typedef float f2 __attribute__((ext_vector_type(2))); typedef __bf16 b2 __attribute__((ext_vector_type(2))); f2 v = {lo, hi}; b2 b = __builtin_convertvector(v, b2); return __builtin_bit_cast(unsigned, b); }
__device__ __forceinline__ bf16x8 pack8(const f32x16& x, int s) { u32x4 w; w[0] = cvtpk(x[8 * s + 0], x[8 * s + 1]); w[1] = cvtpk(x[8 * s + 2], x[8 * s + 3]); w[2] = cvtpk(x[8 * s + 4], x[8 * s + 5]); w[3] = cvtpk(x[8 * s + 6], x[8 * s + 7]); return __builtin_bit_cast(bf16x8, w); }
__device__ __forceinline__ float b2f(unsigned short v) { return __uint_as_float(((unsigned)v) << 16); }
#define GL_MFMA(a, b, c) __builtin_amdgcn_mfma_f32_32x32x16_bf16(a, b, c, 0, 0, 0)

struct Tensors { const float* LOGA; const unsigned short *QG, *KG, *VG, *GG; unsigned short* MIX; float* FG; float* BLAST; const float* gng; };

template <bool FULL> __device__ __forceinline__ void group(lptr lds, const Tensors& T, int bh, int g) {
    int tid = threadIdx.x; asm volatile("" : "+v"(tid));
    const int lane = tid & 63, r32 = lane & 31, hi = lane >> 5, wid = __builtin_amdgcn_readfirstlane(tid >> 6), p = wid >> 1, hf = wid & 1;
    const int b = bh >> 2, h = bh & 3;
    const lptr area = lds + p * AREA;
    GL_LAS float* EL = (GL_LAS float*)(lds + EL_OFF) + p * 64;
    f32x16 S[2][2];
#pragma unroll
    for (int i = 0; i < 2; ++i)
#pragma unroll
        for (int j = 0; j < 2; ++j) S[i][j] = f32x16{};
    if (FULL && p == 0) {
        GL_LAS float* DT = (GL_LAS float*)(lds + DT_OFF) + hf * 64;
#pragma unroll 1
        for (int gp = 0; gp < g; ++gp) {
            float s = 0.f;
#pragma unroll
            for (int n = 0; n < 8; ++n) s += T.BLAST[(size_t)(bh * 64 + gp * 8 + n) * 64 + lane];
            const float* fg = T.FG + ((size_t)(bh * 8 + gp) * 2 + hf) * 4096 + lane * 4;
            f32x4 fa[16];
#pragma unroll
            for (int k = 0; k < 16; ++k) fa[k] = *(const f32x4*)(fg + k * 256);
            DT[lane] = __expf(s);
            asm volatile("s_waitcnt lgkmcnt(0)" ::: "memory");
#pragma unroll
            for (int db = 0; db < 2; ++db)
#pragma unroll
                for (int vb = 0; vb < 2; ++vb)
#pragma unroll
                    for (int q = 0; q < 4; ++q) { const f32x4 f = fa[(2 * db + vb) * 4 + q]; const f32x4 d = *(const GL_LAS f32x4*)(DT + 32 * db + 8 * q + 4 * hi);
#pragma unroll
                        for (int i = 0; i < 4; ++i) S[db][vb][4 * q + i] = S[db][vb][4 * q + i] * d[i] + f[i]; }
            asm volatile("s_waitcnt lgkmcnt(0)" ::: "memory");
        }
    }
    const int trb = (4 * hi + ((lane & 15) >> 2)) * 128 + (16 * ((lane >> 4) & 1) + 4 * (lane & 3)) * 2;
    const int rowb = r32 * 128 + 16 * hi;
    const int prmb = r32 * 128 + 8 * hi;
    for (int rd = 0; rd < 2; ++rd) {
        const int n = 8 * g + 4 * rd + p; const size_t T0 = (size_t)b * 4096 + 64 * n;
        u32x4 vq[8];
        { const unsigned short* vp = T.VG + (T0 + (lane >> 3)) * 512 + 128 * h + 64 * hf + 8 * (lane & 7);
#pragma unroll
            for (int i = 0; i < 8; ++i) vq[i] = *(const u32x4*)(vp + (size_t)i * 8 * 512); }
        if (hf == 0 || FULL) {
            const __attribute__((address_space(1))) float* la = (const __attribute__((address_space(1))) float*)(T.LOGA + T0 * 256 + 64 * h + lane); const __attribute__((address_space(1))) unsigned short* kq = (const __attribute__((address_space(1))) unsigned short*)((hf == 0 ? T.KG : T.QG) + T0 * 256 + 64 * h + lane);
            const lptr img = area + (hf == 0 ? KD_OFF : QD_OFF) + lane * 2; float run = 0.f;
            float lvA[16], lvB[16]; unsigned short kvA[16], kvB[16];
#define GL_LOAD(LV, KV, t0) _Pragma("unroll") for (int i = 0; i < 16; ++i) { LV[i] = la[(size_t)((t0) + i) * 256]; KV[i] = kq[(size_t)((t0) + i) * 256]; }
#define GL_PROC(LV, KV, t0) _Pragma("unroll") for (int i = 0; i < 16; ++i) { run += LV[i]; const float e = __expf(hf == 0 ? -run : run); const float v = b2f(KV[i]) * e * (hf == 0 ? 1.0f : 0.125f); \
                *(GL_LAS unsigned short*)(img + ((t0) + i) * 128) = (unsigned short)(cvtpk(v, v) & 0xffffu); } asm volatile("" : "+v"(la), "+v"(kq), "+v"(run));
            GL_LOAD(lvA, kvA, 0) GL_LOAD(lvB, kvB, 16)
            GL_PROC(lvA, kvA, 0) GL_LOAD(lvA, kvA, 32)
            GL_PROC(lvB, kvB, 16) GL_LOAD(lvB, kvB, 48)
            GL_PROC(lvA, kvA, 32) GL_PROC(lvB, kvB, 48)
#undef GL_LOAD
#undef GL_PROC
            if (hf == 0) { EL[lane] = __expf(run); if (!FULL) T.BLAST[(size_t)(bh * 64 + n) * 64 + lane] = run; }
        }
        {
            const lptr vi = area + VV_OFF + hf * 8192 + (lane >> 3) * 128 + (lane & 7) * 16;
#pragma unroll
            for (int i = 0; i < 8; ++i) *(GL_LAS u32x4*)(vi + i * 1024) = vq[i];
        }
        __syncthreads();
        const lptr vv = area + VV_OFF + hf * 8192 + trb;
        f32x16 o[2][2];
        if (FULL) {
            bf16x8 PA[3][2];
#pragma unroll
            for (int c = 0; c < 3; ++c) { const int kb = c >> 1, qb = (c + 1) >> 1; f32x16 X = f32x16{};
#pragma unroll
                for (int s = 0; s < 4; ++s) { const bf16x8 a = *(const GL_LAS bf16x8*)(area + KD_OFF + kb * 4096 + rowb + s * 32), bq = *(const GL_LAS bf16x8*)(area + QD_OFF + qb * 4096 + rowb + s * 32);
                    X = GL_MFMA(a, bq, X); }
                if (kb == qb) {
#pragma unroll
                    for (int r = 0; r < 16; ++r) X[r] = (crow(r, hi) <= r32) ? X[r] : 0.f; }
                PA[c][0] = pack8(X, 0); PA[c][1] = pack8(X, 1); }
#pragma unroll
            for (int i = 0; i < 2; ++i)
#pragma unroll
                for (int j = 0; j < 2; ++j) o[i][j] = f32x16{};
#pragma unroll
            for (int vb = 0; vb < 2; ++vb)
#pragma unroll
                for (int sg = 0; sg < 4; ++sg) { const bf16x8 vf = cat(vtr(vv + vb * 64 + sg * 2048), vtr(vv + vb * 64 + sg * 2048 + 1024));
                    if (sg < 2) { o[0][vb] = GL_MFMA(PA[0][sg], vf, o[0][vb]); o[1][vb] = GL_MFMA(PA[1][sg], vf, o[1][vb]); }
                    else o[1][vb] = GL_MFMA(PA[2][sg - 2], vf, o[1][vb]); }
        }
#pragma unroll 1
        for (int s = 0; s < 4; ++s) {
            if (p == s) {
                if (FULL) {
#pragma unroll
                    for (int sg = 0; sg < 4; ++sg) { const bf16x8 sf0 = pack8(S[sg >> 1][0], sg & 1), sf1 = pack8(S[sg >> 1][1], sg & 1);
#pragma unroll
                        for (int qb = 0; qb < 2; ++qb) { const lptr qa = area + QD_OFF + qb * 4096 + prmb + sg * 32;
                            const bf16x8 af = cat(*(const GL_LAS s16x4*)(qa), *(const GL_LAS s16x4*)(qa + 16));
                            o[qb][0] = GL_MFMA(af, sf0, o[qb][0]); o[qb][1] = GL_MFMA(af, sf1, o[qb][1]); } }
                }
#pragma unroll
                for (int sg = 0; sg < 4; ++sg) { const bf16x8 v0 = cat(vtr(vv + sg * 2048), vtr(vv + sg * 2048 + 1024)), v1 = cat(vtr(vv + 64 + sg * 2048), vtr(vv + 64 + sg * 2048 + 1024));
#pragma unroll
                    for (int db = 0; db < 2; ++db) { const lptr ka = area + KD_OFF + trb + db * 64 + sg * 2048; const bf16x8 kf = cat(vtr(ka), vtr(ka + 1024));
                        S[db][0] = GL_MFMA(kf, v0, S[db][0]); S[db][1] = GL_MFMA(kf, v1, S[db][1]); } }
#pragma unroll
                for (int db = 0; db < 2; ++db)
#pragma unroll
                    for (int q = 0; q < 4; ++q) { const f32x4 e = *(const GL_LAS f32x4*)(EL + 32 * db + 8 * q + 4 * hi);
#pragma unroll
                        for (int i = 0; i < 4; ++i) { S[db][0][4 * q + i] *= e[i]; S[db][1][4 * q + i] *= e[i]; } }
            }
            __syncthreads();
            const bool last = (rd == 1 && s == 3);
            const lptr hand = lds + ((s == 3) ? 0 : s) * AREA;
            if (p == s && !last) {
#pragma unroll
                for (int bi = 0; bi < 4; ++bi)
#pragma unroll
                    for (int q = 0; q < 4; ++q) { const lptr d = hand + ((bi < 2) ? (hf == 0 ? KD_OFF : QD_OFF) : (VV_OFF + hf * 8192)) + ((bi & 1) * 4 + q) * 1024 + lane * 16;
                        *(GL_LAS f32x4*)d = (f32x4){S[bi >> 1][bi & 1][4 * q], S[bi >> 1][bi & 1][4 * q + 1], S[bi >> 1][bi & 1][4 * q + 2], S[bi >> 1][bi & 1][4 * q + 3]}; }
            }
            if (!FULL && last && p == 3) {
                float* fg = T.FG + ((size_t)(bh * 8 + g) * 2 + hf) * 4096;
#pragma unroll
                for (int bi = 0; bi < 4; ++bi)
#pragma unroll
                    for (int q = 0; q < 4; ++q) *(f32x4*)(fg + (bi * 4 + q) * 256 + lane * 4) = (f32x4){S[bi >> 1][bi & 1][4 * q], S[bi >> 1][bi & 1][4 * q + 1], S[bi >> 1][bi & 1][4 * q + 2], S[bi >> 1][bi & 1][4 * q + 3]};
            }
            const bool epi = FULL && ((s >= 1 && p == s - 1) || (s == 3 && p == 3));
            const lptr stg = area + VV_OFF + hf * 8192; GL_LAS float* SSQ = (GL_LAS float*)(lds + SSQ_OFF) + p * 128;
            if (epi) {
#pragma unroll
                for (int qb = 0; qb < 2; ++qb)
#pragma unroll
                    for (int vb = 0; vb < 2; ++vb)
#pragma unroll
                        for (int r = 0; r < 16; ++r) *(GL_LAS unsigned short*)(stg + (32 * qb + crow(r, hi)) * 128 + (32 * vb + r32) * 2) = (unsigned short)(cvtpk(o[qb][vb][r], o[qb][vb][r]) & 0xffffu);
                asm volatile("s_waitcnt lgkmcnt(0)" ::: "memory");
#pragma unroll
                for (int i = 0; i < 8; ++i) { const int t = i * 8 + (lane >> 3); const bf16x8 w = *(const GL_LAS bf16x8*)(stg + t * 128 + (lane & 7) * 16); float ss = 0.f;
#pragma unroll
                    for (int j = 0; j < 8; ++j) { const float x = b2f((unsigned short)w[j]); ss += x * x; }
                    ss += __shfl_xor(ss, 1); ss += __shfl_xor(ss, 2); ss += __shfl_xor(ss, 4);
                    if ((lane & 7) == 0) SSQ[hf * 64 + t] = ss; }
            }
            __syncthreads();
            if (!last && p == ((s + 1) & 3) && (s < 3 || rd == 0)) {
#pragma unroll
                for (int bi = 0; bi < 4; ++bi)
#pragma unroll
                    for (int q = 0; q < 4; ++q) { const lptr d = hand + ((bi < 2) ? (hf == 0 ? KD_OFF : QD_OFF) : (VV_OFF + hf * 8192)) + ((bi & 1) * 4 + q) * 1024 + lane * 16; const f32x4 x = *(const GL_LAS f32x4*)d;
#pragma unroll
                        for (int i = 0; i < 4; ++i) S[bi >> 1][bi & 1][4 * q + i] = x[i]; }
            }
            if (epi) {
                const size_t Te = (size_t)b * 4096 + 64 * n; float gn[8];
#pragma unroll
                for (int j = 0; j < 8; ++j) gn[j] = T.gng[128 * h + 64 * hf + 8 * (lane & 7) + j];
#pragma unroll
                for (int i = 0; i < 8; ++i) { const int t = i * 8 + (lane >> 3); const float tot = SSQ[t] + SSQ[64 + t]; const float rs = 1.0f / sqrtf(tot * (1.0f / 128.0f) + 1e-5f);
                    const bf16x8 w = *(const GL_LAS bf16x8*)(stg + t * 128 + (lane & 7) * 16); const bf16x8 gg = *(const bf16x8*)(T.GG + (Te + t) * 512 + 128 * h + 64 * hf + 8 * (lane & 7)); float r[8];
#pragma unroll
                    for (int j = 0; j < 8; ++j) { const float gv = b2f((unsigned short)gg[j]); r[j] = b2f((unsigned short)w[j]) * rs * gn[j] * (gv / (1.0f + __expf(-gv))); }
                    u32x4 ov; ov[0] = cvtpk(r[0], r[1]); ov[1] = cvtpk(r[2], r[3]); ov[2] = cvtpk(r[4], r[5]); ov[3] = cvtpk(r[6], r[7]);
                    *(u32x4*)(T.MIX + (Te + t) * 1024 + 512 + 128 * h + 64 * hf + 8 * (lane & 7)) = ov; }
            }
        }
        __syncthreads();
    }
}
#undef GL_MFMA
#undef GL_LAS
}
#define GAS __attribute__((address_space(1)))
#define LAS __attribute__((address_space(3)))
typedef unsigned short bf16;
typedef unsigned v4u __attribute__((ext_vector_type(4)));
typedef float f32x4 __attribute__((ext_vector_type(4)));
typedef short bf16x8 __attribute__((ext_vector_type(8)));
typedef GAS unsigned gu32;
typedef GAS unsigned long long gu64;
#define RLX_AGENT __ATOMIC_RELAXED, __HIP_MEMORY_SCOPE_AGENT
#define LDS_WAIT() asm volatile("s_waitcnt lgkmcnt(0)" ::: "memory")
#define VM_WAIT() asm volatile("s_waitcnt vmcnt(0)" ::: "memory")
__device__ __forceinline__ unsigned long long rt() { return __builtin_amdgcn_s_memrealtime(); }
__device__ __forceinline__ unsigned f2bf(float f) { unsigned u = __builtin_bit_cast(unsigned, f); return (u + 0x7fffu + ((u >> 16) & 1u)) >> 16; }
__device__ __forceinline__ unsigned pk2(float lo, float hi) { return f2bf(lo) | (f2bf(hi) << 16); }

#define XB_TMO      128
#define XB_XCNT(j)  (256  + 64 * (j))
#define XB_XSUB(j)  (1280 + 64 * (j))
#define XB_XGEN(j)  (2304 + 64 * (j))
#define XB_TOP      3328
#define XB_TOPGEN   3392
#define XCD_BAR_WORDS 3456
#define XB_SPIN_CAP (1u << 18)

__device__ __forceinline__ unsigned xb_ld(unsigned* p)              { return __hip_atomic_load(p, __ATOMIC_RELAXED, __HIP_MEMORY_SCOPE_AGENT); }
__device__ __forceinline__ unsigned xb_add(unsigned* p, unsigned v) { return __hip_atomic_fetch_add(p, v, __ATOMIC_RELAXED, __HIP_MEMORY_SCOPE_AGENT); }
__device__ __forceinline__ unsigned xb_xcc_id() { return (unsigned)__builtin_amdgcn_s_getreg((3 << 11) | 20) & 0xFu; }
#define XB_SPIN(cond, bar) do { unsigned _sp = 0; while (cond) { __builtin_amdgcn_s_sleep(1); \
    if ((++_sp & 255u) == 0u) { if (xb_ld(&(bar)[XB_TMO])) break; if (_sp > XB_SPIN_CAP) { atomicAdd(&(bar)[XB_TMO], 1u); break; } } } } while (0)

struct XcdBarrier {
    unsigned* bar; unsigned x;
    volatile LAS unsigned* st;
};

__device__ __forceinline__ XcdBarrier xcd_barrier_post(unsigned* bar, volatile LAS unsigned* st) {
    XcdBarrier b; b.bar = bar; b.x = xb_xcc_id(); b.st = st;
    if (threadIdx.x == 0) (void)xb_add(&bar[XB_XCNT(b.x)], 1u);
    return b;
}
__device__ __forceinline__ void xcd_barrier_complete(unsigned* bar, unsigned x, unsigned& nloc, unsigned& nx) {
    const unsigned G = gridDim.x * gridDim.y * gridDim.z;
    unsigned sum, cnt, mine, sp = 0u;
    for (;;) {
        sum = 0u; cnt = 0u; mine = 0u;
#pragma unroll
        for (unsigned j = 0; j < 16; ++j) { const unsigned c = xb_ld(&bar[XB_XCNT(j)]); sum += c; cnt += (c > 0u) ? 1u : 0u; mine = (j == x) ? c : mine; }
        if (sum == G) break;
        __builtin_amdgcn_s_sleep(1);
        if ((++sp & 255u) == 0u) { if (xb_ld(&bar[XB_TMO])) break; if (sp > XB_SPIN_CAP) { atomicAdd(&bar[XB_TMO], 1u); break; } }
    }
    nloc = mine > 0u ? mine : 1u; nx = cnt > 0u ? cnt : 1u;
}

__device__ __forceinline__ void xcd_barrier(const XcdBarrier& b) {
    asm volatile("s_waitcnt vmcnt(0)" ::: "memory");
    __syncthreads();
    if (threadIdx.x == 0) {
        unsigned* bar = b.bar;
        __builtin_amdgcn_s_waitcnt(0);
        unsigned nloc = b.st[0], nx = b.st[1];
        if (nloc == 0u) { xcd_barrier_complete(bar, b.x, nloc, nx); b.st[0] = nloc; b.st[1] = nx; }
        const unsigned old = xb_add(&bar[XB_XSUB(b.x)], 1u);
        const unsigned gen = old / nloc;
        if (old + 1u == (gen + 1u) * nloc) {
            __builtin_amdgcn_fence(__ATOMIC_RELEASE, "agent");
            asm volatile("s_waitcnt vmcnt(0)" ::: "memory");
            const unsigned og = xb_add(&bar[XB_TOP], 1u);
            const unsigned tg = og / nx;
            if (og + 1u == (tg + 1u) * nx) xb_add(&bar[XB_TOPGEN], 1u);
            else XB_SPIN(xb_ld(&bar[XB_TOPGEN]) == tg, bar);
            __builtin_amdgcn_fence(__ATOMIC_ACQUIRE, "agent");
            xb_add(&bar[XB_XGEN(b.x)], 1u);
            asm volatile("s_waitcnt vmcnt(0)" ::: "memory");
        } else {
            XB_SPIN(xb_ld(&bar[XB_XGEN(b.x)]) == gen, bar);
            __builtin_amdgcn_fence(__ATOMIC_ACQUIRE, "agent");
            asm volatile("s_waitcnt vmcnt(0)" ::: "memory");
        }
    }
    __syncthreads();
}

constexpr int NWAVES = 8;
#ifndef MK_N_LAUNCHES
#define MK_N_LAUNCHES 1
#endif
constexpr int N_PHASES = 11;
constexpr int N_LAUNCHES = MK_N_LAUNCHES;
static_assert(N_LAUNCHES == 1 || N_LAUNCHES == N_PHASES, "MK_N_LAUNCHES is 1 or 11");

constexpr int BATCH = 8, SEQ = 4096, D = 1024, M = BATCH * SEQ;
constexpr int AW = 512, GKW = 256, GVW = 512, FF = 2816, INW = 3088;
constexpr int NIN = 3328;
constexpr int NGH = 4, GDK = 64, GDV = 128, GCH = 64, NCH = SEQ / GCH;
constexpr float LN_EPS = 1e-5f, ALPHA = 1.189207115002721f;

constexpr size_t MiB = 1u << 20;
constexpr size_t WS_CTL = 0, CTL_ZERO_BYTES = 1 * MiB;
constexpr size_t WS_MODP = 1 * MiB;
constexpr size_t WS_MOD = 4 * MiB;
constexpr size_t WS_KMEAN = 4 * MiB + 256 * 1024;
constexpr size_t WS_DEC = 4 * MiB + 512 * 1024;
constexpr size_t WS_HALO = 5 * MiB, WS_FIXS = 8 * MiB, WS_FIXV = 11 * MiB;
constexpr size_t WS_WIN = 14 * MiB, WS_WO = 21 * MiB, WS_WUP = 23 * MiB, WS_WDN = 34 * MiB;
constexpr size_t WS_XN = 40 * MiB;
constexpr size_t WS_QA = 104 * MiB, WS_KA = 136 * MiB, WS_VA = 168 * MiB, WS_QG = 200 * MiB, WS_KG = 216 * MiB, WS_VG = 232 * MiB, WS_GG = 264 * MiB, WS_LOGA = 296 * MiB;
constexpr size_t WS_KV = 328 * MiB;
constexpr size_t WS_MIX = 392 * MiB;
constexpr size_t WS_Y1 = 104 * MiB;
constexpr size_t WS_X1 = 328 * MiB;
constexpr size_t WS_ACT = 104 * MiB;
constexpr size_t WS_Y2 = 40 * MiB;
constexpr size_t WS_END = 456 * MiB;
static_assert(WS_X1 + (size_t)M * D * 2 <= WS_MIX && WS_ACT + (size_t)M * FF * 2 <= WS_X1 && WS_MIX + (size_t)M * D * 2 <= WS_END && WS_LOGA + (size_t)M * 256 * 4 <= WS_KV && WS_WDN + (size_t)D * FF * 2 <= WS_XN, "d_ws map");
constexpr int CW_TMO = 0, CW_CODE = 1;
constexpr int CW_BAR = 4096;

constexpr int RING_OFF = 0, RING_BYTES = 131072;
constexpr int LDSCTL_OFF = RING_BYTES, MISC_OFF = LDSCTL_OFF + 320;
constexpr int HTAB_OFF = 132096;
constexpr int LDS_BYTES = 147456;
static_assert(MISC_OFF + 128 <= HTAB_OFF && HTAB_OFF + 4096 <= LDS_BYTES && attn_body::ATTN_LDS_BYTES <= RING_BYTES, "LDS map");

#define CAS __attribute__((address_space(4)))
struct Args { const float* in[19]; float* out; unsigned char* ws; int ph_lo, ph_hi, li, pad; };
struct Frame {
    LAS unsigned char* lds;
    volatile LAS unsigned* MISC;
    gu32* ctl;
    int tid, lane, wave;
    int vcu, G;
    unsigned char* ws;
    const CAS Args* argp;
};
#define ARG_IN(F, k) ({ const CAS Args* p_ = (F).argp; asm volatile("" : "+s"(p_)); p_->in[k]; })
#define ARG_OUT(F) ({ const CAS Args* p_ = (F).argp; asm volatile("" : "+s"(p_)); p_->out; })
enum { I_X = 0, I_C, I_WADA, I_BADA, I_WIN, I_WGATE, I_BGATE, I_ATTNG, I_GLAG, I_WO, I_LN1G, I_LN1B, I_WUP, I_BUP, I_CONVW, I_CONVB, I_WDOWN, I_LN2G, I_LN2B };
__device__ __forceinline__ float bf2f(unsigned short v) { return __uint_as_float(((unsigned)v) << 16); }
__device__ __forceinline__ float wave_sum(float v) {
#pragma unroll
    for (int o = 1; o < 64; o <<= 1) v += __shfl_xor(v, o);
    return v;
}
__device__ __forceinline__ float silu_f(float v) { return v / (1.0f + __expf(-v)); }

__device__ __forceinline__ void p0_transpose_item(const float* W, int pitch, int k0, int n0, bf16* WT, int Kd, int drow0, LAS float* scr, int lane) {
#pragma unroll 8
    for (int i = 0; i < 32; ++i) { const int kk = 2 * i + (lane >> 5); scr[kk * 33 + (lane & 31)] = W[(size_t)(k0 + kk) * pitch + n0 + (lane & 31)]; }
    LDS_WAIT(); asm volatile("" ::: "memory");
    const int c = lane & 7;
#pragma unroll
    for (int j = 0; j < 4; ++j) { const int n = (lane >> 3) + 8 * j; const LAS float* s = scr + (8 * c) * 33 + n;
        v4u o; o.x = pk2(s[0 * 33], s[1 * 33]); o.y = pk2(s[2 * 33], s[3 * 33]); o.z = pk2(s[4 * 33], s[5 * 33]); o.w = pk2(s[6 * 33], s[7 * 33]);
        *(GAS v4u*)(WT + (size_t)(drow0 + n) * Kd + k0 + 8 * c) = o; }
    LDS_WAIT(); asm volatile("" ::: "memory");
}
__device__ __forceinline__ void p0a_prologue(Frame& F) {
    LAS float* scr = (LAS float*)(F.lds + RING_OFF + F.wave * 16384);
    const int gw = F.vcu * NWAVES + F.wave, NGW = F.G * NWAVES, lane = F.lane;
    bf16* Win_t = (bf16*)(F.ws + WS_WIN); bf16* Wo_t = (bf16*)(F.ws + WS_WO); bf16* Wup_t = (bf16*)(F.ws + WS_WUP); bf16* Wdn_t = (bf16*)(F.ws + WS_WDN);
    float* MODP = (float*)(F.ws + WS_MODP);
    const float* c_in = ARG_IN(F, I_C); const float* w_ada = ARG_IN(F, I_WADA); const float* w_in = ARG_IN(F, I_WIN); const float* w_gate = ARG_IN(F, I_WGATE);
    const float* w_o = ARG_IN(F, I_WO); const float* w_up = ARG_IN(F, I_WUP); const float* w_down = ARG_IN(F, I_WDOWN);
    constexpr int I_MOD = 96 * 16, I_IN = 16 * 96, I_O = 16 * 32, I_UP = 16 * 176, I_DN = 44 * 32, I_CB = 16 * 32;
    constexpr int NITEMS = I_MOD + I_IN + I_O + I_UP + I_DN + I_CB;
    for (int it = gw; it < NITEMS; it += NGW) {
        int r = it;
        if (r < I_MOD) {
            const int cg = r % 96, ks = r / 96;
            float sv[8], acc[8];
#pragma unroll
            for (int b = 0; b < 8; ++b) { sv[b] = silu_f(c_in[b * 1024 + 64 * ks + lane]); acc[b] = 0.f; }
            const float* wp = w_ada + (size_t)(64 * ks) * 6144 + 64 * cg + lane;
#pragma unroll 4
            for (int kk = 0; kk < 64; ++kk) { const float w = wp[(size_t)kk * 6144];
#pragma unroll
                for (int b = 0; b < 8; ++b) acc[b] += __int_as_float(__builtin_amdgcn_readlane(__float_as_int(sv[b]), kk)) * w; }
#pragma unroll
            for (int b = 0; b < 8; ++b) MODP[(size_t)(ks * 8 + b) * 6144 + 64 * cg + lane] = acc[b];
            continue; }
        r -= I_MOD;
        if (r < I_IN) { const int kb = r / 96, nb = r % 96; p0_transpose_item(w_in, INW, 64 * kb, 32 * nb, Win_t, D, 32 * nb, scr, lane); continue; } r -= I_IN;
        if (r < I_O) { const int kb = r / 32, nb = r % 32; p0_transpose_item(w_o, D, 64 * kb, 32 * nb, Wo_t, D, 32 * nb, scr, lane); continue; } r -= I_O;
        if (r < I_UP) { const int kb = r / 176, nb = r % 176; const int cc = 32 * nb; const int dr = (cc < FF) ? (256 * (cc / 128) + (cc % 128)) : (256 * ((cc - FF) / 128) + 128 + ((cc - FF) % 128));
            p0_transpose_item(w_up, 2 * FF, 64 * kb, cc, Wup_t, D, dr, scr, lane); continue; } r -= I_UP;
        if (r < I_DN) { const int kb = r / 32, nb = r % 32; p0_transpose_item(w_down, D, 64 * kb, 32 * nb, Wdn_t, FF, 32 * nb, scr, lane); continue; } r -= I_DN;
        {
            const int kb = r / 32, nb = r % 32, k0 = 64 * kb, n = 8 * nb + (lane >> 3), c = lane & 7;
            float g[16], o[8];
#pragma unroll
            for (int rr = 0; rr < 16; ++rr) g[rr] = w_gate[rr * 256 + n];
#pragma unroll
            for (int i = 0; i < 8; ++i) { const float* wr_ = w_in + (size_t)(k0 + 8 * c + i) * INW + 3072;
                const f32x4 a0 = *(const f32x4*)(wr_), a1 = *(const f32x4*)(wr_ + 4), a2 = *(const f32x4*)(wr_ + 8), a3 = *(const f32x4*)(wr_ + 12);
                float s = 0.f;
#pragma unroll
                for (int q = 0; q < 4; ++q) { s += a0[q] * g[q]; s += a1[q] * g[4 + q]; s += a2[q] * g[8 + q]; s += a3[q] * g[12 + q]; }
                o[i] = s; }
            v4u w; w.x = pk2(o[0], o[1]); w.y = pk2(o[2], o[3]); w.z = pk2(o[4], o[5]); w.w = pk2(o[6], o[7]);
            *(GAS v4u*)(Win_t + (size_t)(3072 + n) * D + k0 + 8 * c) = w;
        }
    }
}
__device__ __forceinline__ void ln16(f32x4 (&v)[4]) {
    float s = 0.f;
#pragma unroll
    for (int j = 0; j < 4; ++j) s += (v[j].x + v[j].y) + (v[j].z + v[j].w);
    const float mean = wave_sum(s) * (1.f / D); float s2 = 0.f;
#pragma unroll
    for (int j = 0; j < 4; ++j) { v[j] = v[j] - mean; s2 += (v[j].x * v[j].x + v[j].y * v[j].y) + (v[j].z * v[j].z + v[j].w * v[j].w); }
    const float rstd = 1.f / sqrtf(wave_sum(s2) * (1.f / D) + LN_EPS);
#pragma unroll
    for (int j = 0; j < 4; ++j) v[j] = v[j] * rstd;
}
__device__ __forceinline__ void p0b_adaln1(Frame& F) {
    const int b = F.vcu >> 5, tid = F.tid, lane = F.lane;
    const float* MODP = (const float*)(F.ws + WS_MODP); float* MOD = (float*)(F.ws + WS_MOD);
    LAS float* sv = (LAS float*)(F.lds + RING_OFF);
    const bool writer = (F.vcu & 31) == 0; const float* b_ada = ARG_IN(F, I_BADA); const float* x = ARG_IN(F, I_X);
    for (int j = tid; j < (writer ? 6144 : 2048); j += NWAVES * 64) { float v = b_ada[j];
#pragma unroll
        for (int ks = 0; ks < 16; ++ks) v += MODP[(size_t)(ks * 8 + b) * 6144 + j];
        if (j < 2048) sv[j] = (j >= 1024) ? 1.0f + v : v;
        if (writer) MOD[b * 6144 + j] = v; }
    __syncthreads();
    f32x4 shf[4], scl[4];
#pragma unroll
    for (int j = 0; j < 4; ++j) { shf[j] = *(const LAS f32x4*)(sv + 4 * lane + 256 * j); scl[j] = *(const LAS f32x4*)(sv + 1024 + 4 * lane + 256 * j); }
    bf16* XN = (bf16*)(F.ws + WS_XN);
    for (int r0 = 0; r0 < 16; r0 += 4) { const size_t row0 = (size_t)F.vcu * 128 + F.wave * 16 + r0; f32x4 v[4][4];
#pragma unroll
        for (int q = 0; q < 4; ++q) { const GAS f32x4* xr = (const GAS f32x4*)(x + (row0 + q) * D) + lane;
#pragma unroll
            for (int j = 0; j < 4; ++j) v[q][j] = xr[64 * j]; }
#pragma unroll
        for (int q = 0; q < 4; ++q) { ln16(v[q]);
            GAS unsigned long long* o8 = (GAS unsigned long long*)(XN + (row0 + q) * D) + lane;
#pragma unroll
            for (int j = 0; j < 4; ++j) { const f32x4 u = v[q][j] * scl[j] + shf[j]; o8[64 * j] = (unsigned long long)pk2(u.x, u.y) | ((unsigned long long)pk2(u.z, u.w) << 32); } } }
    __syncthreads();
}
__device__ __forceinline__ void p3_kmean(Frame& F) {
    const int gw = F.vcu * NWAVES + F.wave, NGW = F.G * NWAVES, lane = F.lane;
    const bf16* KA = (const bf16*)(F.ws + WS_KA); float* KMEAN = (float*)(F.ws + WS_KMEAN);
    for (int it = gw; it < BATCH * 16 * 8; it += NGW) {
        const int h = it & 7, blk = (it >> 3) & 15, b = it >> 7, c = lane & 7, rg = lane >> 3;
        const bf16* p = KA + ((size_t)b * SEQ + blk * 256 + rg) * AW + 64 * h + 8 * c; float a[8];
#pragma unroll
        for (int j = 0; j < 8; ++j) a[j] = 0.f;
#pragma unroll 8
        for (int i = 0; i < 32; ++i) { const bf16x8 q = *(const bf16x8*)(p + (size_t)(8 * i) * AW);
#pragma unroll
            for (int j = 0; j < 8; ++j) a[j] += bf2f(q[j]); }
#pragma unroll
        for (int j = 0; j < 8; ++j) { a[j] += __shfl_xor(a[j], 8); a[j] += __shfl_xor(a[j], 16); a[j] += __shfl_xor(a[j], 32); }
        if (lane < 8) { float* o = KMEAN + ((size_t)(b * 8 + h) * 16 + blk) * 64 + 8 * c;
            *(f32x4*)o = (f32x4){a[0], a[1], a[2], a[3]} * (1.f / 256.f); *(f32x4*)(o + 4) = (f32x4){a[4], a[5], a[6], a[7]} * (1.f / 256.f); }
    }
}
__device__ __forceinline__ gla::Tensors gla_tensors(Frame& F) {
    gla::Tensors T; T.LOGA = (const float*)(F.ws + WS_LOGA); T.QG = (const bf16*)(F.ws + WS_QG); T.KG = (const bf16*)(F.ws + WS_KG); T.VG = (const bf16*)(F.ws + WS_VG); T.GG = (const bf16*)(F.ws + WS_GG);
    T.MIX = (bf16*)(F.ws + WS_MIX); T.FG = (float*)(F.ws + WS_KV); T.BLAST = (float*)(F.ws + WS_DEC); T.gng = ARG_IN(F, I_GLAG); return T;
}
__device__ __forceinline__ void p4b_ln1_adaln2(Frame& F) {
    const int b = F.vcu >> 5, lane = F.lane; const float* MOD = (const float*)(F.ws + WS_MOD) + b * 6144;
    f32x4 g1[4], lg[4], lb[4], scl[4], shf[4]; const float* ln1_g = ARG_IN(F, I_LN1G); const float* ln1_b = ARG_IN(F, I_LN1B); const float* x = ARG_IN(F, I_X);
#pragma unroll
    for (int j = 0; j < 4; ++j) { const int c = 4 * lane + 256 * j; g1[j] = *(const f32x4*)(MOD + 2048 + c); lg[j] = *(const f32x4*)(ln1_g + c); lb[j] = *(const f32x4*)(ln1_b + c);
        shf[j] = *(const f32x4*)(MOD + 3072 + c); scl[j] = *(const f32x4*)(MOD + 4096 + c) + 1.0f; }
    const bf16* Y1 = (const bf16*)(F.ws + WS_Y1); bf16* X1 = (bf16*)(F.ws + WS_X1); bf16* XN = (bf16*)(F.ws + WS_XN);
    for (int r0 = 0; r0 < 16; r0 += 4) { const size_t row0 = (size_t)F.vcu * 128 + F.wave * 16 + r0; f32x4 xv[4][4]; unsigned long long yv[4][4];
#pragma unroll
        for (int q = 0; q < 4; ++q) { const GAS f32x4* xr = (const GAS f32x4*)(x + (row0 + q) * D) + lane; const GAS unsigned long long* yr = (const GAS unsigned long long*)(Y1 + (row0 + q) * D) + lane;
#pragma unroll
            for (int j = 0; j < 4; ++j) { xv[q][j] = xr[64 * j]; yv[q][j] = yr[64 * j]; } }
#pragma unroll
        for (int q = 0; q < 4; ++q) { f32x4 v[4];
#pragma unroll
            for (int j = 0; j < 4; ++j) { const unsigned long long yw = yv[q][j]; const f32x4 y = (f32x4){bf2f((unsigned short)yw), bf2f((unsigned short)(yw >> 16)), bf2f((unsigned short)(yw >> 32)), bf2f((unsigned short)(yw >> 48))};
                v[j] = xv[q][j] * ALPHA + g1[j] * y; }
            ln16(v);
            GAS unsigned long long* x1r = (GAS unsigned long long*)(X1 + (row0 + q) * D) + lane;
#pragma unroll
            for (int j = 0; j < 4; ++j) { v[j] = v[j] * lg[j] + lb[j]; x1r[64 * j] = (unsigned long long)pk2(v[j].x, v[j].y) | ((unsigned long long)pk2(v[j].z, v[j].w) << 32); }
            ln16(v);
            GAS unsigned long long* o8 = (GAS unsigned long long*)(XN + (row0 + q) * D) + lane;
#pragma unroll
            for (int j = 0; j < 4; ++j) { const f32x4 u = v[j] * scl[j] + shf[j]; o8[64 * j] = (unsigned long long)pk2(u.x, u.y) | ((unsigned long long)pk2(u.z, u.w) << 32); } } }
}
__device__ __forceinline__ void p5b_fixup(Frame& F) {
    const float* HALO = (const float*)(F.ws + WS_HALO); const float* FIXS = (const float*)(F.ws + WS_FIXS); const float* FIXV = (const float*)(F.ws + WS_FIXV); bf16* ACT = (bf16*)(F.ws + WS_ACT);
    const int nthr = F.G * NWAVES * 64; const float* conv_w = ARG_IN(F, I_CONVW);
    for (int e = F.vcu * NWAVES * 64 + F.tid; e < 128 * 2 * FF; e += nthr) {
        const int ch = e % FF, rr = (e / FF) & 1, pm = e / (2 * FF);
        if ((pm & 15) == 0) continue;
        const float h14 = HALO[((size_t)(pm - 1) * 2 + 0) * FF + ch], h15 = HALO[((size_t)(pm - 1) * 2 + 1) * FF + ch];
        const float w0 = conv_w[ch], w1 = conv_w[FF + ch];
        const float extra = rr == 0 ? (w0 * h14 + w1 * h15) : (w0 * h15);
        const float cv = FIXS[((size_t)pm * 2 + rr) * FF + ch] + extra;
        ACT[((size_t)pm * 256 + rr) * FF + ch] = (bf16)f2bf(pg8::gelu1(cv) * FIXV[((size_t)pm * 2 + rr) * FF + ch]);
    }
}
__device__ __forceinline__ void p6b_ln2(Frame& F) {
    const int b = F.vcu >> 5, lane = F.lane; const float* MOD = (const float*)(F.ws + WS_MOD) + b * 6144;
    f32x4 g2[4], lg[4], lb[4]; const float* ln2_g = ARG_IN(F, I_LN2G); const float* ln2_b = ARG_IN(F, I_LN2B); float* outp = ARG_OUT(F);
#pragma unroll
    for (int j = 0; j < 4; ++j) { const int c = 4 * lane + 256 * j; g2[j] = *(const f32x4*)(MOD + 5120 + c); lg[j] = *(const f32x4*)(ln2_g + c); lb[j] = *(const f32x4*)(ln2_b + c); }
    const bf16* Y2 = (const bf16*)(F.ws + WS_Y2); const bf16* X1 = (const bf16*)(F.ws + WS_X1);
    for (int r0 = 0; r0 < 16; r0 += 4) { const size_t row0 = (size_t)F.vcu * 128 + F.wave * 16 + r0; unsigned long long xv[4][4], yv[4][4];
#pragma unroll
        for (int q = 0; q < 4; ++q) { const GAS unsigned long long* xr = (const GAS unsigned long long*)(X1 + (row0 + q) * D) + lane; const GAS unsigned long long* yr = (const GAS unsigned long long*)(Y2 + (row0 + q) * D) + lane;
#pragma unroll
            for (int j = 0; j < 4; ++j) { xv[q][j] = xr[64 * j]; yv[q][j] = yr[64 * j]; } }
#pragma unroll
      for (int q = 0; q < 4; ++q) { const size_t row = row0 + q; f32x4 v[4];
#pragma unroll
        for (int j = 0; j < 4; ++j) { const unsigned long long yw = yv[q][j]; const f32x4 y = (f32x4){bf2f((unsigned short)yw), bf2f((unsigned short)(yw >> 16)), bf2f((unsigned short)(yw >> 32)), bf2f((unsigned short)(yw >> 48))};
            const unsigned long long xw = xv[q][j]; const f32x4 x1 = (f32x4){bf2f((unsigned short)xw), bf2f((unsigned short)(xw >> 16)), bf2f((unsigned short)(xw >> 32)), bf2f((unsigned short)(xw >> 48))};
            v[j] = x1 * ALPHA + g2[j] * y; }
        ln16(v);
        GAS f32x4* orow = (GAS f32x4*)(outp + row * D) + lane;
#if defined(MK_PROBE_A)
        if (F.vcu == 0) { const unsigned long long ta0 = __hip_atomic_load((gu64*)(F.ctl + 64) + MK_PROBE_A, RLX_AGENT), ta1 = __hip_atomic_load((gu64*)(F.ctl + 64) + MK_PROBE_A + 1, RLX_AGENT);
            const unsigned long long tb0 = __hip_atomic_load((gu64*)(F.ctl + 64) + MK_PROBE_B, RLX_AGENT), tb1 = __hip_atomic_load((gu64*)(F.ctl + 64) + MK_PROBE_B + 1, RLX_AGENT);
            const float ua = (float)(ta1 - ta0) * 0.01f, ub = (float)(tb1 - tb0) * 0.0001f;
#pragma unroll
            for (int j = 0; j < 4; ++j) { f32x4 o = v[j] * lg[j] + lb[j] + ub; if (row == 0 && lane == 0 && j == 0) o.x += ua; orow[64 * j] = o; }
        } else
#endif
#pragma unroll
        for (int j = 0; j < 4; ++j) orow[64 * j] = v[j] * lg[j] + lb[j]; } }
}

__global__ void __launch_bounds__(NWAVES * 64, 2) mk_fwd(Args args) {
    extern __shared__ __attribute__((aligned(16))) unsigned char lds[];
    Frame F;
    F.lds = (LAS unsigned char*)lds;
    F.MISC = (volatile LAS unsigned*)(F.lds + MISC_OFF);
    F.tid = threadIdx.x; F.lane = F.tid & 63; F.wave = __builtin_amdgcn_readfirstlane(F.tid >> 6);
    F.G = gridDim.x; { const int bx = blockIdx.x; F.vcu = (F.G % 8 == 0) ? (bx % 8) * (F.G / 8) + bx / 8 : bx; }
    F.ws = args.ws; F.ctl = (gu32*)(args.ws + WS_CTL); F.argp = (const CAS Args*)__builtin_amdgcn_kernarg_segment_ptr();
    for (int u = F.tid; u < (LDS_BYTES - LDSCTL_OFF) / 4; u += NWAVES * 64) ((LAS unsigned*)(F.lds + LDSCTL_OFF))[u] = 0u;
    __syncthreads();
    XcdBarrier bar; bar.bar = (unsigned*)(F.ctl + CW_BAR); bar.x = 0; bar.st = nullptr;
    if (N_LAUNCHES == 1) bar = xcd_barrier_post((unsigned*)(F.ctl + CW_BAR), F.MISC + 8);
#if defined(MK_PROBE_A)
#define PROBE_STAMP(k) do { if (blockIdx.x == 0 && F.tid == 0) __hip_atomic_store((gu64*)(F.ctl + 64) + (k), (unsigned long long)__builtin_amdgcn_s_memrealtime(), RLX_AGENT); } while (0)
#else
#define PROBE_STAMP(k) do { } while (0)
#endif
#define GRID_BAR(seam) do { if (N_LAUNCHES != 1) { if (F.tid == 0) __hip_atomic_store(F.ctl + CW_TMO, 0xBADBA0u | (unsigned)(seam), RLX_AGENT); } else { xcd_barrier(bar); } PROBE_STAMP((seam) + 1); } while (0)
    const int lo = args.ph_lo, hi = args.ph_hi;
    PROBE_STAMP(0);
#ifndef MK_PHASE_MASK
#define MK_PHASE_MASK 0x7ff
#endif
#define IN(k) (((MK_PHASE_MASK >> (k)) & 1) && lo <= (k) && (k) < hi)
#define BOTH(k) (IN(k) && IN((k) + 1))
    bf16* XN = (bf16*)(F.ws + WS_XN);
    if (IN(0)) { p0a_prologue(F); if (BOTH(0)) GRID_BAR(0); }
    if (IN(1)) { p0b_adaln1(F); if (BOTH(1)) GRID_BAR(1); }
    if (IN(2)) {
        pg8::Gemm g{XN, (const bf16*)(F.ws + WS_WIN), M, NIN, D}; pg8::StaticOrder S; S.init(M, NIN, F.G, (int)blockIdx.x);
        pg8::EpiInProj E{(bf16*)(F.ws + WS_QA), (bf16*)(F.ws + WS_KA), (bf16*)(F.ws + WS_VA), (bf16*)(F.ws + WS_QG), (bf16*)(F.ws + WS_KG), (bf16*)(F.ws + WS_VG), (bf16*)(F.ws + WS_GG), (float*)(F.ws + WS_LOGA), ARG_IN(F, I_BGATE), attn_body::C2};
        pg8::gemm_phase<pg8::EpiInProj, pg8::StaticOrder, PG8_ALIGN, PG8_SP2>(F.lds + RING_OFF, g, S, E);
        if (BOTH(2)) GRID_BAR(2);
    }
    if (IN(3)) { p3_kmean(F); { const gla::Tensors T = gla_tensors(F); for (int it = F.vcu; it < BATCH * NGH * 8; it += F.G) gla::group<false>((gla::lptr)F.lds, T, it >> 3, it & 7); } if (BOTH(3)) GRID_BAR(3); }
    if (IN(4)) {
#if defined(MK_DUP_GLAC)
        for (int rep_ = ({ int r_ = 2; asm volatile("" : "+s"(r_)); r_; }); rep_ > 0; --rep_)
#endif
        { const gla::Tensors T = gla_tensors(F); for (int it = F.vcu; it < BATCH * NGH * 8; it += F.G) gla::group<true>((gla::lptr)F.lds, T, it >> 3, it & 7); }
        const attn_body::AttnTensors AT{(const attn_body::bf16*)(F.ws + WS_QA), (const attn_body::bf16*)(F.ws + WS_KA), (const attn_body::bf16*)(F.ws + WS_VA), (attn_body::bf16*)(F.ws + WS_MIX), (const float*)(F.ws + WS_KMEAN), ARG_IN(F, I_ATTNG)};
        const attn_body::StaticOrder S((int)F.G, (int)blockIdx.x);
        attn_body::attn_phase<attn_body::StaticOrder>((char*)lds + RING_OFF, AT, S);
        if (BOTH(4)) GRID_BAR(4);
    }
    if (IN(5)) {
        pg8::Gemm g{(const bf16*)(F.ws + WS_MIX), (const bf16*)(F.ws + WS_WO), M, D, D}; pg8::StaticOrder S; S.init(M, D, F.G, (int)blockIdx.x);
        pg8::EpiBf16<0> E{(bf16*)(F.ws + WS_Y1), D, nullptr, 0, 0, 1.f};
        pg8::gemm_phase<pg8::EpiBf16<0>, pg8::StaticOrder, PG8_ALIGN, PG8_SP2>(F.lds + RING_OFF, g, S, E);
        if (BOTH(5)) GRID_BAR(5);
    }
    if (IN(6)) { p4b_ln1_adaln2(F); if (BOTH(6)) GRID_BAR(6); }
    if (IN(7)) {
        pg8::Gemm g{XN, (const bf16*)(F.ws + WS_WUP), M, 2 * FF, D}; pg8::StaticOrder S; S.init(M, 2 * FF, F.G, (int)blockIdx.x);
        pg8::EpiConvGlu E{(bf16*)(F.ws + WS_ACT), ARG_IN(F, I_BUP), ARG_IN(F, I_CONVW), ARG_IN(F, I_CONVB), (float*)(F.ws + WS_HALO), (float*)(F.ws + WS_FIXS), (float*)(F.ws + WS_FIXV), (LAS float*)(F.lds + HTAB_OFF)};
        pg8::gemm_phase<pg8::EpiConvGlu, pg8::StaticOrder, true, PG8_SP2>(F.lds + RING_OFF, g, S, E);
        if (BOTH(7)) GRID_BAR(7);
    }
    if (IN(8)) { p5b_fixup(F); if (BOTH(8)) GRID_BAR(8); }
    if (IN(9)) {
        pg8::Gemm g{(const bf16*)(F.ws + WS_ACT), (const bf16*)(F.ws + WS_WDN), M, D, FF}; pg8::StaticOrder S; S.init(M, D, F.G, (int)blockIdx.x);
        pg8::EpiBf16<0> E{(bf16*)(F.ws + WS_Y2), D, nullptr, 0, 0, 1.f};
        pg8::gemm_phase<pg8::EpiBf16<0>, pg8::StaticOrder, PG8_ALIGN, PG8_SP2>(F.lds + RING_OFF, g, S, E);
        if (BOTH(9)) GRID_BAR(9);
    }
    if (IN(10)) { p6b_ln2(F); }
#undef IN
#undef BOTH
}

extern "C" void kernel_launch(void* const* d_in, const int* in_sizes, int n_in, void* d_out, int out_size, void* d_ws, size_t ws_size, hipStream_t stream) {
    static int grid = 0;
    if (grid == 0) {
        if (n_in != 19 || in_sizes[0] != M * D || out_size != M * D || ws_size < WS_END) { fprintf(stderr, "kernel_launch: built for 19 inputs, x/out of %d floats, >= %zu bytes of workspace; got n_in %d, in0 %d, out %d, ws %zu; nothing launched\n", M * D, (size_t)WS_END, n_in, n_in > 0 ? in_sizes[0] : -1, out_size, ws_size); grid = -1; return; }
        int dev = 0, cus = 0, per_cu = 0;
        if (hipGetDevice(&dev) != hipSuccess || hipDeviceGetAttribute(&cus, hipDeviceAttributeMultiprocessorCount, dev) != hipSuccess) { fprintf(stderr, "kernel_launch: device query failed\n"); grid = -1; return; }
        if (hipFuncSetAttribute((const void*)mk_fwd, hipFuncAttributeMaxDynamicSharedMemorySize, LDS_BYTES) != hipSuccess) { fprintf(stderr, "kernel_launch: hipFuncSetAttribute failed\n"); grid = -1; return; }
        if (hipOccupancyMaxActiveBlocksPerMultiprocessor(&per_cu, (const void*)mk_fwd, NWAVES * 64, LDS_BYTES) != hipSuccess || per_cu < 1)
            fprintf(stderr, "kernel_launch: note: the occupancy query reports %d workgroups per CU\n", per_cu);
        (void)hipGetLastError();
        grid = cus;
        if (grid != 256) { fprintf(stderr, "kernel_launch: this kernel's row split needs exactly 256 CUs, got %d; nothing launched\n", grid); grid = -1; return; }
    }
    if (grid < 0) return;
    if (hipMemsetAsync((char*)d_ws + WS_CTL, 0, CTL_ZERO_BYTES, stream) != hipSuccess) { fprintf(stderr, "kernel_launch: hipMemsetAsync failed\n"); return; }
    Args a{};
    for (int i = 0; i < 19; ++i) a.in[i] = (const float*)d_in[i];
    a.out = (float*)d_out; a.ws = (unsigned char*)d_ws;
    for (int li = 0; li < N_LAUNCHES; ++li) {
        a.ph_lo = (N_LAUNCHES == 1) ? 0 : li; a.ph_hi = (N_LAUNCHES == 1) ? N_PHASES : li + 1; a.li = li;
        hipLaunchKernelGGL(mk_fwd, dim3(grid), dim3(NWAVES * 64), LDS_BYTES, stream, a);
#if defined(MK_DUP_MASK)
        if (N_LAUNCHES != 1 && ((MK_DUP_MASK >> li) & 1)) hipLaunchKernelGGL(mk_fwd, dim3(grid), dim3(NWAVES * 64), LDS_BYTES, stream, a);
#endif
        const hipError_t le = hipPeekAtLastError();
        if (le != hipSuccess) { fprintf(stderr, "kernel_launch: launch %d failed: %s\n", li, hipGetErrorName(le)); break; }
    }
}
```
